# Optimizing an MI355X kernel written in HIP

```python
import jax
import jax.numpy as jnp
from jax import lax
import numpy as np

D_MODEL = 1024
BATCH = 16
SEQ = 2048
DEPTH = 2

GRID_W = 64
CTX_LEN = 256

RET_HEADS = 4
RET_DK = 128
RET_DV = 128
RET_CHUNK = 128
NA_HEADS = 8
NA_DH = 64
NA_WIN_R = 8
NA_WIN_C = 16
NA_QB = NA_WIN_C
NA_KBW = 2 * NA_WIN_C
POOL_SIZES = (2, 4, 8, 16)
POOL_GROUP = D_MODEL // len(POOL_SIZES)
MOE_GROUPS = 4
MOE_PER_GROUP = 8
MOE_EXPERTS = MOE_GROUPS * MOE_PER_GROUP
MOE_HIDDEN = D_MODEL // 2
MOE_TOPK = 2

ROPE_BASE = 10000.0
LN_EPS = 1e-5
N_MOD = 6
DEEPNORM_ALPHA = (2 * DEPTH) ** 0.25
DEEPNORM_BETA = (8 * DEPTH) ** -0.25

RET_QKW = RET_HEADS * RET_DK
RET_VW = RET_HEADS * RET_DV
NA_W = NA_HEADS * NA_DH
MIX_W = RET_VW + NA_W
OFF_RK = 0
OFF_RV = OFF_RK + RET_QKW
OFF_NK = OFF_RV + RET_VW
OFF_NV = OFF_NK + NA_W
KV_COLS = OFF_NV + NA_W
OFF_RQ = KV_COLS
OFF_RG = OFF_RQ + RET_QKW
OFF_NQ = OFF_RG + RET_VW
IN_COLS = OFF_NQ + NA_W

kernel_name = 'hybrid_retention_natten_pool_hmoe_dit'


def _layer_norm(x, g, b):
    xf = x.astype(jnp.float32)
    mu = jnp.mean(xf, -1, keepdims=True)
    var = jnp.mean(jnp.square(xf - mu), -1, keepdims=True)
    return ((xf - mu) * lax.rsqrt(var + LN_EPS)).astype(x.dtype) * g + b


def _post_norm(h, y, g, b):
    return _layer_norm(DEEPNORM_ALPHA * h + y, g, b)


def _modulation(cvec, w_mod, b_mod):
    m = jax.nn.silu(cvec) @ w_mod + b_mod
    return [p[..., None, :] for p in jnp.split(m, N_MOD, axis=-1)]


def _modulate(h, shift, scale):
    return h * (1 + scale) + shift


def _split_heads(t, n_heads):
    b, n, _ = t.shape
    return jnp.transpose(t.reshape(b, n, n_heads, -1), (0, 2, 1, 3))


def _merge_heads(t):
    b, h, n, d = t.shape
    return jnp.transpose(t, (0, 2, 1, 3)).reshape(b, n, h * d)


def _axial_rope(n_tokens, head_dim):
    t = jnp.arange(n_tokens)
    rows = (t // GRID_W).astype(jnp.float32)
    cols = (t % GRID_W).astype(jnp.float32)
    n_freq = head_dim // 4
    inv_freq = ROPE_BASE ** (-jnp.arange(n_freq, dtype=jnp.float32) / n_freq)
    ang = jnp.concatenate([rows[:, None] * inv_freq, cols[:, None] * inv_freq], axis=-1)
    return jnp.cos(ang), jnp.sin(ang)


def _apply_rope(x, cos, sin):
    half = x.shape[-1] // 2
    x1, x2 = x[..., :half], x[..., half:]
    cos = cos.astype(x.dtype)
    sin = sin.astype(x.dtype)
    return jnp.concatenate([x1 * cos - x2 * sin, x1 * sin + x2 * cos], axis=-1)


def _retention_chunked(q, k, v, log_gamma, s0):
    b, h, n, _ = q.shape
    dv = v.shape[-1]
    nc = n // RET_CHUNK
    idx = jnp.arange(RET_CHUNK, dtype=jnp.float32)
    lg = log_gamma[:, None]
    diff = idx[:, None] - idx[None, :]
    intra = jnp.where(diff >= 0, jnp.exp(lg[..., None] * jnp.maximum(diff, 0.0)), 0.0)
    q_dec = jnp.exp(lg * (idx + 1.0))[..., None]
    k_dec = jnp.exp(lg * (RET_CHUNK - 1.0 - idx))[..., None]
    chunk_dec = jnp.exp(log_gamma * RET_CHUNK)[:, None, None]

    def to_chunks(t):
        return jnp.moveaxis(t.astype(jnp.float32).reshape(b, h, nc, RET_CHUNK, t.shape[-1]), 2, 0)

    def step(state, blk):
        qi, ki, vi = blk
        att = jnp.einsum('bhid,bhjd->bhij', qi, ki) * intra
        o = (jnp.einsum('bhij,bhje->bhie', att, vi)
             + jnp.einsum('bhid,bhde->bhie', qi, state) * q_dec)
        state = state * chunk_dec + jnp.einsum('bhjd,bhje->bhde', ki * k_dec, vi)
        return state, o

    state, o = lax.scan(step, s0, (to_chunks(q), to_chunks(k), to_chunks(v)))
    return jnp.moveaxis(o, 0, 2).reshape(b, h, n, dv), state


def _bidir_retention(q, k, v, log_gamma2, s0_fwd, s0_bwd):
    o_f, s_f = _retention_chunked(q, k, v, log_gamma2[0], s0_fwd)
    flip = lambda t: jnp.flip(t, axis=2)
    o_b, s_b = _retention_chunked(flip(q), flip(k), flip(v), log_gamma2[1], s0_bwd)
    return o_f + flip(o_b), s_f, s_b


def _retention_final_states(k, v, log_gamma2):
    n = k.shape[2]
    pos = jnp.arange(n, dtype=jnp.float32)
    w_f = jnp.exp(log_gamma2[0][:, None] * (n - 1.0 - pos))
    w_b = jnp.exp(log_gamma2[1][:, None] * pos)
    kf = k.astype(jnp.float32)
    vf = v.astype(jnp.float32)
    s_f = jnp.einsum('bhld,hl,bhle->bhde', kf, w_f, vf)
    s_b = jnp.einsum('bhld,hl,bhle->bhde', kf, w_b, vf)
    return s_f, s_b


def _head_group_norm(o):
    mu = jnp.mean(o, -1, keepdims=True)
    var = jnp.mean(jnp.square(o - mu), -1, keepdims=True)
    return (o - mu) * lax.rsqrt(var + LN_EPS)


def _neighbourhood_attention(q, k, v, k_ctx, v_ctx, rpb):
    b, h, n, d = q.shape
    rows = n // GRID_W
    wr = min(NA_WIN_R, rows)
    ncb = GRID_W // NA_QB
    qcol = np.arange(ncb)[:, None] * NA_QB + np.arange(NA_QB)[None, :]
    kstart = np.clip(np.arange(ncb) * NA_QB - NA_WIN_C // 2, 0, GRID_W - NA_KBW)
    kcol = kstart[:, None] + np.arange(NA_KBW)[None, :]
    wstart = np.clip(qcol - NA_WIN_C // 2, 0, GRID_W - NA_WIN_C)[..., None]
    col_ok = (kcol[:, None, :] >= wstart) & (kcol[:, None, :] < wstart + NA_WIN_C)
    col_bias_idx = np.clip(kcol[:, None, :] - qcol[..., None] + NA_WIN_C - 1, 0, 2 * NA_WIN_C - 2)
    qg = (q * NA_DH ** -0.5).reshape(b, h, rows, GRID_W, d)
    kg = k.reshape(b, h, rows, GRID_W, d)
    vg = v.reshape(b, h, rows, GRID_W, d)
    n_win = wr * NA_KBW

    def row_block(r):
        r0 = jnp.clip(r - wr // 2, 0, rows - wr)
        k_blk = lax.dynamic_slice_in_dim(kg, r0, wr, axis=2)[:, :, :, kcol]
        v_blk = lax.dynamic_slice_in_dim(vg, r0, wr, axis=2)[:, :, :, kcol]
        q_r = lax.dynamic_index_in_dim(qg, r, axis=2, keepdims=False).reshape(b, h, ncb, NA_QB, d)
        row_bias_idx = r0 + jnp.arange(wr) - r + NA_WIN_R - 1
        bias = rpb[:, row_bias_idx[:, None, None, None], col_bias_idx[None]]
        s_win = jnp.einsum('bhcqd,bhrckd->bhcqrk', q_r, k_blk).astype(jnp.float32)
        s_win = s_win + jnp.transpose(bias, (0, 2, 3, 1, 4)).astype(jnp.float32)
        s_win = jnp.where(col_ok[:, :, None, :], s_win, -jnp.inf)
        s_ctx = jnp.einsum('bhcqd,bhld->bhcql', q_r, k_ctx).astype(jnp.float32)
        logits = jnp.concatenate([s_win.reshape(b, h, ncb, NA_QB, n_win), s_ctx], axis=-1)
        p = jax.nn.softmax(logits, axis=-1).astype(v.dtype)
        p_win = p[..., :n_win].reshape(b, h, ncb, NA_QB, wr, NA_KBW)
        o = (jnp.einsum('bhcqrk,bhrckd->bhcqd', p_win, v_blk)
             + jnp.einsum('bhcql,bhld->bhcqd', p[..., n_win:], v_ctx))
        return o.reshape(b, h, GRID_W, d)

    o = lax.map(row_block, jnp.arange(rows))
    return jnp.transpose(o, (1, 2, 0, 3, 4)).reshape(b, h, n, d)


def _context_attention(q, k, v):
    s = jnp.einsum('bhqd,bhkd->bhqk', q, k).astype(jnp.float32) * NA_DH ** -0.5
    p = jax.nn.softmax(s, axis=-1).astype(v.dtype)
    return jnp.einsum('bhqk,bhkd->bhqd', p, v)


def _mixer_retention_na(h, hc, w_in, w_out, log_decay, rpb, update_ctx):
    b, n, _ = h.shape
    dtype = h.dtype
    log_gamma2 = jnp.log1p(-jnp.exp(log_decay.astype(jnp.float32)))
    cols = lambda t, off, width: t[..., off:off + width]
    p = h @ w_in
    pc = hc @ (w_in if update_ctx else w_in[:, :KV_COLS])
    rk_c = _split_heads(cols(pc, OFF_RK, RET_QKW), RET_HEADS)
    rv_c = _split_heads(cols(pc, OFF_RV, RET_VW), RET_HEADS)
    nk_c = _split_heads(cols(pc, OFF_NK, NA_W), NA_HEADS)
    nv_c = _split_heads(cols(pc, OFF_NV, NA_W), NA_HEADS)
    cos, sin = _axial_rope(n, RET_DK)
    rq = _apply_rope(_split_heads(cols(p, OFF_RQ, RET_QKW), RET_HEADS), cos, sin) * RET_DK ** -0.5
    rk = _apply_rope(_split_heads(cols(p, OFF_RK, RET_QKW), RET_HEADS), cos, sin)
    rv = _split_heads(cols(p, OFF_RV, RET_VW), RET_HEADS)
    rg = cols(p, OFF_RG, RET_VW)
    nq = _split_heads(cols(p, OFF_NQ, NA_W), NA_HEADS)
    nk = _split_heads(cols(p, OFF_NK, NA_W), NA_HEADS)
    nv = _split_heads(cols(p, OFF_NV, NA_W), NA_HEADS)
    if update_ctx:
        rq_c = _split_heads(cols(pc, OFF_RQ, RET_QKW), RET_HEADS) * RET_DK ** -0.5
        zeros = jnp.zeros((b, RET_HEADS, RET_DK, RET_DV), jnp.float32)
        o_ret_c, s_f, s_b = _bidir_retention(rq_c, rk_c, rv_c, log_gamma2, zeros, zeros)
    else:
        s_f, s_b = _retention_final_states(rk_c, rv_c, log_gamma2)
    o_ret, _, _ = _bidir_retention(rq, rk, rv, log_gamma2, s_f, s_b)
    y_ret = jax.nn.silu(rg) * _merge_heads(_head_group_norm(o_ret)).astype(dtype)
    y_na = _merge_heads(_neighbourhood_attention(nq, nk, nv, nk_c, nv_c, rpb))
    y = jnp.concatenate([y_ret, y_na], axis=-1) @ w_out
    if not update_ctx:
        return y, None
    rg_c = cols(pc, OFF_RG, RET_VW)
    nq_c = _split_heads(cols(pc, OFF_NQ, NA_W), NA_HEADS)
    y_ret_c = jax.nn.silu(rg_c) * _merge_heads(_head_group_norm(o_ret_c)).astype(dtype)
    y_na_c = _merge_heads(_context_attention(nq_c, nk_c, nv_c))
    yc = jnp.concatenate([y_ret_c, y_na_c], axis=-1) @ w_out
    return y, yc


def _pool_mixer(h, pool_w, pool_scale):
    b, n, d = h.shape
    hf = h.astype(jnp.float32).reshape(b, n, len(POOL_SIZES), POOL_GROUP)
    csum = jnp.pad(jnp.cumsum(hf, axis=1), ((0, 0), (1, 0), (0, 0), (0, 0)))
    pos = jnp.arange(n)
    outs = []
    for g, w in enumerate(POOL_SIZES):
        lo = jnp.clip(pos - w // 2, 0, n)
        hi = jnp.clip(pos + (w - w // 2), 0, n)
        cg = csum[:, :, g]
        mean = (cg[:, hi] - cg[:, lo]) / (hi - lo).astype(jnp.float32)[None, :, None]
        outs.append(mean - hf[:, :, g])
    z = jnp.stack(outs, axis=2).astype(h.dtype)
    y = jnp.einsum('bngc,gce->bnge', z, pool_w).reshape(b, n, d)
    return y * pool_scale


def _hier_moe(h, w_r1, b_r1, w_r2, b_r2, w_gate, w_up, w_down):
    b, n, d = h.shape
    t = h.reshape(b * n, d)
    logit_g = (t @ w_r1).astype(jnp.float32) + b_r1.astype(jnp.float32)
    grp = jnp.argmax(logit_g, axis=-1)
    gate_g = jnp.take_along_axis(jax.nn.softmax(logit_g, axis=-1), grp[:, None], axis=-1)
    logit_e = jnp.einsum('td,gde->tge', t, w_r2).astype(jnp.float32) + b_r2.astype(jnp.float32)
    logit_e = jnp.take_along_axis(logit_e, grp[:, None, None], axis=1)[:, 0]
    top_v, top_i = lax.top_k(logit_e, MOE_TOPK)
    w_sel = jax.nn.softmax(top_v, axis=-1) * gate_g
    eid = grp[:, None] * MOE_PER_GROUP + top_i
    combine = jnp.einsum('tk,tke->te', w_sel, jax.nn.one_hot(eid, MOE_EXPERTS, dtype=jnp.float32))

    def expert_step(acc, xs):
        wg, wu, wd, gcol = xs
        y = (jax.nn.silu(t @ wg) * (t @ wu)) @ wd
        return acc + y.astype(jnp.float32) * gcol[:, None], None

    acc, _ = lax.scan(expert_step, jnp.zeros((b * n, d), jnp.float32),
                      (w_gate, w_up, w_down, combine.T))
    return acc.astype(h.dtype).reshape(b, n, d)


def setup_inputs(seed: int = 0) -> dict:
    key = jax.random.key(seed)
    ks = jax.random.split(key, 21)
    f32 = jnp.float32

    def nrm(k, shape, scale):
        return jax.random.normal(k, shape, f32) * scale

    n_ab = (DEPTH + 1) // 2
    n_pool = DEPTH // 2
    base_log_decay = -(5.0 + jnp.arange(RET_HEADS, dtype=f32)) * jnp.log(2.0)
    return {
        'x': nrm(ks[0], (BATCH, SEQ, D_MODEL), 1.0),
        'c': nrm(ks[1], (BATCH, D_MODEL), 1.0),
        'ctx': nrm(ks[2], (BATCH, CTX_LEN, D_MODEL), 1.0),
        'c_ctx': nrm(ks[3], (D_MODEL,), 1.0),
        'w_mod': nrm(ks[4], (DEPTH, D_MODEL, N_MOD * D_MODEL), 0.5 * D_MODEL ** -0.5),
        'b_mod': nrm(ks[5], (DEPTH, N_MOD * D_MODEL), 0.02),
        'ln_g': 1.0 + nrm(ks[6], (DEPTH, 2, D_MODEL), 0.02),
        'ln_b': nrm(ks[7], (DEPTH, 2, D_MODEL), 0.02),
        'ab_w_in': nrm(ks[8], (n_ab, D_MODEL, IN_COLS), D_MODEL ** -0.5),
        'ab_w_out': nrm(ks[9], (n_ab, MIX_W, D_MODEL), DEEPNORM_BETA * MIX_W ** -0.5),
        'ab_log_decay': base_log_decay + nrm(ks[10], (n_ab, 2, RET_HEADS), 0.05),
        'ab_rpb': nrm(ks[11], (n_ab, NA_HEADS, 2 * NA_WIN_R - 1, 2 * NA_WIN_C - 1), 0.1),
        'pool_w': nrm(ks[12], (n_pool, len(POOL_SIZES), POOL_GROUP, POOL_GROUP), DEEPNORM_BETA * POOL_GROUP ** -0.5),
        'pool_scale': 1.0 + nrm(ks[13], (n_pool, D_MODEL), 0.1),
        'moe_w_r1': nrm(ks[14], (DEPTH, D_MODEL, MOE_GROUPS), D_MODEL ** -0.5),
        'moe_b_r1': nrm(ks[15], (DEPTH, MOE_GROUPS), 0.01),
        'moe_w_r2': nrm(ks[16], (DEPTH, MOE_GROUPS, D_MODEL, MOE_PER_GROUP), D_MODEL ** -0.5),
        'moe_b_r2': nrm(ks[17], (DEPTH, MOE_GROUPS, MOE_PER_GROUP), 0.01),
        'moe_w_gate': nrm(ks[18], (DEPTH, MOE_EXPERTS, D_MODEL, MOE_HIDDEN), D_MODEL ** -0.5),
        'moe_w_up': nrm(ks[19], (DEPTH, MOE_EXPERTS, D_MODEL, MOE_HIDDEN), D_MODEL ** -0.5),
        'moe_w_down': nrm(ks[20], (DEPTH, MOE_EXPERTS, MOE_HIDDEN, D_MODEL), DEEPNORM_BETA * MOE_HIDDEN ** -0.5),
    }


def reference(x, c, ctx, c_ctx, w_mod, b_mod, ln_g, ln_b, ab_w_in, ab_w_out, ab_log_decay, ab_rpb,
              pool_w, pool_scale, moe_w_r1, moe_b_r1, moe_w_r2, moe_b_r2, moe_w_gate, moe_w_up, moe_w_down):
    h, hc = x, ctx
    for i in range(DEPTH):
        j = i // 2
        carry_ctx = any(later % 2 == 0 for later in range(i + 1, DEPTH))
        moe_p = (moe_w_r1[i], moe_b_r1[i], moe_w_r2[i], moe_b_r2[i], moe_w_gate[i], moe_w_up[i], moe_w_down[i])
        m = _modulation(c, w_mod[i], b_mod[i])
        if i % 2 == 0 or carry_ctx:
            mc = _modulation(c_ctx, w_mod[i], b_mod[i])
        if i % 2 == 0:
            y, yc = _mixer_retention_na(_modulate(h, m[0], m[1]), _modulate(hc, mc[0], mc[1]),
                                        ab_w_in[j], ab_w_out[j], ab_log_decay[j], ab_rpb[j], carry_ctx)
        else:
            y = _pool_mixer(_modulate(h, m[0], m[1]), pool_w[j], pool_scale[j])
            if carry_ctx:
                yc = _pool_mixer(_modulate(hc, mc[0], mc[1]), pool_w[j], pool_scale[j])
        h = _post_norm(h, m[2] * y, ln_g[i, 0], ln_b[i, 0])
        h = _post_norm(h, m[5] * _hier_moe(_modulate(h, m[3], m[4]), *moe_p), ln_g[i, 1], ln_b[i, 1])
        if carry_ctx:
            hc = _post_norm(hc, mc[2] * yc, ln_g[i, 0], ln_b[i, 0])
            hc = _post_norm(hc, mc[5] * _hier_moe(_modulate(hc, mc[3], mc[4]), *moe_p), ln_g[i, 1], ln_b[i, 1])
    return h
```

```cpp
#include <hip/hip_runtime.h>
#include <cstdio>
#include <cstdint>

#ifndef ABL
#define ABL 0
#endif
#ifndef RPT
#define RPT 0
#endif
#ifndef MK_N_LAUNCHES
#define MK_N_LAUNCHES 1
#endif

#define GAS __attribute__((address_space(1)))
#define LAS __attribute__((address_space(3)))
typedef unsigned short bf16;
typedef short bf16x8 __attribute__((ext_vector_type(8)));
typedef float f32x4 __attribute__((ext_vector_type(4)));
typedef float f32x16 __attribute__((ext_vector_type(16)));
typedef unsigned u32x4 __attribute__((ext_vector_type(4)));
typedef unsigned u32x2 __attribute__((ext_vector_type(2)));

constexpr int D = 1024, NB = 16, SEQ = 2048, T = NB * SEQ, CTXL = 256, TC = NB * CTXL;
constexpr int GRIDW = 64, GROWS = SEQ / GRIDW;
constexpr int OFF_RK = 0, OFF_RV = 512, OFF_NK = 1024, OFF_NV = 1536, KV_COLS = 2048, OFF_RQ = 2048, OFF_RG = 2560, OFF_NQ = 3072, IN_COLS = 3584;
constexpr int NEXP = 32, HID = 512, LISTCAP = T;
constexpr int MAXSLOT = 73728;
constexpr float LN_EPS = 1e-5f;
constexpr float ALPHA = 1.41421356237309515f;
constexpr int NPHASE = 16;

constexpr size_t MiB = 1u << 20;
constexpr size_t WS_CTL = 0, CTL_ZERO_BYTES = 128 * 1024;
constexpr size_t WS_MOD = 1 * MiB;
constexpr size_t WS_TOKINFO = 2 * MiB;
constexpr size_t WS_LIST = 3 * MiB;
constexpr size_t WS_WIN = 8 * MiB, WS_WOUT = 15 * MiB, WS_WPOOL = 17 * MiB, WS_WGU = 18 * MiB, WS_WDN = 146 * MiB;
constexpr size_t WS_XA = 210 * MiB;
constexpr size_t WS_P = 282 * MiB;
constexpr size_t WS_ACT = 282 * MiB, WS_EO = 354 * MiB;
constexpr int TPITCH = SEQ + 64;
constexpr size_t WS_VTR = 446 * MiB, WS_VTRC = 480 * MiB;
constexpr size_t WS_VTN = 484 * MiB, WS_VTNC = 518 * MiB;
constexpr size_t WS_PC = 522 * MiB;
constexpr size_t WS_H16 = 526 * MiB;
constexpr size_t WS_END = 590 * MiB;
constexpr size_t DO_ST = 0;
constexpr size_t DO_KTR = 64 * MiB, DO_KTRC = 98 * MiB;
constexpr int PW = 2624, PO_RK = 0, PO_NK = 512, PO_RQ = 1024, PO_RG = 1536, PO_NQ = 2048, PCW = 512;
static_assert(WS_EO + (size_t)MAXSLOT * 1024 * 2 <= 498 * MiB && WS_ACT + (size_t)MAXSLOT * 512 * 2 <= WS_EO, "ws map");
static_assert(WS_P + (size_t)T * PW * 2 <= WS_VTR && WS_VTR + (size_t)64 * 128 * TPITCH * 2 <= WS_VTRC && WS_VTN + (size_t)128 * 64 * TPITCH * 2 <= WS_VTNC && DO_KTR + (size_t)64 * 128 * TPITCH * 2 <= DO_KTRC && WS_XA + (size_t)(T + TC) * D * 2 <= WS_P, "ws map");
constexpr int CW_BAR = 4096, XCD_BAR_WORDS_C = 3456;
constexpr int CW_CNT = 16384;
static_assert((CW_CNT + 64 * 64) * 4 <= (int)CTL_ZERO_BYTES && (CW_BAR + XCD_BAR_WORDS_C) * 4 <= (int)CTL_ZERO_BYTES, "ctl words inside the memset");

constexpr int RING_BYTES = 131072, LDS_SCR_OFF = RING_BYTES, LDSCTL_OFF = 154112, LDS_TAB_OFF = LDSCTL_OFF + 256, LDS_BYTES = 163840;

__device__ __forceinline__ unsigned f2bf(float f) { unsigned u = __builtin_bit_cast(unsigned, f); return (u + 0x7fffu + ((u >> 16) & 1u)) >> 16; }
__device__ __forceinline__ unsigned pk2(float lo, float hi) { return f2bf(lo) | (f2bf(hi) << 16); }
__device__ __forceinline__ float bf2f(unsigned h) { return __builtin_bit_cast(float, h << 16); }
__device__ __forceinline__ float bflo(unsigned w) { return __builtin_bit_cast(float, w << 16); }
__device__ __forceinline__ float bfhi(unsigned w) { return __builtin_bit_cast(float, w & 0xffff0000u); }
__device__ __forceinline__ float wave_sum(float v) {
    int x = __builtin_bit_cast(int, v);
#define WS_STEP(ctrl, rmask) do { const int t_ = __builtin_amdgcn_update_dpp(0, x, (ctrl), (rmask), 0xF, false); x = __builtin_bit_cast(int, __builtin_bit_cast(float, x) + __builtin_bit_cast(float, t_)); } while (0)
    WS_STEP(0xB1, 0xF);
    WS_STEP(0x4E, 0xF);
    WS_STEP(0x141, 0xF);
    WS_STEP(0x140, 0xF);
    WS_STEP(0x142, 0xA);
    WS_STEP(0x143, 0xC);
#undef WS_STEP
    return __builtin_bit_cast(float, __builtin_amdgcn_readlane(x, 63));
}
__device__ __forceinline__ float silu_f(float v) { return v / (1.0f + __expf(-v)); }
__device__ __forceinline__ float fexp2(float x) { return __builtin_amdgcn_exp2f(x); }
#define LDS_WAIT() asm volatile("s_waitcnt lgkmcnt(0)" ::: "memory")

#define XB_TMO      128
#define XB_XCNT(j)  (256  + 64 * (j))
#define XB_XSUB(j)  (1280 + 64 * (j))
#define XB_XGEN(j)  (2304 + 64 * (j))
#define XB_TOP      3328
#define XB_TOPGEN   3392
#define XCD_BAR_WORDS 3456
#define XB_SPIN_CAP (1u << 18)
__device__ __forceinline__ unsigned xb_ld(unsigned* p)              { return __hip_atomic_load(p, __ATOMIC_RELAXED, __HIP_MEMORY_SCOPE_AGENT); }
__device__ __forceinline__ unsigned xb_add(unsigned* p, unsigned v) { return __hip_atomic_fetch_add(p, v, __ATOMIC_RELAXED, __HIP_MEMORY_SCOPE_AGENT); }
__device__ __forceinline__ unsigned xb_xcc_id() { return (unsigned)__builtin_amdgcn_s_getreg((3 << 11) | 20) & 0xFu; }
#define XB_SPIN(cond, bar) do { unsigned _sp = 0; while (cond) { __builtin_amdgcn_s_sleep(1); \
    if ((++_sp & 255u) == 0u) { if (xb_ld(&(bar)[XB_TMO])) break; if (_sp > XB_SPIN_CAP) { atomicAdd(&(bar)[XB_TMO], 1u); break; } } } } while (0)
struct XcdBarrier { unsigned* bar; unsigned x; volatile LAS unsigned* st; };
__device__ __forceinline__ XcdBarrier xcd_barrier_post(unsigned* bar, volatile LAS unsigned* st) {
    XcdBarrier b; b.bar = bar; b.x = xb_xcc_id(); b.st = st;
    if (threadIdx.x == 0) (void)xb_add(&bar[XB_XCNT(b.x)], 1u);
    return b;
}
__device__ __forceinline__ void xcd_barrier_complete(unsigned* bar, unsigned x, unsigned& nloc, unsigned& nx) {
    const unsigned G = gridDim.x * gridDim.y * gridDim.z;
    unsigned sum, cnt, mine, sp = 0u;
    for (;;) {
        sum = 0u; cnt = 0u; mine = 0u;
#pragma unroll
        for (unsigned j = 0; j < 16; ++j) { const unsigned c = xb_ld(&bar[XB_XCNT(j)]); sum += c; cnt += (c > 0u) ? 1u : 0u; mine = (j == x) ? c : mine; }
        if (sum == G) break;
        __builtin_amdgcn_s_sleep(1);
        if ((++sp & 255u) == 0u) { if (xb_ld(&bar[XB_TMO])) break; if (sp > XB_SPIN_CAP) { atomicAdd(&bar[XB_TMO], 1u); break; } }
    }
    nloc = mine > 0u ? mine : 1u; nx = cnt > 0u ? cnt : 1u;
}
__device__ __forceinline__ void xcd_barrier(const XcdBarrier& b) {
    asm volatile("s_waitcnt vmcnt(0)" ::: "memory");
    __syncthreads();
    if (threadIdx.x == 0) {
        unsigned* bar = b.bar;
        __builtin_amdgcn_s_waitcnt(0);
        unsigned nloc = b.st[0], nx = b.st[1];
        if (nloc == 0u) { xcd_barrier_complete(bar, b.x, nloc, nx); b.st[0] = nloc; b.st[1] = nx; }
        const unsigned old = xb_add(&bar[XB_XSUB(b.x)], 1u);
        const unsigned gen = old / nloc;
        if (old + 1u == (gen + 1u) * nloc) {
            __builtin_amdgcn_fence(__ATOMIC_RELEASE, "agent");
            asm volatile("s_waitcnt vmcnt(0)" ::: "memory");
            const unsigned og = xb_add(&bar[XB_TOP], 1u);
            const unsigned tg = og / nx;
            if (og + 1u == (tg + 1u) * nx) xb_add(&bar[XB_TOPGEN], 1u);
            else XB_SPIN(xb_ld(&bar[XB_TOPGEN]) == tg, bar);
            __builtin_amdgcn_fence(__ATOMIC_ACQUIRE, "agent");
            xb_add(&bar[XB_XGEN(b.x)], 1u);
            asm volatile("s_waitcnt vmcnt(0)" ::: "memory");
        } else {
            XB_SPIN(xb_ld(&bar[XB_XGEN(b.x)]) == gen, bar);
            __builtin_amdgcn_fence(__ATOMIC_ACQUIRE, "agent");
            asm volatile("s_waitcnt vmcnt(0)" ::: "memory");
        }
    }
    __syncthreads();
}

struct Args { const float* in[21]; float* out; unsigned char* ws; int ph_lo, ph_hi; };
typedef const __attribute__((address_space(4))) Args* KArgs;
struct Ctx {
    LAS unsigned char* lds;
    int tid, lane, wave, G, bid;
    KArgs a;
    float* H;
    unsigned char* ws;
};
__device__ __forceinline__ const float* modp(const Ctx& F, int l, int row, int part) { return (const float*)(F.ws + WS_MOD) + (size_t)(l * 17 + row) * 6144 + part * 1024; }

namespace g8 {
constexpr int BM = 256, BK = 64, HALF = 128, HTB = HALF * BK * 2, STAGE_BYTES = 8 * HTB;
__device__ __forceinline__ int lds_byte(int r, int c) { const int st = (r >> 4) * 2 + (c >> 5), rr = r & 15, cc = c & 31, ob = rr * 64 + cc * 2; return st * 1024 + (ob ^ (((ob >> 9) & 1) << 5)); }
__device__ __forceinline__ void stage_rc(int b, int& R, int& C) { const int st = b / 1024, sb = b % 1024, swz = sb ^ (((sb >> 9) & 1) << 5); R = (st >> 1) * 16 + swz / 64; C = (st & 1) * 32 + (swz % 64) / 2; }
struct Unit { const char* B; int pm, pn, e, aux; };
__device__ __forceinline__ void tile_of(int L, int nM, int nN, int& pm, int& pn) {
    const int nwg = nM * nN; int wgid = L; { const int q = nwg / 8, r = nwg % 8, xcd = wgid % 8, off = wgid / 8; wgid = (xcd < r ? xcd * (q + 1) : r * (q + 1) + (xcd - r) * q) + off; }
    const int nig = 8 * nN, gid = wgid / nig, fm = gid * 8, gsz = (nM - fm) < 8 ? (nM - fm) : 8;
    pm = fm + ((wgid % nig) % gsz); pn = (wgid % nig) / gsz;
}
template <class Epi, class Sched>
__device__ __forceinline__ void gemm_phase(LAS unsigned char* lds, const char* Abase, const int K, const Sched& S, const Epi& E) {
    const int tid = threadIdx.x, wid = __builtin_amdgcn_readfirstlane(tid >> 6), lane = tid & 63, wr = wid >> 2, wc = wid & 3, fr = lane & 15, fq = lane >> 4;
    const int nt = K / BK;
    int R0, C0, R1, C1; stage_rc(tid * 16, R0, C0); stage_rc(tid * 16 + 8192, R1, C1);
    unsigned voffB[2]; voffB[0] = (unsigned)(R0 * K + C0) * 2u; voffB[1] = (unsigned)(R1 * K + C1) * 2u;
    const unsigned kstep = (unsigned)(BK * 2);
    const size_t hstepB = (size_t)HALF * K * 2;
    const unsigned ldsw = (unsigned)wid * 1024u;
    const int aoff = lds_byte(wr * 64 + fr, fq * 8), boff = lds_byte(wc * 32 + fr, fq * 8);
#define G8_SA(b, h) (((b) * 2 + (h)) * HTB)
#define G8_SB(b, h) ((4 + (b) * 2 + (h)) * HTB)
#define G8_STAGEB(bufoff, gbase) do { _Pragma("unroll") for (int _i = 0; _i < 2; ++_i) \
        __builtin_amdgcn_global_load_lds((const unsigned*)((const char*)(gbase) + voffB[_i]), (LAS unsigned*)(lds + (bufoff) + ldsw + _i * 8192), 16, 0, 0); } while (0)
#define G8_STAGEA(bufoff, offs, h, koff) do { _Pragma("unroll") for (int _i = 0; _i < 2; ++_i) \
        __builtin_amdgcn_global_load_lds((const unsigned*)((Abase + (koff)) + (offs)[h][_i]), (LAS unsigned*)(lds + (bufoff) + ldsw + _i * 8192), 16, 0, 0); } while (0)
#define G8_LDA(dst, b, h) do { _Pragma("unroll") for (int m = 0; m < 4; ++m) _Pragma("unroll") for (int k = 0; k < 2; ++k) dst[m][k] = *(const LAS bf16x8*)(lds + G8_SA(b, h) + aoff + m * 2048 + k * 1024); } while (0)
#define G8_LDB(dst, b, h) do { _Pragma("unroll") for (int n = 0; n < 2; ++n) _Pragma("unroll") for (int k = 0; k < 2; ++k) dst[n][k] = *(const LAS bf16x8*)(lds + G8_SB(b, h) + boff + n * 2048 + k * 1024); } while (0)
#define G8_MMA(ai, bj, At, Bt) do { __builtin_amdgcn_s_setprio(1); _Pragma("unroll") for (int m = 0; m < 4; ++m) _Pragma("unroll") for (int n = 0; n < 2; ++n) _Pragma("unroll") for (int k = 0; k < 2; ++k) \
        acc[ai][bj][m][n] = __builtin_amdgcn_mfma_f32_16x16x32_bf16(Bt[n][k], At[m][k], acc[ai][bj][m][n], 0, 0, 0); __builtin_amdgcn_s_setprio(0); } while (0)
#define G8_WAIT_V(n) asm volatile("s_waitcnt vmcnt(" #n ")" ::: "memory")
#define G8_WAIT_L(n) asm volatile("s_waitcnt lgkmcnt(" #n ")" ::: "memory")
#define G8_BAR __builtin_amdgcn_s_barrier()
#define G8_SCHED __builtin_amdgcn_sched_barrier(0)
    Unit cur, nxt; int ui = 0;
    if (!S.next(0, cur)) return;
    f32x4 acc[2][2][4][2];
#pragma unroll
    for (int a = 0; a < 2; ++a)
#pragma unroll
        for (int b = 0; b < 2; ++b)
#pragma unroll
            for (int m = 0; m < 4; ++m)
#pragma unroll
                for (int n = 0; n < 2; ++n) acc[a][b][m][n] = (f32x4){0.f, 0.f, 0.f, 0.f};
    bf16x8 At[4][2], B0[2][2], B1[2][2];
    unsigned ac[2][2];
    ac[0][0] = S.rowoff(cur, R0) + (unsigned)C0 * 2u; ac[0][1] = S.rowoff(cur, R1) + (unsigned)C1 * 2u;
    ac[1][0] = S.rowoff(cur, HALF + R0) + (unsigned)C0 * 2u; ac[1][1] = S.rowoff(cur, HALF + R1) + (unsigned)C1 * 2u;
    const char* cB = cur.B;
    G8_STAGEB(G8_SB(0, 0), cB); G8_STAGEB(G8_SB(0, 1), cB + hstepB); G8_STAGEA(G8_SA(0, 0), ac, 0, 0); G8_STAGEA(G8_SA(0, 1), ac, 1, 0);
    if (wr == 1) G8_BAR;
    G8_WAIT_V(2); G8_BAR;
    G8_STAGEB(G8_SB(1, 0), cB + kstep); G8_STAGEA(G8_SA(1, 0), ac, 0, kstep); G8_STAGEB(G8_SB(1, 1), cB + hstepB + kstep);
    G8_WAIT_V(6); G8_BAR;
    for (;;) {
        const bool has_next = S.next(ui + 1, nxt);
        const char* nB = has_next ? nxt.B : cB;
#pragma unroll 1
        for (int t = 0; t < nt; t += 2) {
            const bool last = (t == nt - 2);
            const unsigned k1 = (unsigned)(t + 1) * kstep;
            const unsigned k2 = last ? 0u : (unsigned)(t + 2) * kstep;
            const unsigned k3 = k2 + kstep;
            const char* b2 = last ? nB : cB + k2; const char* b3 = b2 + kstep;
            G8_LDB(B0, 0, 0); G8_LDB(B1, 0, 1); G8_SCHED; G8_LDA(At, 0, 0); G8_STAGEA(G8_SA(1, 1), ac, 1, k1);
            if (last && has_next) {
                ac[0][0] = S.rowoff(nxt, R0) + (unsigned)C0 * 2u; ac[0][1] = S.rowoff(nxt, R1) + (unsigned)C1 * 2u;
                ac[1][0] = S.rowoff(nxt, HALF + R0) + (unsigned)C0 * 2u; ac[1][1] = S.rowoff(nxt, HALF + R1) + (unsigned)C1 * 2u;
            }
            G8_WAIT_V(8); G8_WAIT_L(0); G8_BAR; G8_MMA(0, 0, At, B0); G8_MMA(0, 1, At, B1); G8_BAR; G8_SCHED;
            G8_LDA(At, 0, 1); G8_STAGEB(G8_SB(0, 0), b2); G8_STAGEB(G8_SB(0, 1), b2 + hstepB); G8_STAGEA(G8_SA(0, 0), ac, 0, k2);
            G8_WAIT_V(8); G8_WAIT_L(0); G8_BAR; G8_MMA(1, 0, At, B0); G8_MMA(1, 1, At, B1); G8_BAR; G8_SCHED;
            G8_LDB(B0, 1, 0); G8_LDB(B1, 1, 1); G8_SCHED; G8_LDA(At, 1, 0); G8_STAGEA(G8_SA(0, 1), ac, 1, k2);
            G8_WAIT_V(8); G8_WAIT_L(0); G8_BAR; G8_MMA(0, 0, At, B0); G8_MMA(0, 1, At, B1); G8_BAR; G8_SCHED;
            G8_LDA(At, 1, 1); G8_STAGEB(G8_SB(1, 0), b3); G8_STAGEB(G8_SB(1, 1), b3 + hstepB); G8_STAGEA(G8_SA(1, 0), ac, 0, k3);
            G8_WAIT_V(8); G8_WAIT_L(0); G8_BAR; G8_MMA(1, 0, At, B0); G8_MMA(1, 1, At, B1); G8_BAR; G8_SCHED;
        }
        if (wr == 0) G8_BAR;
        E(acc, cur, wr, wc, fr, fq);
        if (!has_next) break;
#pragma unroll
        for (int a = 0; a < 2; ++a)
#pragma unroll
            for (int b = 0; b < 2; ++b)
#pragma unroll
                for (int m = 0; m < 4; ++m)
#pragma unroll
                    for (int n = 0; n < 2; ++n) acc[a][b][m][n] = (f32x4){0.f, 0.f, 0.f, 0.f};
        cur = nxt; cB = nB; ++ui;
        if (wr == 1) G8_BAR;
    }
    G8_WAIT_V(0);
    G8_BAR;
#undef G8_SA
#undef G8_SB
#undef G8_STAGEA
#undef G8_STAGEB
#undef G8_LDA
#undef G8_LDB
#undef G8_MMA
#undef G8_WAIT_V
#undef G8_WAIT_L
#undef G8_BAR
#undef G8_SCHED
}
}

struct CvDesc { const float* W; bf16* WT; int ldw, ldo, k0, n0, kind, aux; };
struct RmId   { __device__ __forceinline__ int operator()(int n) const { return n; } };
struct RmGate { int up; __device__ __forceinline__ int operator()(int h) const { return 256 * (h >> 7) + 128 * ((h >> 2) & 1) + 32 * ((h >> 5) & 3) + 16 * up + 4 * ((h >> 3) & 3) + (h & 3); } };
struct RmPerm { __device__ __forceinline__ int operator()(int c) const { const int q = c & 31; return (c & ~31) + 16 * ((q >> 2) & 1) + 4 * (q >> 3) + (q & 3); } };
struct RmIn   { __device__ __forceinline__ int operator()(int n) const {
    const bool rope = (n < 512) || (n >= OFF_RQ && n < OFF_RQ + 512);
    const bool tokmaj = (n >= OFF_NK && n < OFF_NV) || (n >= OFF_RG);
    const int d = n & 127; return rope ? ((n & ~127) + 32 * ((d >> 4) & 3) + 16 * (d >> 6) + (d & 15)) : (tokmaj ? RmPerm{}(n) : n); } };

__device__ __forceinline__ int cv_rowmap(const CvDesc& d, int n) { return d.kind == 1 ? RmGate{d.aux}(n) : (d.kind == 2 ? RmPerm{}(n) : (d.kind == 3 ? RmIn{}(n) : n)); }
__device__ __forceinline__ void cv_load(const CvDesc& d, int lane, float (&buf)[32]) {
    const float* p = d.W + (size_t)(d.k0 + (lane >> 5)) * d.ldw + d.n0 + (lane & 31);
#pragma unroll
    for (int i = 0; i < 32; ++i) buf[i] = __builtin_nontemporal_load(p + (size_t)(2 * i) * d.ldw);
}
__device__ __forceinline__ void cv_store(const CvDesc& d, int lane, const float (&buf)[32], LAS float* scr) {
#pragma unroll
    for (int i = 0; i < 32; ++i) scr[(2 * i + (lane >> 5)) * 33 + (lane & 31)] = buf[i];
    LDS_WAIT(); asm volatile("" ::: "memory");
    const int c = lane & 7;
#pragma unroll
    for (int j = 0; j < 4; ++j) { const int n = (lane >> 3) + 8 * j; const LAS float* sp = scr + (8 * c) * 33 + n;
        u32x4 o; o.x = pk2(sp[0 * 33], sp[1 * 33]); o.y = pk2(sp[2 * 33], sp[3 * 33]); o.z = pk2(sp[4 * 33], sp[5 * 33]); o.w = pk2(sp[6 * 33], sp[7 * 33]);
        *(u32x4*)(d.WT + (size_t)cv_rowmap(d, d.n0 + n) * d.ldo + d.k0 + 8 * c) = o; }
    LDS_WAIT(); asm volatile("" ::: "memory");
}
constexpr int I_E1 = 3 * 32 * 256;
__device__ __forceinline__ CvDesc cv_expert(const Ctx& F, int l, int q) {
    const int mat = q >> 13, r = q & 8191, le = l * 32 + (r >> 8), w = r & 255; CvDesc d;
    if (mat < 2) { d.W = (mat ? F.a->in[19] : F.a->in[18]) + (size_t)le * 1024 * 512; d.ldw = 512; d.WT = (bf16*)(F.ws + WS_WGU) + (size_t)le * 1024 * 1024; d.ldo = 1024; d.kind = 1; d.aux = mat; d.k0 = 64 * (w >> 4); d.n0 = 32 * (w & 15); }
    else { d.W = F.a->in[20] + (size_t)le * 512 * 1024; d.ldw = 1024; d.WT = (bf16*)(F.ws + WS_WDN) + (size_t)le * 1024 * 512; d.ldo = 512; d.kind = 2; d.aux = 0; d.k0 = 64 * (w >> 5); d.n0 = 32 * (w & 31); }
    return d;
}
constexpr int I_IN = 16 * 112, I_OUT = 16 * 32, I_POOL = 4 * 32;
__device__ __forceinline__ CvDesc cv_phase0(const Ctx& F, int r, int nexp) {
    if (r < nexp) return cv_expert(F, r < I_E1 ? 0 : 1, r < I_E1 ? r : r - I_E1);
    r -= nexp; CvDesc d; d.aux = 0;
    if (r < I_IN) { d.W = F.a->in[8]; d.ldw = IN_COLS; d.WT = (bf16*)(F.ws + WS_WIN); d.ldo = 1024; d.kind = 3; d.k0 = 64 * (r / 112); d.n0 = 32 * (r % 112); return d; }
    r -= I_IN;
    if (r < I_OUT) { d.W = F.a->in[9]; d.ldw = 1024; d.WT = (bf16*)(F.ws + WS_WOUT); d.ldo = 1024; d.kind = 2; d.k0 = 64 * (r >> 5); d.n0 = 32 * (r & 31); return d; }
    r -= I_OUT;
    { const int g = r >> 5, q = r & 31; d.W = F.a->in[12] + (size_t)g * 65536; d.ldw = 256; d.WT = (bf16*)(F.ws + WS_WPOOL) + (size_t)g * 65536; d.ldo = 256; d.kind = 2; d.k0 = 64 * (q >> 3); d.n0 = 32 * (q & 7); return d; }
}
#define CV_RUN(first, end, stride, GEN) do { float bA_[32], bB_[32]; const int end_ = (end), st_ = (stride); \
    for (int it_ = (first); it_ < end_; it_ += 2 * st_) { const bool h1_ = it_ + st_ < end_; \
        const CvDesc dA_ = GEN(it_); const CvDesc dB_ = GEN(h1_ ? it_ + st_ : it_); \
        cv_load(dA_, F.lane, bA_); cv_load(dB_, F.lane, bB_);     \
        cv_store(dA_, F.lane, bA_, scr); if (h1_) cv_store(dB_, F.lane, bB_, scr); } } while (0)
__device__ __forceinline__ void phase0(const Ctx& F) {
    LAS float* sil = (LAS float*)F.lds;
    LAS float* red = (LAS float*)(F.lds + 17 * 1024 * 4);
    float* mod = (float*)(F.ws + WS_MOD);
    for (int it = F.bid; it < 192; it += F.G) {
        const int l = it / 96, col0 = (it % 96) * 64;
        for (int idx = F.tid; idx < 17 * 1024; idx += 512) { const int r = idx >> 10, k = idx & 1023; const float v = r < 16 ? F.a->in[1][r * 1024 + k] : F.a->in[3][k]; sil[idx] = silu_f(v); }
        __syncthreads();
        float a[17];
#pragma unroll
        for (int r = 0; r < 17; ++r) a[r] = 0.f;
        const int k0 = F.wave * 128;
        const float* wp = F.a->in[4] + ((size_t)l * 1024 + k0) * 6144 + col0 + F.lane;
#pragma unroll 4
        for (int kk = 0; kk < 128; ++kk) { const float w = wp[(size_t)kk * 6144];
#pragma unroll
            for (int r = 0; r < 17; ++r) a[r] += sil[r * 1024 + k0 + kk] * w; }
#pragma unroll
        for (int r = 0; r < 17; ++r) red[(F.wave * 17 + r) * 64 + F.lane] = a[r];
        __syncthreads();
        for (int idx = F.tid; idx < 17 * 64; idx += 512) { const int r = idx >> 6, cc = idx & 63; float s = F.a->in[5][l * 6144 + col0 + cc];
#pragma unroll
            for (int w8 = 0; w8 < 8; ++w8) s += red[(w8 * 17 + r) * 64 + cc];
            mod[(size_t)(l * 17 + r) * 6144 + col0 + cc] = s; }
        __syncthreads();
    }
    __syncthreads();
    LAS float* scr = (LAS float*)(F.lds + F.wave * 16384);
    const int gw = F.bid * 8 + F.wave, NGW = F.G * 8;
    const int nexp_items = (F.G == 256) ? 0 : 2 * I_E1;
    const int NITEMS = nexp_items + I_IN + I_OUT + I_POOL;
#define CV_GEN0(i_) cv_phase0(F, (i_), nexp_items)
    CV_RUN(gw, NITEMS, NGW, CV_GEN0);
#undef CV_GEN0
}
__device__ __forceinline__ void convert_range(const Ctx& F, int rank, int nranks, int lo, int hi) {
    if (rank < 0 || rank >= nranks) return;
    LAS float* scr = (LAS float*)(F.lds + F.wave * 16384);
#define CV_GEN1(i_) cv_expert(F, (i_) < I_E1 ? 0 : 1, (i_) < I_E1 ? (i_) : (i_) - I_E1)
    CV_RUN(lo + rank * 8 + F.wave, hi, nranks * 8, CV_GEN1);
#undef CV_GEN1
}
__device__ __forceinline__ void convert_tail(const Ctx& F, int vc, int first, int lo, int hi) {
    if (F.G != 256) return;
    if (first >= F.G) first = 0;
    convert_range(F, vc - first, F.G - first, lo, hi);
}
constexpr int DEDICATED_CV = 32;

__device__ __forceinline__ void p1_load(const Ctx& F, int row, f32x4 (&b)[4]) {
    const float* src = row < T ? F.a->in[0] + (size_t)row * D : F.a->in[2] + (size_t)(row - T) * D;
#pragma unroll
    for (int j = 0; j < 4; ++j) b[j] = *(const f32x4*)(src + 4 * F.lane + 256 * j);
}
__device__ __forceinline__ void p1_row(const Ctx& F, int row, const f32x4 (&v)[4], f32x4 (&sh)[4], f32x4 (&sc)[4], int& mr_cur) {
    const int mr = row < T ? (row >> 11) : 16;
    if (mr != mr_cur) { mr_cur = mr;
#pragma unroll
        for (int j = 0; j < 4; ++j) { sh[j] = *(const f32x4*)(modp(F, 0, mr, 0) + 4 * F.lane + 256 * j); sc[j] = *(const f32x4*)(modp(F, 0, mr, 1) + 4 * F.lane + 256 * j) + 1.0f; } }
    unsigned long long* o8 = (unsigned long long*)((bf16*)(F.ws + WS_XA) + (size_t)row * D) + F.lane;
#pragma unroll
    for (int j = 0; j < 4; ++j) { const f32x4 y = v[j] * sc[j] + sh[j];
        o8[64 * j] = (unsigned long long)pk2(y.x, y.y) | ((unsigned long long)pk2(y.z, y.w) << 32); }
}
__device__ __forceinline__ void phase1(const Ctx& F) {
    const int gw = F.bid * 8 + F.wave, NGW = F.G * 8;
    const int per = (T + TC + NGW - 1) / NGW, r_lo = gw * per, r_hi = min(r_lo + per, T + TC);
    if (r_lo >= r_hi) return;
    f32x4 A[4], B[4], sh[4], sc[4]; int mr_cur = -1;
    p1_load(F, r_lo, A);
    for (int row = r_lo; row < r_hi; row += 2) {
        if (row + 1 < r_hi) p1_load(F, row + 1, B);
        asm volatile("" ::: "memory");
        p1_row(F, row, A, sh, sc, mr_cur);
        if (row + 1 < r_hi) {
            if (row + 2 < r_hi) p1_load(F, row + 2, A);
            asm volatile("" ::: "memory");
            p1_row(F, row + 1, B, sh, sc, mr_cur);
        }
    }
}

struct SchedIn {
    int G, c; const char* Wt;
    __device__ __forceinline__ bool next(int i, g8::Unit& u) const {
        const int L = i * G + c; if (L >= 1792 + 128) return false;
        int pm, pn; if (L < 1792) g8::tile_of(L, 128, 14, pm, pn); else { g8::tile_of(L - 1792, 16, 8, pm, pn); pm += 128; }
        u.pm = pm; u.pn = pn; u.e = 0; u.aux = 0; u.B = Wt + (size_t)pn * 256 * 1024 * 2; return true; }
    __device__ __forceinline__ unsigned rowoff(const g8::Unit& u, int r) const { return (unsigned)(u.pm * 256 + r) * 2048u; }
};
struct EpiIn {
    unsigned char* ws; unsigned char* dout; LAS unsigned char* lds;
    __device__ __forceinline__ void tstore(const f32x4 (&v)[4], LAS bf16* scr, bf16* dst0, size_t colpitch, int lane, int fr, int fq) const {
#pragma unroll
        for (int m = 0; m < 4; ++m)
#pragma unroll
            for (int j = 0; j < 4; ++j) scr[(4 * fq + j) * 72 + 16 * m + fr] = (bf16)f2bf(v[m][j]);
        LDS_WAIT(); asm volatile("" ::: "memory");
#pragma unroll
        for (int i = 0; i < 2; ++i) { const int q = lane + 64 * i, cc = q >> 3, ch = q & 7;
            const u32x4 w = *(const LAS u32x4*)(scr + cc * 72 + ch * 8);
            *(u32x4*)(dst0 + (size_t)cc * colpitch + ch * 8) = w; }
        LDS_WAIT(); asm volatile("" ::: "memory");
    }
    __device__ __forceinline__ void operator()(const f32x4 (&acc)[2][2][4][2], const g8::Unit& u, int wr, int wc, int fr, int fq) const {
        const bool isctx = u.pm >= 128;
        const int lane = fr + 16 * fq, wid = wr * 4 + wc;
        LAS bf16* scr = (LAS bf16*)(lds + LDS_SCR_OFF + wid * 2304);
        const int row0 = u.pm * 256 + wr * 64 + fr;
        const int bb = isctx ? (u.pm - 128) : (u.pm >> 3);
        const int tt0 = isctx ? 0 : ((u.pm & 7) * 256);
        const size_t tp = isctx ? CTXL : TPITCH;
        const int pn = u.pn;
        if (pn < 2 || pn == 8 || pn == 9) {
            const float scale = (pn >= 8) ? 0.08838834764831845f : 1.0f;
            const int dd = 16 * wc + 4 * fq;
            f32x4 invf;
#pragma unroll
            for (int j = 0; j < 4; ++j) invf[j] = fexp2(-(float)((dd & 31) + j) * (13.287712379549449f / 32.0f));
#pragma unroll
            for (int ai = 0; ai < 2; ++ai)
#pragma unroll
                for (int bj = 0; bj < 2; ++bj) {
                    f32x4 o1[4], o2[4];
#pragma unroll
                    for (int m = 0; m < 4; ++m) { const int row = row0 + ai * 128 + m * 16;
                        f32x4 cs = (f32x4){1.f, 1.f, 1.f, 1.f}, sn = (f32x4){0.f, 0.f, 0.f, 0.f};
                        if (!isctx) { const float pos = (float)((wc < 2) ? (4 * (u.pm & 7) + wr + 2 * ai) : (fr + 16 * m));
#pragma unroll
                            for (int j = 0; j < 4; ++j) { const float ang = pos * invf[j]; cs[j] = __cosf(ang); sn[j] = __sinf(ang); } }
                        const f32x4 x1 = acc[ai][bj][m][0], x2 = acc[ai][bj][m][1];
                        o1[m] = (x1 * cs - x2 * sn) * scale; o2[m] = (x1 * sn + x2 * cs) * scale;
                        if (!isctx) { bf16* rp = (bf16*)(ws + WS_P) + (size_t)row * PW + (pn < 2 ? PO_RK + pn * 256 : PO_RQ + (pn - 8) * 256) + bj * 128 + dd;
                            *(u32x2*)(rp) = (u32x2){pk2(o1[m].x, o1[m].y), pk2(o1[m].z, o1[m].w)};
                            *(u32x2*)(rp + 64) = (u32x2){pk2(o2[m].x, o2[m].y), pk2(o2[m].z, o2[m].w)}; } }
                    if (pn < 2) {
                        const int head = pn * 2 + bj;
                        bf16* d0 = (bf16*)(dout + (isctx ? DO_KTRC : DO_KTR)) + ((size_t)(bb * 4 + head) * 128 + 16 * wc) * tp + tt0 + ai * 128 + wr * 64;
                        tstore(o1, scr, d0, tp, lane, fr, fq);
                        tstore(o2, scr, d0 + (size_t)64 * tp, tp, lane, fr, fq);
                    }
                }
        } else if (pn == 2 || pn == 3 || pn == 6 || pn == 7) {
#pragma unroll
            for (int ai = 0; ai < 2; ++ai)
#pragma unroll
                for (int bj = 0; bj < 2; ++bj)
#pragma unroll
                    for (int n = 0; n < 2; ++n) {
                        const int col = (pn & 1) * 256 + bj * 128 + wc * 32 + n * 16;
                        const size_t boff = (pn < 4) ? (isctx ? WS_VTRC : WS_VTR) : (isctx ? WS_VTNC : WS_VTN);
                        const size_t roff = (pn < 4) ? ((size_t)(bb * 4 + (col >> 7)) * 128 + (col & 127)) : ((size_t)(bb * 8 + (col >> 6)) * 64 + (col & 63));
                        bf16* d0 = (bf16*)(ws + boff) + roff * tp;
                        f32x4 v[4];
#pragma unroll
                        for (int m = 0; m < 4; ++m) v[m] = acc[ai][bj][m][n];
                        tstore(v, scr, d0 + tt0 + ai * 128 + wr * 64, tp, lane, fr, fq);
                    }
        } else {
            const float scale = (pn >= 12) ? 0.125f : 1.0f;
            int ld = PW, c0; size_t boff = WS_P;
            if (pn < 6) { if (isctx) { boff = WS_PC; ld = PCW; } c0 = (isctx ? 0 : PO_NK) + (pn - 4) * 256; }
            else if (pn < 12) { c0 = PO_RG + (pn - 10) * 256; }
            else { c0 = PO_NQ + (pn - 12) * 256; }
            bf16* base = (bf16*)(ws + boff);
            const int rsub = isctx ? T : 0;
            const int col0 = c0 + wc * 32 + 8 * fq;
#pragma unroll
            for (int ai = 0; ai < 2; ++ai)
#pragma unroll
                for (int m = 0; m < 4; ++m) { bf16* rp = base + (size_t)(row0 + ai * 128 + m * 16 - rsub) * ld + col0;
#pragma unroll
                    for (int bj = 0; bj < 2; ++bj) { const f32x4 v0 = acc[ai][bj][m][0] * scale, v1 = acc[ai][bj][m][1] * scale;
                        *(u32x4*)(rp + bj * 128) = (u32x4){pk2(v0.x, v0.y), pk2(v0.z, v0.w), pk2(v1.x, v1.y), pk2(v1.z, v1.w)}; } }
        }
    }
};

__device__ __forceinline__ void dma16(const void* g, LAS unsigned char* l) { __builtin_amdgcn_global_load_lds((const unsigned*)g, (LAS unsigned*)l, 16, 0, 0); }
__device__ __forceinline__ bf16x8 frag256(const LAS unsigned char* tile, int row, int chunk) { return *(const LAS bf16x8*)(tile + row * 256 + ((chunk ^ (row & 15)) << 4)); }
__device__ __forceinline__ void phase3(const Ctx& F) {
    const bf16* KTr = (const bf16*)((const char*)F.H + DO_KTR); const bf16* KTrc = (const bf16*)((const char*)F.H + DO_KTRC);
    const bf16* VTr = (const bf16*)(F.ws + WS_VTR); const bf16* VTrc = (const bf16*)(F.ws + WS_VTRC);
    bf16* ST = (bf16*)((char*)F.H + DO_ST);
    const int lane = F.lane, r = lane & 31, hh = lane >> 5, dkt = F.wave & 3, dvs = F.wave >> 2, w = F.wave;
    for (int u0 = F.bid; u0 < 256; u0 += F.G) {
        const int unit = (F.G == 256) ? ((u0 & 7) * 32 + (u0 >> 3)) : u0;
        const int bh = unit >> 2, dvh = (unit >> 1) & 1, dir = unit & 1, h = bh & 3;
        const float lg2 = __log2f(1.0f - __expf(F.a->in[10][dir * 4 + h]));
        const float gstep = fexp2(dir == 0 ? -lg2 : lg2);
        const float cdec = fexp2(lg2 * 128.0f);
        f32x16 acc;
#pragma unroll
        for (int i = 0; i < 16; ++i) acc[i] = 0.f;
        __syncthreads();
#define P3_STAGE(s_) do { const int s__ = (s_); const bool cx = s__ < 2; const int ci = cx ? (dir == 0 ? s__ : 1 - s__) : (dir == 0 ? s__ - 2 : 17 - s__); \
            const bf16* kb = cx ? KTrc + (size_t)bh * 128 * CTXL + ci * 128 : KTr + (size_t)bh * 128 * TPITCH + ci * 128; \
            const bf16* vb = cx ? VTrc + ((size_t)bh * 128 + dvh * 64) * CTXL + ci * 128 : VTr + ((size_t)bh * 128 + dvh * 64) * TPITCH + ci * 128; \
            const size_t pitch = cx ? (size_t)CTXL : (size_t)TPITCH; \
            _Pragma("unroll") for (int i = 0; i < 6; ++i) { const int idx = (i < 4 ? i : i - 4) * 512 + w * 64 + lane, R = idx >> 4, cc = (idx & 15) ^ (R & 15); \
                dma16((i < 4 ? kb : vb) + (size_t)R * pitch + 8 * cc, F.lds + (s__ % 3) * 49152 + (i * 512 + w * 64) * 16); } } while (0)
        P3_STAGE(0); P3_STAGE(1);
#pragma unroll 1
        for (int s = 0; s < 18; ++s) {
            if (s >= 2) {
                const int c = dir == 0 ? s - 2 : 17 - s;
                bf16* sp = ST + ((((size_t)dir * 64 + bh) * 16 + c) * 128 + dvh * 64 + dvs * 32 + r) * 128 + dkt * 32 + 4 * hh;
#pragma unroll
                for (int g = 0; g < 4; ++g) *(u32x2*)(sp + 8 * g) = (u32x2){pk2(acc[4 * g], acc[4 * g + 1]), pk2(acc[4 * g + 2], acc[4 * g + 3])};
            }
            if (s < 2) asm volatile("s_waitcnt vmcnt(6)" ::: "memory"); else if (s < 17) asm volatile("s_waitcnt vmcnt(10)" ::: "memory"); else asm volatile("s_waitcnt vmcnt(0)" ::: "memory");
            __builtin_amdgcn_s_barrier(); asm volatile("" ::: "memory");
            if (s < 16) P3_STAGE(s + 2);
            if (s < 17) {
#pragma unroll
                for (int i = 0; i < 16; ++i) acc[i] *= cdec;
                const LAS unsigned char* kt = F.lds + (s % 3) * 49152; const LAS unsigned char* vt = kt + 32768;
#pragma unroll
                for (int ks = 0; ks < 8; ++ks) {
                    const bf16x8 af = frag256(kt, 32 * dkt + r, 2 * ks + hh); const bf16x8 vv = frag256(vt, 32 * dvs + r, 2 * ks + hh); bf16x8 bfr;
                    const int tk = 16 * ks + 8 * hh; float wgt = fexp2(lg2 * (float)(dir == 0 ? (127 - tk) : tk));
#pragma unroll
                    for (int j = 0; j < 8; ++j) { bfr[j] = (short)f2bf(bf2f((unsigned short)vv[j]) * wgt); wgt *= gstep; }
                    acc = __builtin_amdgcn_mfma_f32_32x32x16_bf16(af, bfr, acc, 0, 0, 0);
                }
            }
        }
        asm volatile("s_waitcnt vmcnt(0) lgkmcnt(0)" ::: "memory");
        __syncthreads();
#undef P3_STAGE
    }
}

__device__ __forceinline__ void ret_unit(const Ctx& F, int unit) {
    const bf16* P = (const bf16*)(F.ws + WS_P); const bf16* ST = (const bf16*)((const char*)F.H + DO_ST); const bf16* VTr = (const bf16*)(F.ws + WS_VTR); bf16* Y = (bf16*)(F.ws + WS_XA);
    int lane = F.lane; asm volatile("" : "+v"(lane));
    const int li = lane & 15, kq = lane >> 4, w = F.wave;
    const int b = unit >> 6, h = (unit >> 4) & 3, c = unit & 15, bh = b * 4 + h;
    const size_t tok0 = (size_t)b * SEQ + c * 128;
    const int i0 = 16 * w;
    const float lgf = __log2f(1.0f - __expf(F.a->in[10][h])), lgb = __log2f(1.0f - __expf(F.a->in[10][4 + h]));
    constexpr int T_ST0 = 0, T_K = 65536, T_V = 98304;
    __syncthreads();
#pragma unroll
    for (int i = 0; i < 16; ++i) { const int tile = i >> 2; const int idx = (i & 3) * 512 + w * 64 + lane, R = idx >> 4, cc = (idx & 15) ^ (R & 15);
        const bf16* src;
        if (tile < 2) src = ST + ((((size_t)tile * 64 + bh) * 16 + c) * 128 + R) * 128 + 8 * cc;
        else if (tile == 2) src = P + (tok0 + R) * PW + PO_RK + h * 128 + 8 * cc;
        else src = VTr + ((size_t)bh * 128 + R) * TPITCH + c * 128 + 8 * cc;
        dma16(src, F.lds + (i * 512 + w * 64) * 16); }
    bf16x8 qf[4];
    { const bf16* qp = P + (tok0 + i0 + li) * PW + PO_RQ + h * 128 + 8 * kq;
#pragma unroll
      for (int ks = 0; ks < 4; ++ks) qf[ks] = *(const bf16x8*)(qp + 32 * ks); }
    asm volatile("s_waitcnt vmcnt(0)" ::: "memory");
    __syncthreads();
    f32x4 O[8];
#pragma unroll
    for (int dirn = 0; dirn < 2; ++dirn) {
        const LAS unsigned char* tl = F.lds + T_ST0 + dirn * 32768;
        float rs[4];
#pragma unroll
        for (int jj = 0; jj < 4; ++jj) { const int i = i0 + 4 * kq + jj; rs[jj] = dirn == 0 ? fexp2(lgf * (float)(i + 1)) : fexp2(lgb * (float)(128 - i)); }
#pragma unroll
        for (int nt = 0; nt < 8; ++nt) { f32x4 a = (f32x4){0.f, 0.f, 0.f, 0.f};
#pragma unroll
            for (int ks = 0; ks < 4; ++ks) a = __builtin_amdgcn_mfma_f32_16x16x32_bf16(qf[ks], frag256(tl, 16 * nt + li, 4 * ks + kq), a, 0, 0, 0);
#pragma unroll
            for (int jj = 0; jj < 4; ++jj) { const float v = a[jj] * rs[jj]; if (dirn == 0) O[nt][jj] = v; else O[nt][jj] += v; } }
    }
    bf16x8 pf[4];
    const int krow = 8 * (li >> 2) + (li & 3);
#pragma unroll
    for (int u = 0; u < 4; ++u) {
        f32x4 s2[2];
#pragma unroll
        for (int hf = 0; hf < 2; ++hf) { f32x4 a = (f32x4){0.f, 0.f, 0.f, 0.f};
#pragma unroll
            for (int ks = 0; ks < 4; ++ks) a = __builtin_amdgcn_mfma_f32_16x16x32_bf16(frag256(F.lds + T_K, 32 * u + krow + 4 * hf, 4 * ks + kq), qf[ks], a, 0, 0, 0);
#pragma unroll
            for (int jj = 0; jj < 4; ++jj) { const int dlt = (i0 + li) - (32 * u + 8 * kq + 4 * hf + jj);
                const float ex = fexp2((dlt > 0 ? lgf : lgb) * fabsf((float)dlt));
                a[jj] *= (dlt == 0) ? 2.0f : ex; }
            s2[hf] = a; }
#pragma unroll
        for (int e = 0; e < 4; ++e) { pf[u][e] = (short)f2bf(s2[0][e]); pf[u][4 + e] = (short)f2bf(s2[1][e]); }
    }
#pragma unroll
    for (int u = 0; u < 4; ++u)
#pragma unroll
        for (int nt = 0; nt < 8; ++nt) O[nt] = __builtin_amdgcn_mfma_f32_16x16x32_bf16(pf[u], frag256(F.lds + T_V, 16 * nt + li, 4 * u + kq), O[nt], 0, 0, 0);
    __syncthreads();
    LAS float* osc = (LAS float*)(F.lds + w * 8448);
#pragma unroll
    for (int jj = 0; jj < 4; ++jj) {
        float sm = 0.f;
#pragma unroll
        for (int nt = 0; nt < 8; ++nt) sm += O[nt][jj];
        sm += __shfl_xor(sm, 1); sm += __shfl_xor(sm, 2); sm += __shfl_xor(sm, 4); sm += __shfl_xor(sm, 8);
        const float mean = sm * (1.0f / 128.0f); float q = 0.f;
#pragma unroll
        for (int nt = 0; nt < 8; ++nt) { const float d = O[nt][jj] - mean; q += d * d; }
        q += __shfl_xor(q, 1); q += __shfl_xor(q, 2); q += __shfl_xor(q, 4); q += __shfl_xor(q, 8);
        const float rstd = 1.0f / sqrtf(q * (1.0f / 128.0f) + LN_EPS);
#pragma unroll
        for (int nt = 0; nt < 8; ++nt) osc[(4 * kq + jj) * 132 + 16 * nt + li] = (O[nt][jj] - mean) * rstd;
    }
    LDS_WAIT(); asm volatile("" ::: "memory");
#pragma unroll
    for (int i = 0; i < 4; ++i) { const int q = lane + 64 * i, row = q >> 4, ch = q & 15; const size_t tk = tok0 + i0 + row;
        const f32x4 a = *(const LAS f32x4*)(osc + row * 132 + 8 * ch), c2 = *(const LAS f32x4*)(osc + row * 132 + 8 * ch + 4);
        const u32x4 g = *(const u32x4*)(P + tk * PW + PO_RG + h * 128 + 8 * ch);
        u32x4 o;
        o.x = pk2(silu_f(bflo(g.x)) * a.x, silu_f(bfhi(g.x)) * a.y); o.y = pk2(silu_f(bflo(g.y)) * a.z, silu_f(bfhi(g.y)) * a.w);
        o.z = pk2(silu_f(bflo(g.z)) * c2.x, silu_f(bfhi(g.z)) * c2.y); o.w = pk2(silu_f(bflo(g.w)) * c2.z, silu_f(bfhi(g.w)) * c2.w);
        if (ABL & 32) o = (u32x4){0u, 0u, 0u, 0u};
        *(u32x4*)(Y + tk * D + h * 128 + 8 * ch) = o; }
    LDS_WAIT(); asm volatile("" ::: "memory");
}
__device__ __forceinline__ void na_unit(const Ctx& F, int unit, bool load_ctx) {
    const bf16* P = (const bf16*)(F.ws + WS_P); const bf16* Pc = (const bf16*)(F.ws + WS_PC); bf16* Y = (bf16*)(F.ws + WS_XA);
    const bf16* VTn = (const bf16*)(F.ws + WS_VTN); const bf16* VTnc = (const bf16*)(F.ws + WS_VTNC);
    int lane = F.lane; asm volatile("" : "+v"(lane));
    const int li = lane & 15, kq = lane >> 4, w = F.wave;
    const int b = unit >> 7, nh = (unit >> 4) & 7, rp = unit & 15;
    const int r = 2 * rp + (w >> 2), cb = w & 3;
    const int rmin = min(max(2 * rp - 4, 0), GROWS - 8);
    const int r0 = min(max(r - 4, 0), GROWS - 8), kstart = min(max(16 * cb - 8, 0), GRIDW - 32);
    const int qc = 16 * cb + li; const int wstart = min(max(qc - 8, 0), GRIDW - 16);
    const size_t tokb = (size_t)b * SEQ;
    const int krow = 8 * (li >> 2) + (li & 3);
    constexpr int L_CTX = 73728, L_TBL = 106496, L_CTXV = 108544;
    __syncthreads();
#pragma unroll
    for (int i = 0; i < 13; ++i) { const int idx = i * 512 + w * 64 + lane; const bf16* src;
        if (i < 9) { const int R = idx >> 3, cc = (idx & 7) ^ (R & 7); const int kr = min(rmin + (R >> 6), GROWS - 1);
            src = P + (tokb + kr * 64 + (R & 63)) * PW + PO_NK + nh * 64 + 8 * cc; }
        else { if (!load_ctx) continue; const int id2 = idx - 4608, R = id2 >> 3, cc = (id2 & 7) ^ (R & 7); src = Pc + ((size_t)b * CTXL + R) * PCW + nh * 64 + 8 * cc; }
        dma16(src, F.lds + (i * 512 + w * 64) * 16); }
    if (load_ctx) {
#pragma unroll
        for (int i = 0; i < 4; ++i) { const int id2 = i * 512 + w * 64 + lane, Rd = id2 >> 5, cc = (id2 & 31) ^ (Rd & 7);
            dma16(VTnc + ((size_t)(b * 8 + nh) * 64 + Rd) * CTXL + 8 * cc, F.lds + L_CTXV + (i * 512 + w * 64) * 16); } }
    LAS float* tbl = (LAS float*)(F.lds + L_TBL);
    for (int q = F.tid; q < 15 * 32; q += 512) { const int rr = q >> 5, cc = q & 31; tbl[q] = cc < 31 ? F.a->in[11][(size_t)(nh * 15 + rr) * 31 + cc] : -3.0e38f; }
    bf16x8 qf[2];
    { const bf16* qp = P + (tokb + r * 64 + qc) * PW + PO_NQ + nh * 64 + 8 * kq; qf[0] = *(const bf16x8*)qp; qf[1] = *(const bf16x8*)(qp + 32); }
    asm volatile("s_waitcnt vmcnt(0)" ::: "memory");
    __syncthreads();
    f32x4 sw[16], sc[16];
    float mx = -3.0e38f;
#pragma unroll
    for (int wt = 0; wt < 16; ++wt) {
        const int kr = r0 + (wt >> 1);
        f32x4 a;
#pragma unroll
        for (int jj = 0; jj < 4; ++jj) { const int kc = kstart + 8 * kq + 4 * (wt & 1) + jj; const bool ok = (kc >= wstart) && (kc < wstart + 16);
            const int cbi = ok ? (kc - qc + 15) : 31; a[jj] = tbl[(kr - r + 7) * 32 + cbi]; }
        const int R = (kr - rmin) * 64 + kstart + krow + 4 * (wt & 1);
        const LAS unsigned char* rowp = F.lds + R * 128;
        a = __builtin_amdgcn_mfma_f32_16x16x32_bf16(*(const LAS bf16x8*)(rowp + ((kq ^ (R & 7)) << 4)), qf[0], a, 0, 0, 0);
        a = __builtin_amdgcn_mfma_f32_16x16x32_bf16(*(const LAS bf16x8*)(rowp + (((4 + kq) ^ (R & 7)) << 4)), qf[1], a, 0, 0, 0);
#pragma unroll
        for (int jj = 0; jj < 4; ++jj) mx = fmaxf(mx, a[jj]);
        sw[wt] = a;
    }
#pragma unroll
    for (int ct = 0; ct < 16; ++ct) {
        const int R = 32 * (ct >> 1) + krow + 4 * (ct & 1);
        const LAS unsigned char* rowp = F.lds + L_CTX + R * 128;
        f32x4 a = (f32x4){0.f, 0.f, 0.f, 0.f};
        a = __builtin_amdgcn_mfma_f32_16x16x32_bf16(*(const LAS bf16x8*)(rowp + ((kq ^ (R & 7)) << 4)), qf[0], a, 0, 0, 0);
        a = __builtin_amdgcn_mfma_f32_16x16x32_bf16(*(const LAS bf16x8*)(rowp + (((4 + kq) ^ (R & 7)) << 4)), qf[1], a, 0, 0, 0);
#pragma unroll
        for (int jj = 0; jj < 4; ++jj) mx = fmaxf(mx, a[jj]);
        sc[ct] = a;
    }
    __syncthreads();
#pragma unroll
    for (int i = 0; i < 13; ++i) { const int idx = i * 512 + w * 64 + lane; const bf16* src;
        if (i < 9) { const int Rd = idx / 72, q = idx - Rd * 72, cc = q ^ (Rd & 7); const int kr = min(rmin + (cc >> 3), GROWS - 1);
            src = VTn + ((size_t)(b * 8 + nh) * 64 + Rd) * TPITCH + kr * 64 + (cc & 7) * 8; }
        else continue;
        dma16(src, F.lds + (i * 512 + w * 64) * 16); }
    mx = fmaxf(mx, __shfl_xor(mx, 16)); mx = fmaxf(mx, __shfl_xor(mx, 32));
    float sum = 0.f;
#pragma unroll
    for (int wt = 0; wt < 16; ++wt)
#pragma unroll
        for (int jj = 0; jj < 4; ++jj) { const float e = __expf(sw[wt][jj] - mx); sw[wt][jj] = e; sum += e; }
#pragma unroll
    for (int ct = 0; ct < 16; ++ct)
#pragma unroll
        for (int jj = 0; jj < 4; ++jj) { const float e = __expf(sc[ct][jj] - mx); sc[ct][jj] = e; sum += e; }
    sum += __shfl_xor(sum, 16); sum += __shfl_xor(sum, 32);
    asm volatile("s_waitcnt vmcnt(0)" ::: "memory");
    __syncthreads();
    f32x4 O[4];
#pragma unroll
    for (int nt = 0; nt < 4; ++nt) O[nt] = (f32x4){0.f, 0.f, 0.f, 0.f};
#pragma unroll
    for (int u = 0; u < 8; ++u) { bf16x8 pf;
#pragma unroll
        for (int e = 0; e < 4; ++e) { pf[e] = (short)f2bf(sw[2 * u][e]); pf[4 + e] = (short)f2bf(sw[2 * u + 1][e]); }
        const int cch = (r0 + u - rmin) * 8 + (kstart >> 3) + kq;
#pragma unroll
        for (int nt = 0; nt < 4; ++nt) { const int Rd = 16 * nt + li;
            O[nt] = __builtin_amdgcn_mfma_f32_16x16x32_bf16(pf, *(const LAS bf16x8*)(F.lds + Rd * 1152 + ((cch ^ (Rd & 7)) << 4)), O[nt], 0, 0, 0); } }
#pragma unroll
    for (int u = 0; u < 8; ++u) { bf16x8 pf;
#pragma unroll
        for (int e = 0; e < 4; ++e) { pf[e] = (short)f2bf(sc[2 * u][e]); pf[4 + e] = (short)f2bf(sc[2 * u + 1][e]); }
#pragma unroll
        for (int nt = 0; nt < 4; ++nt) { const int Rd = 16 * nt + li;
            O[nt] = __builtin_amdgcn_mfma_f32_16x16x32_bf16(pf, *(const LAS bf16x8*)(F.lds + L_CTXV + Rd * 512 + (((4 * u + kq) ^ (Rd & 7)) << 4)), O[nt], 0, 0, 0); } }
    __syncthreads();
    LAS float* osc = (LAS float*)(F.lds + w * 4352);
#pragma unroll
    for (int jj = 0; jj < 4; ++jj) {
        const float sq = __shfl(sum, 4 * kq + jj); const float inv = 1.0f / sq;
#pragma unroll
        for (int nt = 0; nt < 4; ++nt) osc[(4 * kq + jj) * 68 + 16 * nt + li] = O[nt][jj] * inv;
    }
    LDS_WAIT(); asm volatile("" ::: "memory");
#pragma unroll
    for (int i = 0; i < 2; ++i) { const int q = lane + 64 * i, row = q >> 3, ch = q & 7;
        const f32x4 a = *(const LAS f32x4*)(osc + row * 68 + 8 * ch), c2 = *(const LAS f32x4*)(osc + row * 68 + 8 * ch + 4);
        u32x4 o = (u32x4){pk2(a.x, a.y), pk2(a.z, a.w), pk2(c2.x, c2.y), pk2(c2.z, c2.w)};
        if (ABL & 16) o = (u32x4){0u, 0u, 0u, 0u};
        *(u32x4*)(Y + (tokb + r * 64 + 16 * cb + row) * D + 512 + nh * 64 + 8 * ch) = o; }
    LDS_WAIT(); asm volatile("" ::: "memory");
}
__device__ __forceinline__ void phase4(const Ctx& F) {
#ifndef P4MASK
#define P4MASK 3
#endif
    if (P4MASK & 1) for (int u = F.bid; u < 1024; u += F.G) ret_unit(F, u);
    if (P4MASK & 2) {
        if (F.G == 256) { const int vb = (F.bid & 7) * 32 + (F.bid >> 3);
            for (int k = 0; k < 8; ++k) na_unit(F, vb * 8 + k, k == 0); }
        else for (int u = F.bid; u < 2048; u += F.G) na_unit(F, u, true);
    }
}

struct SchedOut {
    int G, c; const char* Wt;
    __device__ __forceinline__ bool next(int i, g8::Unit& u) const {
        const int L = i * G + c; if (L >= 512) return false;
        int pm, pn; g8::tile_of(L, 128, 4, pm, pn); u.pm = pm; u.pn = pn; u.e = 0; u.aux = 0; u.B = Wt + (size_t)pn * 256 * 1024 * 2; return true; }
    __device__ __forceinline__ unsigned rowoff(const g8::Unit& u, int r) const { return (unsigned)(u.pm * 256 + r) * 2048u; }
};
struct EpiY {
    static constexpr bool IDEMP = true;
    bf16* Yg; const float* gate0; const float* cs; float abl;
    __device__ __forceinline__ void operator()(const f32x4 (&acc)[2][2][4][2], const g8::Unit& u, int wr, int wc, int fr, int fq) const {
        const int row0 = u.pm * 256 + wr * 64 + fr, col0 = u.pn * 256 + wc * 32 + 8 * fq;
        const float* gp = gate0 + (size_t)(row0 >> 11) * 6144 + col0;
        f32x4 gv[2][2];
#pragma unroll
        for (int bj = 0; bj < 2; ++bj)
#pragma unroll
            for (int n = 0; n < 2; ++n) { gv[bj][n] = *(const f32x4*)(gp + bj * 128 + n * 4) * abl; if (cs) gv[bj][n] *= *(const f32x4*)(cs + col0 + bj * 128 + n * 4); }
#pragma unroll
        for (int ai = 0; ai < 2; ++ai)
#pragma unroll
            for (int m = 0; m < 4; ++m) { bf16* rp = Yg + (size_t)(row0 + ai * 128 + m * 16) * D + col0;
#pragma unroll
                for (int bj = 0; bj < 2; ++bj) { const f32x4 v0 = acc[ai][bj][m][0] * gv[bj][0], v1 = acc[ai][bj][m][1] * gv[bj][1];
                    *(u32x4*)(rp + bj * 128) = (u32x4){pk2(v0.x, v0.y), pk2(v0.z, v0.w), pk2(v1.x, v1.y), pk2(v1.z, v1.w)}; } }
    }
};

struct LnVecs { f32x4 lg[4], lb[4], sh[4], sc1[4]; f32x4 br1; };
__device__ __forceinline__ void ln_load(const float* R32, const bf16* R16, const bf16* Yg, int t, int lane, f32x4 (&nr)[4], u32x2 (&ny)[4]) {
    const u32x2* yr = (const u32x2*)(Yg + (size_t)t * D) + lane;
    if (R32) { const float* rr = R32 + (size_t)t * D;
#pragma unroll
        for (int j = 0; j < 4; ++j) nr[j] = *(const f32x4*)(rr + 4 * lane + 256 * j); }
    else { const u32x2* rr = (const u32x2*)(R16 + (size_t)t * D) + lane;
#pragma unroll
        for (int j = 0; j < 4; ++j) { const u32x2 h = rr[64 * j]; nr[j] = (f32x4){bflo(h.x), bfhi(h.x), bflo(h.y), bfhi(h.y)}; } }
#pragma unroll
    for (int j = 0; j < 4; ++j) ny[j] = yr[64 * j];
}
__device__ __forceinline__ void ln_row(const Ctx& F, int l, int t, const f32x4 (&nr)[4], const u32x2 (&ny)[4], const LnVecs& V, LAS f32x4* wl, LAS u32x4* rec_slot) {
    const int lane = F.lane; const LAS float* br2l = (const LAS float*)(F.lds + 149760);
    bf16* hm = (bf16*)(F.ws + WS_XA);
    unsigned long long* hr8 = (unsigned long long*)((bf16*)(F.ws + WS_H16) + (size_t)t * D) + lane;
    f32x4 v[4]; float s = 0.f;
#pragma unroll
    for (int j = 0; j < 4; ++j) { const u32x2 y = ny[j]; v[j] = nr[j] * ALPHA + (f32x4){bflo(y.x), bfhi(y.x), bflo(y.y), bfhi(y.y)}; s += (v[j].x + v[j].y) + (v[j].z + v[j].w); }
    const float mean = wave_sum(s) * (1.0f / D); float s2 = 0.f;
#pragma unroll
    for (int j = 0; j < 4; ++j) { v[j] = v[j] - mean; s2 += (v[j].x * v[j].x + v[j].y * v[j].y) + (v[j].z * v[j].z + v[j].w * v[j].w); }
    const float rstd = 1.0f / sqrtf(wave_sum(s2) * (1.0f / D) + LN_EPS);
    unsigned long long* o8 = (unsigned long long*)(hm + (size_t)t * D) + lane;
    float pg[4] = {0.f, 0.f, 0.f, 0.f};
#pragma unroll
    for (int j = 0; j < 4; ++j) { const int ci = 4 * lane + 256 * j;
        const f32x4 h1 = v[j] * rstd * V.lg[j] + V.lb[j];
        hr8[64 * j] = (unsigned long long)pk2(h1.x, h1.y) | ((unsigned long long)pk2(h1.z, h1.w) << 32);
        const f32x4 m = h1 * V.sc1[j] + V.sh[j];
        v[j] = m;
        o8[64 * j] = (unsigned long long)pk2(m.x, m.y) | ((unsigned long long)pk2(m.z, m.w) << 32);
#pragma unroll
        for (int e = 0; e < 4; ++e) { const f32x4 w = wl[(4 * j + e) * 64 + lane];
#pragma unroll
            for (int g = 0; g < 4; ++g) pg[g] += m[e] * w[g]; } }
    float lgt[4];
#pragma unroll
    for (int g = 0; g < 4; ++g) lgt[g] = wave_sum(pg[g]) + V.br1[g];
    int grp = 0; float gm = lgt[0];
#pragma unroll
    for (int g = 1; g < 4; ++g) if (lgt[g] > gm) { gm = lgt[g]; grp = g; }
    float gs = 0.f;
#pragma unroll
    for (int g = 0; g < 4; ++g) gs += __expf(lgt[g] - gm);
    const float gate_g = 1.0f / gs;
    float pe[8] = {0.f, 0.f, 0.f, 0.f, 0.f, 0.f, 0.f, 0.f};
#pragma unroll
    for (int j = 0; j < 4; ++j) {
#pragma unroll
        for (int e = 0; e < 4; ++e) { const f32x4 wa = wl[1024 + 2048 * grp + ((4 * j + e) * 2) * 64 + lane], wb = wl[1024 + 2048 * grp + ((4 * j + e) * 2 + 1) * 64 + lane];
#pragma unroll
            for (int q = 0; q < 4; ++q) { pe[q] += v[j][e] * wa[q]; pe[4 + q] += v[j][e] * wb[q]; } } }
    float le[8];
    {
        float a4[4], a2[2], a1;
#pragma unroll
        for (int q = 0; q < 4; ++q) { const float mine = (lane & 1) ? pe[q + 4] : pe[q], send = (lane & 1) ? pe[q] : pe[q + 4]; a4[q] = mine + __shfl_xor(send, 1); }
#pragma unroll
        for (int q = 0; q < 2; ++q) { const float mine = (lane & 2) ? a4[q + 2] : a4[q], send = (lane & 2) ? a4[q] : a4[q + 2]; a2[q] = mine + __shfl_xor(send, 2); }
        { const float mine = (lane & 4) ? a2[1] : a2[0], send = (lane & 4) ? a2[0] : a2[1]; a1 = mine + __shfl_xor(send, 4); }
        a1 += __shfl_xor(a1, 8); a1 += __shfl_xor(a1, 16); a1 += __shfl_xor(a1, 32);
#pragma unroll
        for (int q = 0; q < 8; ++q) { const int src = ((q >> 2) & 1) | (((q >> 1) & 1) << 1) | ((q & 1) << 2); le[q] = __shfl(a1, src) + br2l[grp * 8 + q]; }

    }
    int i0 = 0; float v0 = le[0];
#pragma unroll
    for (int q = 1; q < 8; ++q) if (le[q] > v0) { v0 = le[q]; i0 = q; }
    int i1 = -1; float v1 = -3.0e38f;
#pragma unroll
    for (int q = 0; q < 8; ++q) if (q != i0 && le[q] > v1) { v1 = le[q]; i1 = q; }
    const float e1 = __expf(v1 - v0); const float w0 = (ABL & 128) ? 0.f : gate_g / (1.0f + e1), w1 = (ABL & 1024) ? 1.0f : ((ABL & 64) ? 0.f : gate_g * e1 / (1.0f + e1));
    if (lane == 0) *rec_slot = (u32x4){(unsigned)(grp * 8 + i0), (unsigned)(grp * 8 + i1), __builtin_bit_cast(unsigned, w0), __builtin_bit_cast(unsigned, w1)};
}
__device__ __forceinline__ void phase_ln_router(const Ctx& F, int l, const float* R32, const bf16* Yg) {
    const bf16* R16 = (const bf16*)(F.ws + WS_H16);
    const int gw = F.bid * 8 + F.wave, lane = F.lane;
    int* tokinfo = (int*)(F.ws + WS_TOKINFO); int* list = (int*)(F.ws + WS_LIST);
    unsigned* cnt = (unsigned*)(F.ws + WS_CTL) + CW_CNT + 64 * (l * 32);
    LAS f32x4* wl = (LAS f32x4*)F.lds;
    __syncthreads();
    for (int k = F.tid; k < 1024; k += 512) { const int ln = (k & 255) >> 2, e = k & 3, j = k >> 8;
        wl[(4 * j + e) * 64 + ln] = *(const f32x4*)(F.a->in[14] + ((size_t)l * D + k) * 4);
#pragma unroll
        for (int g = 0; g < 4; ++g)
#pragma unroll
            for (int q = 0; q < 2; ++q) wl[1024 + 2048 * g + ((4 * j + e) * 2 + q) * 64 + ln] = *(const f32x4*)(F.a->in[16] + (((size_t)l * 4 + g) * D + k) * 8 + 4 * q); }
    if (F.tid < 32) ((LAS float*)(F.lds + 149760))[F.tid] = F.a->in[17][l * 32 + F.tid];
    __syncthreads();
    LAS u32x4* recs = (LAS u32x4*)(F.lds + 147456);
    const int t_lo = gw * 16;
    for (int tb = t_lo; tb < T; tb += F.G * 8 * 16) {
        const int b = tb >> 11;
        LnVecs V;
#pragma unroll
        for (int j = 0; j < 4; ++j) { const int ci = 4 * lane + 256 * j;
            V.lg[j] = *(const f32x4*)(F.a->in[6] + (l * 2 + 0) * D + ci); V.lb[j] = *(const f32x4*)(F.a->in[7] + (l * 2 + 0) * D + ci);
            V.sh[j] = *(const f32x4*)(modp(F, l, b, 3) + ci); V.sc1[j] = *(const f32x4*)(modp(F, l, b, 4) + ci) + 1.0f; }
        V.br1 = *(const f32x4*)(F.a->in[15] + l * 4);
        f32x4 rA[4], rB[4]; u32x2 yA[4], yB[4];
        ln_load(R32, R16, Yg, tb, lane, rA, yA);
#pragma unroll 1
        for (int k = 0; k < 16; k += 2) {
            ln_load(R32, R16, Yg, tb + k + 1, lane, rB, yB);
            asm volatile("" ::: "memory");
            ln_row(F, l, tb + k, rA, yA, V, wl, recs + F.wave * 16 + k);
            if (k + 2 < 16) ln_load(R32, R16, Yg, tb + k + 2, lane, rA, yA);
            asm volatile("" ::: "memory");
            ln_row(F, l, tb + k + 1, rB, yB, V, wl, recs + F.wave * 16 + k + 1);
        }
        LAS int* lcnt = (LAS int*)(F.lds + 149504);
        __syncthreads();
        if (F.tid < 64) lcnt[F.tid] = 0;
        __syncthreads();
        int e = 0, lp = 0; unsigned wa = 0u, wb = 0u; const int which = F.tid & 1;
        const int r = F.tid >> 1; const int t = (tb - F.wave * 16) + r;
        if (F.tid < 256) { const u32x4 rec = recs[r]; e = which ? (int)rec.y : (int)rec.x; wa = rec.z; wb = rec.w;
            lp = __hip_atomic_fetch_add(&lcnt[e], 1, __ATOMIC_RELAXED, __HIP_MEMORY_SCOPE_WORKGROUP); }
        __syncthreads();
        if (F.tid < 32) lcnt[32 + F.tid] = (int)atomicAdd(cnt + 64 * F.tid, (unsigned)lcnt[F.tid]);
        __syncthreads();
        if (F.tid < 256) { const int pos = lcnt[32 + e] + lp;
            list[(size_t)e * LISTCAP + pos] = t;
            int* ti = tokinfo + (size_t)t * 8;
            *(u32x2*)(ti + 2 * which) = (u32x2){(unsigned)e, (unsigned)pos};
            if (which == 0) *(u32x2*)(ti + 4) = (u32x2){wa, wb}; }
    }
}

__device__ __forceinline__ void moe_table(const Ctx& F, int l) {
    LAS int* tab = (LAS int*)(F.lds + LDS_TAB_OFF);
    __syncthreads();
    if (F.tid < 32) tab[40 + F.tid] = (int)__hip_atomic_load((unsigned*)(F.ws + WS_CTL) + CW_CNT + 64 * (l * 32 + F.tid), __ATOMIC_RELAXED, __HIP_MEMORY_SCOPE_AGENT);
    __syncthreads();
    if (F.tid == 0) { int s = 0; for (int e = 0; e < 32; ++e) { tab[e] = s; s += (tab[40 + e] + 255) >> 8; } tab[32] = s; }
    __syncthreads();
}
__device__ __forceinline__ int moe_vc(int c, int G) { return (G == 256) ? (((c & 7) * 8 + (c >> 5)) * 4 + ((c >> 3) & 3)) : c; }
struct SchedMoe {
    int G, c; const char* Wt; size_t wstride; size_t pnstride; const LAS int* tab; const LAS int* tokl; int gather; unsigned lda2;
    __device__ __forceinline__ bool next(int i, g8::Unit& u) const {
        const int L = i * G + moe_vc(c, G); const int nrt = __builtin_amdgcn_readfirstlane(tab[32]); if (L >= 4 * nrt) return false;
        const int rt = L >> 2, pn = L & 3; int e = 0;
        for (int q = 1; q < 32; ++q) e = (tab[q] <= rt) ? q : e;
        e = __builtin_amdgcn_readfirstlane(e);
        u.pm = rt; u.pn = pn; u.e = e; u.aux = i; u.B = Wt + (size_t)e * wstride + (size_t)pn * pnstride; return true; }
    __device__ __forceinline__ unsigned rowoff(const g8::Unit& u, int r) const {
        if (gather) return (unsigned)tokl[u.aux * 256 + r] * lda2;
        return (unsigned)(u.pm * 256 + r) * lda2; }
};
constexpr int MOE_MAXU = 8, LDS_TOKL_OFF = LDSCTL_OFF + 1024;
static_assert(LDS_TOKL_OFF + MOE_MAXU * 256 * 4 <= LDS_BYTES && LDS_SCR_OFF + 8 * 2304 <= LDSCTL_OFF, "LDS map");
__device__ __forceinline__ void moe_tokl(const Ctx& F) {
    const LAS int* tab = (const LAS int*)(F.lds + LDS_TAB_OFF); LAS int* tokl = (LAS int*)(F.lds + LDS_TOKL_OFF);
    const int* list = (const int*)(F.ws + WS_LIST);
    for (int q = F.tid; q < MOE_MAXU * 256; q += 512) { const int i = q >> 8, r = q & 255; const int L = i * F.G + moe_vc(F.bid, F.G); int tk = 0;
        if (L < 4 * tab[32]) { const int rt = L >> 2; int e = 0; for (int k = 1; k < 32; ++k) e = (tab[k] <= rt) ? k : e;
            const int idx = (rt - tab[e]) * 256 + r; tk = list[(size_t)e * LISTCAP + (idx < tab[40 + e] ? idx : 0)]; }
        tokl[q] = tk; }
    __syncthreads();
}
struct EpiAct {
    bf16* act;
    __device__ __forceinline__ void operator()(const f32x4 (&acc)[2][2][4][2], const g8::Unit& u, int wr, int wc, int fr, int fq) const {
        const int row0 = u.pm * 256 + wr * 64 + fr, col0 = u.pn * 128 + wc * 32 + 8 * fq;
#pragma unroll
        for (int ai = 0; ai < 2; ++ai)
#pragma unroll
            for (int m = 0; m < 4; ++m) { bf16* rp = act + (size_t)(row0 + ai * 128 + m * 16) * HID + col0;
                const f32x4 g0 = acc[ai][0][m][0], u0 = acc[ai][0][m][1], g1 = acc[ai][1][m][0], u1 = acc[ai][1][m][1];
                *(u32x4*)rp = (u32x4){pk2(silu_f(g0.x) * u0.x, silu_f(g0.y) * u0.y), pk2(silu_f(g0.z) * u0.z, silu_f(g0.w) * u0.w),
                                      pk2(silu_f(g1.x) * u1.x, silu_f(g1.y) * u1.y), pk2(silu_f(g1.z) * u1.z, silu_f(g1.w) * u1.w)}; }
    }
};
struct EpiEo {
    bf16* eo;
    __device__ __forceinline__ void operator()(const f32x4 (&acc)[2][2][4][2], const g8::Unit& u, int wr, int wc, int fr, int fq) const {
        const int row0 = u.pm * 256 + wr * 64 + fr, col0 = u.pn * 256 + wc * 32 + 8 * fq;
#pragma unroll
        for (int ai = 0; ai < 2; ++ai)
#pragma unroll
            for (int m = 0; m < 4; ++m) { bf16* rp = eo + (size_t)(row0 + ai * 128 + m * 16) * D + col0;
#pragma unroll
                for (int bj = 0; bj < 2; ++bj) { const f32x4 v0 = acc[ai][bj][m][0], v1 = acc[ai][bj][m][1];
                    *(u32x4*)(rp + bj * 128) = (u32x4){pk2(v0.x, v0.y), pk2(v0.z, v0.w), pk2(v1.x, v1.y), pk2(v1.z, v1.w)}; } }
    }
};

struct CmbRow { u32x2 h[4]; u32x2 ea[4], eb[4]; };
__device__ __forceinline__ void cmb_load(const Ctx& F, const LAS int* tab, int t, const u32x4& ti, CmbRow& r) {
    const unsigned e0i = ti.x, p0i = ti.y, e1i = ti.z, p1i = ti.w;
    const size_t s0 = (size_t)tab[e0i] * 256 + p0i, s1 = (size_t)tab[e1i] * 256 + p1i;
    const bf16* eo = (const bf16*)(F.ws + WS_EO);
    const u32x2* e0 = (const u32x2*)(eo + s0 * D) + F.lane; const u32x2* e1 = (const u32x2*)(eo + s1 * D) + F.lane; const u32x2* hp = (const u32x2*)((const bf16*)(F.ws + WS_H16) + (size_t)t * D) + F.lane;
#pragma unroll
    for (int j = 0; j < 4; ++j) { r.ea[j] = e0[64 * j]; r.eb[j] = e1[64 * j]; r.h[j] = hp[64 * j]; }
}
__device__ __forceinline__ void cmb_row(const Ctx& F, int l, int t, const CmbRow& r, const u32x2& tw, const f32x4 (&gt)[4], const f32x4 (&lg)[4], const f32x4 (&lb)[4]) {
    const float ab = ((ABL >> (1 + 2 * l)) & 1) ? 0.f : 1.f;
    const unsigned twx = tw.x, twy = tw.y;
    const float w0 = ab * __uint_as_float(twx), w1 = ab * __uint_as_float(twy);
    f32x4 v[4]; float s = 0.f;
#pragma unroll
    for (int j = 0; j < 4; ++j) { const u32x2 a = r.ea[j], c2 = r.eb[j];
        f32x4 y; y.x = w0 * bflo(a.x) + w1 * bflo(c2.x); y.y = w0 * bfhi(a.x) + w1 * bfhi(c2.x); y.z = w0 * bflo(a.y) + w1 * bflo(c2.y); y.w = w0 * bfhi(a.y) + w1 * bfhi(c2.y);
        const u32x2 hh = r.h[j]; v[j] = (f32x4){bflo(hh.x), bfhi(hh.x), bflo(hh.y), bfhi(hh.y)} * ALPHA + gt[j] * y; s += (v[j].x + v[j].y) + (v[j].z + v[j].w); }
    const float mean = wave_sum(s) * (1.0f / D); float s2 = 0.f;
#pragma unroll
    for (int j = 0; j < 4; ++j) { v[j] = v[j] - mean; s2 += (v[j].x * v[j].x + v[j].y * v[j].y) + (v[j].z * v[j].z + v[j].w * v[j].w); }
    const float rstd = 1.0f / sqrtf(wave_sum(s2) * (1.0f / D) + LN_EPS);
    if (l == 1) { float* hr = F.H + (size_t)t * D;
#pragma unroll
        for (int j = 0; j < 4; ++j) *(f32x4*)(hr + 4 * F.lane + 256 * j) = v[j] * rstd * lg[j] + lb[j]; }
    else { unsigned long long* hr8 = (unsigned long long*)((bf16*)(F.ws + WS_H16) + (size_t)t * D) + F.lane;
#pragma unroll
        for (int j = 0; j < 4; ++j) { const f32x4 o = v[j] * rstd * lg[j] + lb[j]; hr8[64 * j] = (unsigned long long)pk2(o.x, o.y) | ((unsigned long long)pk2(o.z, o.w) << 32); } }
}
__device__ __forceinline__ void phase_combine(const Ctx& F, int l) {
    moe_table(F, l);
    const LAS int* tab = (const LAS int*)(F.lds + LDS_TAB_OFF);
    const int gw = F.bid * 8 + F.wave, lane = F.lane;
    const int* tokinfo = (const int*)(F.ws + WS_TOKINFO);
    for (int tb = gw * 16; tb < T; tb += F.G * 8 * 16) {
        const int b = tb >> 11;
        f32x4 gt[4], lg[4], lb[4];
#pragma unroll
        for (int j = 0; j < 4; ++j) { const int ci = 4 * lane + 256 * j; gt[j] = *(const f32x4*)(modp(F, l, b, 5) + ci);
            lg[j] = *(const f32x4*)(F.a->in[6] + (l * 2 + 1) * D + ci); lb[j] = *(const f32x4*)(F.a->in[7] + (l * 2 + 1) * D + ci); }
        u32x4 tiv = (u32x4){0u, 0u, 0u, 0u}; u32x2 twv = (u32x2){0u, 0u};
        if (lane < 16) { tiv = *(const u32x4*)(tokinfo + (size_t)(tb + lane) * 8); twv = *(const u32x2*)(tokinfo + (size_t)(tb + lane) * 8 + 4); }
#define CMB_TI(k_) ((u32x4){(unsigned)__shfl((int)tiv.x, (k_)), (unsigned)__shfl((int)tiv.y, (k_)), (unsigned)__shfl((int)tiv.z, (k_)), (unsigned)__shfl((int)tiv.w, (k_))})
#define CMB_TW(k_) ((u32x2){(unsigned)__shfl((int)twv.x, (k_)), (unsigned)__shfl((int)twv.y, (k_))})
        CmbRow A, B;
        cmb_load(F, tab, tb, CMB_TI(0), A);
#pragma unroll 1
        for (int k = 0; k < 16; k += 2) {
            cmb_load(F, tab, tb + k + 1, CMB_TI(k + 1), B);
            asm volatile("" ::: "memory");
            cmb_row(F, l, tb + k, A, CMB_TW(k), gt, lg, lb);
            if (k + 2 < 16) cmb_load(F, tab, tb + k + 2, CMB_TI(k + 2), A);
            asm volatile("" ::: "memory");
            cmb_row(F, l, tb + k + 1, B, CMB_TW(k + 1), gt, lg, lb);
        }
#undef CMB_TI
#undef CMB_TW
    }
}

template <int WH> __device__ __forceinline__ void pool_item(const Ctx& F, bf16* zp, int b, int p0, int ch) {
    const bf16* hb = (const bf16*)(F.ws + WS_H16) + (size_t)b * SEQ * D + ch;
    const f32x4 sc1 = *(const f32x4*)(modp(F, 1, b, 1) + ch) + 1.0f;
    u32x2 rw[8 + 2 * WH];
#pragma unroll
    for (int i = 0; i < 8 + 2 * WH; ++i) { const int p = p0 - WH + i; const bool ok = (p >= 0) && (p < SEQ); const u32x2 v = *(const u32x2*)(hb + (size_t)(ok ? p : p0) * D); rw[i] = ok ? v : (u32x2){0u, 0u}; }
#define PZ_ROW(i_) ((f32x4){bflo(rw[i_].x), bfhi(rw[i_].x), bflo(rw[i_].y), bfhi(rw[i_].y)})
    f32x4 sum = (f32x4){0.f, 0.f, 0.f, 0.f};
#pragma unroll
    for (int i = 0; i < 2 * WH; ++i) sum += PZ_ROW(i);
#pragma unroll
    for (int j = 0; j < 8; ++j) { const int p = p0 + j; const int cnt = min(p + WH, SEQ) - max(p - WH, 0);
        const f32x4 z = (sum * (1.0f / (float)cnt) - PZ_ROW(j + WH)) * sc1;
        *(u32x2*)(zp + ((size_t)b * SEQ + p) * D + ch) = (u32x2){pk2(z.x, z.y), pk2(z.z, z.w)};
        sum += PZ_ROW(j + 2 * WH) - PZ_ROW(j); }
#undef PZ_ROW
}
__device__ __forceinline__ void phase_pool(const Ctx& F) {
    bf16* zp = (bf16*)(F.ws + WS_XA);
    for (int item = F.bid * 512 + F.tid; item < 4096 * 256; item += F.G * 512) {
        const int strip = item >> 8, ct = item & 255, b = strip >> 8, p0 = (strip & 255) * 8, ch = 4 * ct;
        const int g = __builtin_amdgcn_readfirstlane(ct >> 6);
        if (g == 0) pool_item<1>(F, zp, b, p0, ch); else if (g == 1) pool_item<2>(F, zp, b, p0, ch); else if (g == 2) pool_item<4>(F, zp, b, p0, ch); else pool_item<8>(F, zp, b, p0, ch);
    }
}
struct SchedPool {
    int G, c; const char* Wt;
    __device__ __forceinline__ bool next(int i, g8::Unit& u) const {
        const int L = i * G + c; if (L >= 512) return false;
        int pm, pn; g8::tile_of(L, 128, 4, pm, pn); u.pm = pm; u.pn = pn; u.e = 0; u.aux = 0; u.B = Wt + (size_t)pn * 256 * 256 * 2; return true; }
    __device__ __forceinline__ unsigned rowoff(const g8::Unit& u, int r) const { return (unsigned)(u.pm * 256 + r) * 2048u + (unsigned)u.pn * 512u; }
};

__global__ void __launch_bounds__(512, 2) mk_fwd(Args args) {
    extern __shared__ __attribute__((aligned(16))) unsigned char lds_raw[];
    Ctx F;
    F.lds = (LAS unsigned char*)lds_raw;
    F.tid = threadIdx.x; F.lane = F.tid & 63; F.wave = __builtin_amdgcn_readfirstlane(F.tid >> 6); F.G = gridDim.x; F.bid = blockIdx.x;
    F.a = (KArgs)__builtin_amdgcn_kernarg_segment_ptr();
    F.H = args.out; F.ws = args.ws;
    for (int u = F.tid; u < (LDS_BYTES - LDSCTL_OFF) / 4; u += 512) ((LAS unsigned*)(F.lds + LDSCTL_OFF))[u] = 0u;
    __syncthreads();
    XcdBarrier bar; bar.bar = (unsigned*)(F.ws + WS_CTL) + CW_BAR; bar.x = 0; bar.st = nullptr;
    if (MK_N_LAUNCHES == 1) bar = xcd_barrier_post((unsigned*)(F.ws + WS_CTL) + CW_BAR, (volatile LAS unsigned*)(F.lds + LDSCTL_OFF));
    const int lo = args.ph_lo, hi = args.ph_hi;
#ifndef PHMASK
#define PHMASK 0xFFFF
#endif
#define IN(k) (((PHMASK >> (k)) & 1) && lo <= (k) && (k) < hi)
#define FRESH() do { asm volatile("" : "+s"(F.a)); } while (0)
#define SEAM(k) do { if (IN(k) && IN((k) + 1)) xcd_barrier(bar); } while (0)

    if (IN(0)) { FRESH(); phase0(F); if (RPT & 1) { __syncthreads(); phase0(F); } } SEAM(0);
    if (IN(1)) { FRESH(); phase1(F); if (RPT & 2) { __syncthreads(); phase1(F); } } SEAM(1);
    if (IN(2)) { FRESH();
        if (F.G == 256) {
            if (F.bid < 256 - DEDICATED_CV) {
                SchedIn S{256 - DEDICATED_CV, F.bid, (const char*)(F.ws + WS_WIN)};
                EpiIn E{F.ws, (unsigned char*)F.H, F.lds};
                g8::gemm_phase(F.lds, (const char*)(F.ws + WS_XA), 1024, S, E);
                convert_range(F, F.bid - 128, (256 - DEDICATED_CV) - 128, I_E1 + 1792, I_E1 + 10240);
            } else convert_range(F, F.bid - (256 - DEDICATED_CV), DEDICATED_CV, 0, I_E1 + 1792);
        } else {
            SchedIn S{F.G, F.bid, (const char*)(F.ws + WS_WIN)};
            EpiIn E{F.ws, (unsigned char*)F.H, F.lds};
            g8::gemm_phase(F.lds, (const char*)(F.ws + WS_XA), 1024, S, E);
        }
    } SEAM(2);
    if (IN(3)) { FRESH(); phase3(F); if (RPT & 8) { __syncthreads(); phase3(F); } } SEAM(3);
    if (IN(4)) { FRESH(); phase4(F); if (RPT & 16) { __syncthreads(); phase4(F); } } SEAM(4);
    if (IN(5)) { FRESH();
        SchedOut S{F.G, F.bid, (const char*)(F.ws + WS_WOUT)};
        EpiY E{(bf16*)(F.ws + WS_P), modp(F, 0, 0, 2), nullptr, (ABL & 1) ? 0.f : 1.f};
        g8::gemm_phase(F.lds, (const char*)(F.ws + WS_XA), 1024, S, E); if ((RPT >> 5) & 1) { __syncthreads(); g8::gemm_phase(F.lds, (const char*)(F.ws + WS_XA), 1024, S, E); }
    } SEAM(5);
    if (IN(6)) { FRESH(); phase_ln_router(F, 0, F.a->in[0], (const bf16*)(F.ws + WS_P)); } SEAM(6);
    if (IN(7)) { FRESH();
        moe_table(F, 0); moe_tokl(F);
        SchedMoe S{F.G, F.bid, (const char*)(F.ws + WS_WGU), (size_t)1024 * 1024 * 2, (size_t)256 * 1024 * 2, (const LAS int*)(F.lds + LDS_TAB_OFF), (const LAS int*)(F.lds + LDS_TOKL_OFF), 1, 2048u};
        EpiAct E{(bf16*)(F.ws + WS_ACT)};
        g8::gemm_phase(F.lds, (const char*)(F.ws + WS_XA), 1024, S, E);
        convert_tail(F, moe_vc(F.bid, F.G), (4 * ((const LAS int*)(F.lds + LDS_TAB_OFF))[32]) % 256, I_E1 + 10240, I_E1 + 20480); if ((RPT >> 7) & 1) { __syncthreads(); g8::gemm_phase(F.lds, (const char*)(F.ws + WS_XA), 1024, S, E); }
    } SEAM(7);
    if (IN(8)) { FRESH();
        moe_table(F, 0);
        SchedMoe S{F.G, F.bid, (const char*)(F.ws + WS_WDN), (size_t)1024 * 512 * 2, (size_t)256 * 512 * 2, (const LAS int*)(F.lds + LDS_TAB_OFF), (const LAS int*)(F.lds + LDS_TOKL_OFF), 0, 1024u};
        EpiEo E{(bf16*)(F.ws + WS_EO)};
        g8::gemm_phase(F.lds, (const char*)(F.ws + WS_ACT), 512, S, E);
        convert_tail(F, moe_vc(F.bid, F.G), (4 * ((const LAS int*)(F.lds + LDS_TAB_OFF))[32]) % 256, I_E1 + 20480, 2 * I_E1); if ((RPT >> 8) & 1) { __syncthreads(); g8::gemm_phase(F.lds, (const char*)(F.ws + WS_ACT), 512, S, E); }
    } SEAM(8);
    if (IN(9)) { FRESH(); phase_combine(F, 0); } SEAM(9);
    if (IN(10)) { FRESH(); phase_pool(F); if (RPT & 1024) { __syncthreads(); phase_pool(F); } } SEAM(10);
    if (IN(11)) { FRESH();
        SchedPool S{F.G, F.bid, (const char*)(F.ws + WS_WPOOL)};
        EpiY E{(bf16*)(F.ws + WS_ACT), modp(F, 1, 0, 2), F.a->in[13], (ABL & 4) ? 0.f : 1.f};
        g8::gemm_phase(F.lds, (const char*)(F.ws + WS_XA), 256, S, E);
    } SEAM(11);
    if (IN(12)) { FRESH(); phase_ln_router(F, 1, nullptr, (const bf16*)(F.ws + WS_ACT)); } SEAM(12);
    if (IN(13)) { FRESH();
        moe_table(F, 1); moe_tokl(F);
        SchedMoe S{F.G, F.bid, (const char*)(F.ws + WS_WGU) + (size_t)32 * 1024 * 1024 * 2, (size_t)1024 * 1024 * 2, (size_t)256 * 1024 * 2, (const LAS int*)(F.lds + LDS_TAB_OFF), (const LAS int*)(F.lds + LDS_TOKL_OFF), 1, 2048u};
        EpiAct E{(bf16*)(F.ws + WS_ACT)};
        g8::gemm_phase(F.lds, (const char*)(F.ws + WS_XA), 1024, S, E);
    } SEAM(13);
    if (IN(14)) { FRESH();
        moe_table(F, 1);
        SchedMoe S{F.G, F.bid, (const char*)(F.ws + WS_WDN) + (size_t)32 * 1024 * 512 * 2, (size_t)1024 * 512 * 2, (size_t)256 * 512 * 2, (const LAS int*)(F.lds + LDS_TAB_OFF), (const LAS int*)(F.lds + LDS_TOKL_OFF), 0, 1024u};
        EpiEo E{(bf16*)(F.ws + WS_EO)};
        g8::gemm_phase(F.lds, (const char*)(F.ws + WS_ACT), 512, S, E);
    } SEAM(14);
    if (IN(15)) { FRESH(); phase_combine(F, 1); }
#undef IN
#undef SEAM
}

extern "C" void kernel_launch(void* const* d_in, const int* in_sizes, int n_in, void* d_out, int out_size, void* d_ws, size_t ws_size, hipStream_t stream) {
    static int grid = 0;
    if (grid == 0) {
        if (n_in != 21 || in_sizes[0] != T * D || out_size != T * D || ws_size < WS_END) { fprintf(stderr, "kernel_launch: unexpected shapes (n_in %d, ws %zu); nothing launched\n", n_in, ws_size); grid = -1; return; }
        int dev = 0, cus = 0, per_cu = 0;
        if (hipGetDevice(&dev) != hipSuccess || hipDeviceGetAttribute(&cus, hipDeviceAttributeMultiprocessorCount, dev) != hipSuccess) { grid = -1; return; }
        if (hipFuncSetAttribute((const void*)mk_fwd, hipFuncAttributeMaxDynamicSharedMemorySize, LDS_BYTES) != hipSuccess) { fprintf(stderr, "kernel_launch: hipFuncSetAttribute failed\n"); grid = -1; return; }
        if (hipOccupancyMaxActiveBlocksPerMultiprocessor(&per_cu, (const void*)mk_fwd, 512, LDS_BYTES) != hipSuccess || per_cu < 1) { fprintf(stderr, "kernel_launch: occupancy query reports %d\n", per_cu); }
        (void)hipGetLastError();
        grid = cus;
    }
    if (grid < 0) return;
    if (hipMemsetAsync((char*)d_ws + WS_CTL, 0, CTL_ZERO_BYTES, stream) != hipSuccess) return;
    Args a{};
    for (int i = 0; i < 21; ++i) a.in[i] = (const float*)d_in[i];
    a.out = (float*)d_out; a.ws = (unsigned char*)d_ws;
    if (MK_N_LAUNCHES == 1) { a.ph_lo = 0; a.ph_hi = NPHASE; hipLaunchKernelGGL(mk_fwd, dim3(grid), dim3(512), LDS_BYTES, stream, a); }
    else for (int p = 0; p < NPHASE; ++p) { a.ph_lo = p; a.ph_hi = p + 1; hipLaunchKernelGGL(mk_fwd, dim3(grid), dim3(512), LDS_BYTES, stream, a); }
}
```

```cpp
#include <hip/hip_runtime.h>
#include <cstdio>
#include <cstdint>

#ifndef ABL
#define ABL 0
#endif
#ifndef RPT
#define RPT 0
#endif
#ifndef MK_N_LAUNCHES
#define MK_N_LAUNCHES 1
#endif

#define GAS __attribute__((address_space(1)))
#define LAS __attribute__((address_space(3)))
typedef unsigned short bf16;
typedef short bf16x8 __attribute__((ext_vector_type(8)));
typedef float f32x4 __attribute__((ext_vector_type(4)));
typedef float f32x16 __attribute__((ext_vector_type(16)));
typedef unsigned u32x4 __attribute__((ext_vector_type(4)));
typedef unsigned u32x2 __attribute__((ext_vector_type(2)));

constexpr int D = 1024, NB = 16, SEQ = 2048, T = NB * SEQ, CTXL = 256, TC = NB * CTXL;
constexpr int GRIDW = 64, GROWS = SEQ / GRIDW;
constexpr int OFF_RK = 0, OFF_RV = 512, OFF_NK = 1024, OFF_NV = 1536, KV_COLS = 2048, OFF_RQ = 2048, OFF_RG = 2560, OFF_NQ = 3072, IN_COLS = 3584;
constexpr int NEXP = 32, HID = 512, LISTCAP = T;
constexpr int MAXSLOT = 73728;
constexpr float LN_EPS = 1e-5f;
constexpr float ALPHA = 1.41421356237309515f;
constexpr int NPHASE = 16;

constexpr size_t MiB = 1u << 20;
constexpr size_t WS_CTL = 0, CTL_ZERO_BYTES = 128 * 1024;
constexpr size_t WS_MOD = 1 * MiB;
constexpr size_t WS_TOKINFO = 2 * MiB;
constexpr size_t WS_LIST = 3 * MiB;
constexpr size_t WS_WIN = 8 * MiB, WS_WOUT = 15 * MiB, WS_WPOOL = 17 * MiB, WS_WGU = 18 * MiB, WS_WDN = 146 * MiB;
constexpr size_t WS_XA = 210 * MiB;
constexpr size_t WS_P = 282 * MiB;
constexpr size_t WS_ACT = 282 * MiB, WS_EO = 354 * MiB;
constexpr int TPITCH = SEQ + 64;
constexpr size_t WS_VTR = 446 * MiB, WS_VTRC = 480 * MiB;
constexpr size_t WS_VTN = 484 * MiB, WS_VTNC = 518 * MiB;
constexpr size_t WS_PC = 522 * MiB;
constexpr size_t WS_H16 = 526 * MiB;
constexpr size_t WS_END = 590 * MiB;
constexpr size_t DO_ST = 0;
constexpr size_t DO_KTR = 64 * MiB, DO_KTRC = 98 * MiB;
constexpr int PW = 2624, PO_RK = 0, PO_NK = 512, PO_RQ = 1024, PO_RG = 1536, PO_NQ = 2048, PCW = 512;
static_assert(WS_EO + (size_t)MAXSLOT * 1024 * 2 <= 498 * MiB && WS_ACT + (size_t)MAXSLOT * 512 * 2 <= WS_EO, "ws map");
static_assert(WS_P + (size_t)T * PW * 2 <= WS_VTR && WS_VTR + (size_t)64 * 128 * TPITCH * 2 <= WS_VTRC && WS_VTN + (size_t)128 * 64 * TPITCH * 2 <= WS_VTNC && DO_KTR + (size_t)64 * 128 * TPITCH * 2 <= DO_KTRC && WS_XA + (size_t)(T + TC) * D * 2 <= WS_P, "ws map");
constexpr int CW_BAR = 4096, XCD_BAR_WORDS_C = 3456;
constexpr int CW_CNT = 16384;
static_assert((CW_CNT + 64 * 64) * 4 <= (int)CTL_ZERO_BYTES && (CW_BAR + XCD_BAR_WORDS_C) * 4 <= (int)CTL_ZERO_BYTES, "ctl words inside the memset");

constexpr int RING_BYTES = 131072, LDS_SCR_OFF = RING_BYTES, LDSCTL_OFF = 154112, LDS_TAB_OFF = LDSCTL_OFF + 256, LDS_BYTES = 163840;

__device__ __forceinline__ unsigned f2bf(float f) { unsigned u = __builtin_bit_cast(unsigned, f); return (u + 0x7fffu + ((u >> 16) & 1u)) >> 16; }
__device__ __forceinline__ unsigned pk2(float lo, float hi) { unsigned r; asm("v_cvt_pk_bf16_f32 %0, %1, %2" : "=v"(r) : "v"(lo), "v"(hi)); return r; }
__device__ __forceinline__ bf16x8 pack8(const f32x4& a, const f32x4& b) { const u32x4 w = (u32x4){pk2(a.x, a.y), pk2(a.z, a.w), pk2(b.x, b.y), pk2(b.z, b.w)}; return __builtin_bit_cast(bf16x8, w); }
__device__ __forceinline__ float bf2f(unsigned h) { return __builtin_bit_cast(float, h << 16); }
__device__ __forceinline__ float bflo(unsigned w) { return __builtin_bit_cast(float, w << 16); }
__device__ __forceinline__ float bfhi(unsigned w) { return __builtin_bit_cast(float, w & 0xffff0000u); }
__device__ __forceinline__ float wave_sum(float v) {
    int x = __builtin_bit_cast(int, v);
#define WS_STEP(ctrl, rmask) do { const int t_ = __builtin_amdgcn_update_dpp(0, x, (ctrl), (rmask), 0xF, false); x = __builtin_bit_cast(int, __builtin_bit_cast(float, x) + __builtin_bit_cast(float, t_)); } while (0)
    WS_STEP(0xB1, 0xF);
    WS_STEP(0x4E, 0xF);
    WS_STEP(0x141, 0xF);
    WS_STEP(0x140, 0xF);
    WS_STEP(0x142, 0xA);
    WS_STEP(0x143, 0xC);
#undef WS_STEP
    return __builtin_bit_cast(float, __builtin_amdgcn_readlane(x, 63));
}
__device__ __forceinline__ float silu_f(float v) { return v / (1.0f + __expf(-v)); }
__device__ __forceinline__ float fexp2(float x) { return __builtin_amdgcn_exp2f(x); }
#define LDS_WAIT() asm volatile("s_waitcnt lgkmcnt(0)" ::: "memory")

#define XB_TMO      128
#define XB_XCNT(j)  (256  + 64 * (j))
#define XB_XSUB(j)  (1280 + 64 * (j))
#define XB_XGEN(j)  (2304 + 64 * (j))
#define XB_TOP      3328
#define XB_TOPGEN   3392
#define XCD_BAR_WORDS 3456
#define XB_SPIN_CAP (1u << 18)
__device__ __forceinline__ unsigned xb_ld(unsigned* p)              { return __hip_atomic_load(p, __ATOMIC_RELAXED, __HIP_MEMORY_SCOPE_AGENT); }
__device__ __forceinline__ unsigned xb_add(unsigned* p, unsigned v) { return __hip_atomic_fetch_add(p, v, __ATOMIC_RELAXED, __HIP_MEMORY_SCOPE_AGENT); }
__device__ __forceinline__ unsigned xb_xcc_id() { return (unsigned)__builtin_amdgcn_s_getreg((3 << 11) | 20) & 0xFu; }
#define XB_SPIN(cond, bar) do { unsigned _sp = 0; while (cond) { __builtin_amdgcn_s_sleep(1); \
    if ((++_sp & 255u) == 0u) { if (xb_ld(&(bar)[XB_TMO])) break; if (_sp > XB_SPIN_CAP) { atomicAdd(&(bar)[XB_TMO], 1u); break; } } } } while (0)
struct XcdBarrier { unsigned* bar; unsigned x; volatile LAS unsigned* st; };
__device__ __forceinline__ XcdBarrier xcd_barrier_post(unsigned* bar, volatile LAS unsigned* st) {
    XcdBarrier b; b.bar = bar; b.x = xb_xcc_id(); b.st = st;
    if (threadIdx.x == 0) (void)xb_add(&bar[XB_XCNT(b.x)], 1u);
    return b;
}
__device__ __forceinline__ void xcd_barrier_complete(unsigned* bar, unsigned x, unsigned& nloc, unsigned& nx) {
    const unsigned G = gridDim.x * gridDim.y * gridDim.z;
    unsigned sum, cnt, mine, sp = 0u;
    for (;;) {
        sum = 0u; cnt = 0u; mine = 0u;
#pragma unroll
        for (unsigned j = 0; j < 16; ++j) { const unsigned c = xb_ld(&bar[XB_XCNT(j)]); sum += c; cnt += (c > 0u) ? 1u : 0u; mine = (j == x) ? c : mine; }
        if (sum == G) break;
        __builtin_amdgcn_s_sleep(1);
        if ((++sp & 255u) == 0u) { if (xb_ld(&bar[XB_TMO])) break; if (sp > XB_SPIN_CAP) { atomicAdd(&bar[XB_TMO], 1u); break; } }
    }
    nloc = mine > 0u ? mine : 1u; nx = cnt > 0u ? cnt : 1u;
}
__device__ __forceinline__ void xcd_barrier(const XcdBarrier& b) {
    asm volatile("s_waitcnt vmcnt(0)" ::: "memory");
    __syncthreads();
    if (threadIdx.x == 0) {
        unsigned* bar = b.bar;
        __builtin_amdgcn_s_waitcnt(0);
        unsigned nloc = b.st[0], nx = b.st[1];
        if (nloc == 0u) { xcd_barrier_complete(bar, b.x, nloc, nx); b.st[0] = nloc; b.st[1] = nx; }
        const unsigned old = xb_add(&bar[XB_XSUB(b.x)], 1u);
        const unsigned gen = old / nloc;
        if (old + 1u == (gen + 1u) * nloc) {
            __builtin_amdgcn_fence(__ATOMIC_RELEASE, "agent");
            asm volatile("s_waitcnt vmcnt(0)" ::: "memory");
            const unsigned og = xb_add(&bar[XB_TOP], 1u);
            const unsigned tg = og / nx;
            if (og + 1u == (tg + 1u) * nx) xb_add(&bar[XB_TOPGEN], 1u);
            else XB_SPIN(xb_ld(&bar[XB_TOPGEN]) == tg, bar);
            __builtin_amdgcn_fence(__ATOMIC_ACQUIRE, "agent");
            xb_add(&bar[XB_XGEN(b.x)], 1u);
            asm volatile("s_waitcnt vmcnt(0)" ::: "memory");
        } else {
            XB_SPIN(xb_ld(&bar[XB_XGEN(b.x)]) == gen, bar);
            __builtin_amdgcn_fence(__ATOMIC_ACQUIRE, "agent");
            asm volatile("s_waitcnt vmcnt(0)" ::: "memory");
        }
    }
    __syncthreads();
}

struct Args { const float* in[21]; float* out; unsigned char* ws; int ph_lo, ph_hi; };
typedef const __attribute__((address_space(4))) Args* KArgs;
struct Ctx {
    LAS unsigned char* lds;
    int tid, lane, wave, G, bid;
    KArgs a;
    float* H;
    unsigned char* ws;
};
__device__ __forceinline__ const float* modp(const Ctx& F, int l, int row, int part) { return (const float*)(F.ws + WS_MOD) + (size_t)(l * 17 + row) * 6144 + part * 1024; }

namespace g8 {
constexpr int BM = 256, BK = 64, HALF = 128, HTB = HALF * BK * 2, STAGE_BYTES = 8 * HTB;
__device__ __forceinline__ int lds_byte(int r, int c) { const int st = (r >> 4) * 2 + (c >> 5), rr = r & 15, cc = c & 31, ob = rr * 64 + cc * 2; return st * 1024 + (ob ^ (((ob >> 9) & 1) << 5)); }
__device__ __forceinline__ void stage_rc(int b, int& R, int& C) { const int st = b / 1024, sb = b % 1024, swz = sb ^ (((sb >> 9) & 1) << 5); R = (st >> 1) * 16 + swz / 64; C = (st & 1) * 32 + (swz % 64) / 2; }
struct Unit { const char* B; int pm, pn, e, aux; };
__device__ __forceinline__ void tile_of(int L, int nM, int nN, int& pm, int& pn) {
    const int nwg = nM * nN; int wgid = L; { const int q = nwg / 8, r = nwg % 8, xcd = wgid % 8, off = wgid / 8; wgid = (xcd < r ? xcd * (q + 1) : r * (q + 1) + (xcd - r) * q) + off; }
    const int nig = 8 * nN, gid = wgid / nig, fm = gid * 8, gsz = (nM - fm) < 8 ? (nM - fm) : 8;
    pm = fm + ((wgid % nig) % gsz); pn = (wgid % nig) / gsz;
}
template <class Epi, class Sched>
__device__ __forceinline__ void gemm_phase(LAS unsigned char* lds, const char* Abase, const int K, const Sched& S, const Epi& E) {
    const int tid = threadIdx.x, wid = __builtin_amdgcn_readfirstlane(tid >> 6), lane = tid & 63, wr = wid >> 2, wc = wid & 3, fr = lane & 15, fq = lane >> 4;
    const int nt = K / BK;
    int R0, C0, R1, C1; stage_rc(tid * 16, R0, C0); stage_rc(tid * 16 + 8192, R1, C1);
    unsigned voffB[2]; voffB[0] = (unsigned)(R0 * K + C0) * 2u; voffB[1] = (unsigned)(R1 * K + C1) * 2u;
    const unsigned kstep = (unsigned)(BK * 2);
    const size_t hstepB = (size_t)HALF * K * 2;
    const unsigned ldsw = (unsigned)wid * 1024u;
    const int aoff = lds_byte(wr * 64 + fr, fq * 8), boff = lds_byte(wc * 32 + fr, fq * 8);
#define G8_SA(b, h) (((b) * 2 + (h)) * HTB)
#define G8_SB(b, h) ((4 + (b) * 2 + (h)) * HTB)
#define G8_STAGEB(bufoff, gbase) do { _Pragma("unroll") for (int _i = 0; _i < 2; ++_i) \
        __builtin_amdgcn_global_load_lds((const unsigned*)((const char*)(gbase) + voffB[_i]), (LAS unsigned*)(lds + (bufoff) + ldsw + _i * 8192), 16, 0, 0); } while (0)
#define G8_STAGEA(bufoff, offs, h, koff) do { _Pragma("unroll") for (int _i = 0; _i < 2; ++_i) \
        __builtin_amdgcn_global_load_lds((const unsigned*)((Abase + (koff)) + (offs)[h][_i]), (LAS unsigned*)(lds + (bufoff) + ldsw + _i * 8192), 16, 0, 0); } while (0)
#define G8_LDA(dst, b, h) do { _Pragma("unroll") for (int m = 0; m < 4; ++m) _Pragma("unroll") for (int k = 0; k < 2; ++k) dst[m][k] = *(const LAS bf16x8*)(lds + G8_SA(b, h) + aoff + m * 2048 + k * 1024); } while (0)
#define G8_LDB(dst, b, h) do { _Pragma("unroll") for (int n = 0; n < 2; ++n) _Pragma("unroll") for (int k = 0; k < 2; ++k) dst[n][k] = *(const LAS bf16x8*)(lds + G8_SB(b, h) + boff + n * 2048 + k * 1024); } while (0)
#define G8_MMA(ai, bj, At, Bt) do { __builtin_amdgcn_s_setprio(1); _Pragma("unroll") for (int m = 0; m < 4; ++m) _Pragma("unroll") for (int n = 0; n < 2; ++n) _Pragma("unroll") for (int k = 0; k < 2; ++k) \
        acc[ai][bj][m][n] = __builtin_amdgcn_mfma_f32_16x16x32_bf16(Bt[n][k], At[m][k], acc[ai][bj][m][n], 0, 0, 0); __builtin_amdgcn_s_setprio(0); } while (0)
#define G8_WAIT_V(n) asm volatile("s_waitcnt vmcnt(" #n ")" ::: "memory")
#define G8_WAIT_L(n) asm volatile("s_waitcnt lgkmcnt(" #n ")" ::: "memory")
#define G8_BAR __builtin_amdgcn_s_barrier()
#define G8_SCHED __builtin_amdgcn_sched_barrier(0)
    Unit cur, nxt; int ui = 0;
    if (!S.next(0, cur)) return;
    f32x4 acc[2][2][4][2];
#pragma unroll
    for (int a = 0; a < 2; ++a)
#pragma unroll
        for (int b = 0; b < 2; ++b)
#pragma unroll
            for (int m = 0; m < 4; ++m)
#pragma unroll
                for (int n = 0; n < 2; ++n) acc[a][b][m][n] = (f32x4){0.f, 0.f, 0.f, 0.f};
    bf16x8 At[4][2], B0[2][2], B1[2][2];
    unsigned ac[2][2];
    ac[0][0] = S.rowoff(cur, R0) + (unsigned)C0 * 2u; ac[0][1] = S.rowoff(cur, R1) + (unsigned)C1 * 2u;
    ac[1][0] = S.rowoff(cur, HALF + R0) + (unsigned)C0 * 2u; ac[1][1] = S.rowoff(cur, HALF + R1) + (unsigned)C1 * 2u;
    const char* cB = cur.B;
    G8_STAGEB(G8_SB(0, 0), cB); G8_STAGEB(G8_SB(0, 1), cB + hstepB); G8_STAGEA(G8_SA(0, 0), ac, 0, 0); G8_STAGEA(G8_SA(0, 1), ac, 1, 0);
    if (wr == 1) G8_BAR;
    G8_WAIT_V(2); G8_BAR;
    G8_STAGEB(G8_SB(1, 0), cB + kstep); G8_STAGEA(G8_SA(1, 0), ac, 0, kstep); G8_STAGEB(G8_SB(1, 1), cB + hstepB + kstep);
    G8_WAIT_V(6); G8_BAR;
    for (;;) {
        const bool has_next = S.next(ui + 1, nxt);
        const char* nB = has_next ? nxt.B : cB;
#pragma unroll 1
        for (int t = 0; t < nt; t += 2) {
            const bool last = (t == nt - 2);
            const unsigned k1 = (unsigned)(t + 1) * kstep;
            const unsigned k2 = last ? 0u : (unsigned)(t + 2) * kstep;
            const unsigned k3 = k2 + kstep;
            const char* b2 = last ? nB : cB + k2; const char* b3 = b2 + kstep;
            G8_LDB(B0, 0, 0); G8_LDB(B1, 0, 1); G8_SCHED; G8_LDA(At, 0, 0); G8_STAGEA(G8_SA(1, 1), ac, 1, k1);
            if (last && has_next) {
                ac[0][0] = S.rowoff(nxt, R0) + (unsigned)C0 * 2u; ac[0][1] = S.rowoff(nxt, R1) + (unsigned)C1 * 2u;
                ac[1][0] = S.rowoff(nxt, HALF + R0) + (unsigned)C0 * 2u; ac[1][1] = S.rowoff(nxt, HALF + R1) + (unsigned)C1 * 2u;
            }
            G8_WAIT_V(8); G8_WAIT_L(0); G8_BAR; G8_MMA(0, 0, At, B0); G8_MMA(0, 1, At, B1); G8_BAR; G8_SCHED;
            G8_LDA(At, 0, 1); G8_STAGEB(G8_SB(0, 0), b2); G8_STAGEB(G8_SB(0, 1), b2 + hstepB); G8_STAGEA(G8_SA(0, 0), ac, 0, k2);
            G8_WAIT_V(8); G8_WAIT_L(0); G8_BAR; G8_MMA(1, 0, At, B0); G8_MMA(1, 1, At, B1); G8_BAR; G8_SCHED;
            G8_LDB(B0, 1, 0); G8_LDB(B1, 1, 1); G8_SCHED; G8_LDA(At, 1, 0); G8_STAGEA(G8_SA(0, 1), ac, 1, k2);
            G8_WAIT_V(8); G8_WAIT_L(0); G8_BAR; G8_MMA(0, 0, At, B0); G8_MMA(0, 1, At, B1); G8_BAR; G8_SCHED;
            G8_LDA(At, 1, 1); G8_STAGEB(G8_SB(1, 0), b3); G8_STAGEB(G8_SB(1, 1), b3 + hstepB); G8_STAGEA(G8_SA(1, 0), ac, 0, k3);
            G8_WAIT_V(8); G8_WAIT_L(0); G8_BAR; G8_MMA(1, 0, At, B0); G8_MMA(1, 1, At, B1); G8_BAR; G8_SCHED;
        }
        if (wr == 0) G8_BAR;
        E(acc, cur, wr, wc, fr, fq);
        if (!has_next) break;
#pragma unroll
        for (int a = 0; a < 2; ++a)
#pragma unroll
            for (int b = 0; b < 2; ++b)
#pragma unroll
                for (int m = 0; m < 4; ++m)
#pragma unroll
                    for (int n = 0; n < 2; ++n) acc[a][b][m][n] = (f32x4){0.f, 0.f, 0.f, 0.f};
        cur = nxt; cB = nB; ++ui;
        if (wr == 1) G8_BAR;
    }
    G8_WAIT_V(0);
    G8_BAR;
#undef G8_SA
#undef G8_SB
#undef G8_STAGEA
#undef G8_STAGEB
#undef G8_LDA
#undef G8_LDB
#undef G8_MMA
#undef G8_WAIT_V
#undef G8_WAIT_L
#undef G8_BAR
#undef G8_SCHED
}
}

struct CvDesc { const float* W; bf16* WT; int ldw, ldo, k0, n0, kind, aux; };
struct RmId   { __device__ __forceinline__ int operator()(int n) const { return n; } };
struct RmGate { int up; __device__ __forceinline__ int operator()(int h) const { return 256 * (h >> 7) + 128 * ((h >> 2) & 1) + 32 * ((h >> 5) & 3) + 16 * up + 4 * ((h >> 3) & 3) + (h & 3); } };
struct RmPerm { __device__ __forceinline__ int operator()(int c) const { const int q = c & 31; return (c & ~31) + 16 * ((q >> 2) & 1) + 4 * (q >> 3) + (q & 3); } };
struct RmIn   { __device__ __forceinline__ int operator()(int n) const {
    const bool rope = (n < 512) || (n >= OFF_RQ && n < OFF_RQ + 512);
    const bool tokmaj = (n >= OFF_NK && n < OFF_NV) || (n >= OFF_RG);
    const int d = n & 127; return rope ? ((n & ~127) + 32 * ((d >> 4) & 3) + 16 * (d >> 6) + (d & 15)) : (tokmaj ? RmPerm{}(n) : n); } };

__device__ __forceinline__ int cv_rowmap(const CvDesc& d, int n) { return d.kind == 1 ? RmGate{d.aux}(n) : (d.kind == 2 ? RmPerm{}(n) : (d.kind == 3 ? RmIn{}(n) : n)); }
__device__ __forceinline__ void cv_load(const CvDesc& d, int lane, float (&buf)[32]) {
    const float* p = d.W + (size_t)(d.k0 + (lane >> 5)) * d.ldw + d.n0 + (lane & 31);
#pragma unroll
    for (int i = 0; i < 32; ++i) buf[i] = __builtin_nontemporal_load(p + (size_t)(2 * i) * d.ldw);
}
__device__ __forceinline__ void cv_store(const CvDesc& d, int lane, const float (&buf)[32], LAS float* scr) {
#pragma unroll
    for (int i = 0; i < 32; ++i) scr[(2 * i + (lane >> 5)) * 33 + (lane & 31)] = buf[i];
    LDS_WAIT(); asm volatile("" ::: "memory");
    const int c = lane & 7;
#pragma unroll
    for (int j = 0; j < 4; ++j) { const int n = (lane >> 3) + 8 * j; const LAS float* sp = scr + (8 * c) * 33 + n;
        u32x4 o; o.x = pk2(sp[0 * 33], sp[1 * 33]); o.y = pk2(sp[2 * 33], sp[3 * 33]); o.z = pk2(sp[4 * 33], sp[5 * 33]); o.w = pk2(sp[6 * 33], sp[7 * 33]);
        *(u32x4*)(d.WT + (size_t)cv_rowmap(d, d.n0 + n) * d.ldo + d.k0 + 8 * c) = o; }
    LDS_WAIT(); asm volatile("" ::: "memory");
}
constexpr int I_E1 = 3 * 32 * 256;
__device__ __forceinline__ CvDesc cv_expert(const Ctx& F, int l, int q) {
    const int mat = q >> 13, r = q & 8191, le = l * 32 + (r >> 8), w = r & 255; CvDesc d;
    if (mat < 2) { d.W = (mat ? F.a->in[19] : F.a->in[18]) + (size_t)le * 1024 * 512; d.ldw = 512; d.WT = (bf16*)(F.ws + WS_WGU) + (size_t)le * 1024 * 1024; d.ldo = 1024; d.kind = 1; d.aux = mat; d.k0 = 64 * (w >> 4); d.n0 = 32 * (w & 15); }
    else { d.W = F.a->in[20] + (size_t)le * 512 * 1024; d.ldw = 1024; d.WT = (bf16*)(F.ws + WS_WDN) + (size_t)le * 1024 * 512; d.ldo = 512; d.kind = 2; d.aux = 0; d.k0 = 64 * (w >> 5); d.n0 = 32 * (w & 31); }
    return d;
}
constexpr int I_IN = 16 * 112, I_OUT = 16 * 32, I_POOL = 4 * 32;
__device__ __forceinline__ CvDesc cv_phase0(const Ctx& F, int r, int nexp) {
    if (r < nexp) return cv_expert(F, r < I_E1 ? 0 : 1, r < I_E1 ? r : r - I_E1);
    r -= nexp; CvDesc d; d.aux = 0;
    if (r < I_IN) { d.W = F.a->in[8]; d.ldw = IN_COLS; d.WT = (bf16*)(F.ws + WS_WIN); d.ldo = 1024; d.kind = 3; d.k0 = 64 * (r / 112); d.n0 = 32 * (r % 112); return d; }
    r -= I_IN;
    if (r < I_OUT) { d.W = F.a->in[9]; d.ldw = 1024; d.WT = (bf16*)(F.ws + WS_WOUT); d.ldo = 1024; d.kind = 2; d.k0 = 64 * (r >> 5); d.n0 = 32 * (r & 31); return d; }
    r -= I_OUT;
    { const int g = r >> 5, q = r & 31; d.W = F.a->in[12] + (size_t)g * 65536; d.ldw = 256; d.WT = (bf16*)(F.ws + WS_WPOOL) + (size_t)g * 65536; d.ldo = 256; d.kind = 2; d.k0 = 64 * (q >> 3); d.n0 = 32 * (q & 7); return d; }
}
#define CV_RUN(first, end, stride, GEN) do { float bA_[32], bB_[32]; const int end_ = (end), st_ = (stride); \
    for (int it_ = (first); it_ < end_; it_ += 2 * st_) { const bool h1_ = it_ + st_ < end_; \
        const CvDesc dA_ = GEN(it_); const CvDesc dB_ = GEN(h1_ ? it_ + st_ : it_); \
        cv_load(dA_, F.lane, bA_); cv_load(dB_, F.lane, bB_);     \
        cv_store(dA_, F.lane, bA_, scr); if (h1_) cv_store(dB_, F.lane, bB_, scr); } } while (0)
__device__ __forceinline__ void phase0(const Ctx& F) {
    LAS float* sil = (LAS float*)F.lds;
    LAS float* red = (LAS float*)(F.lds + 17 * 1024 * 4);
    float* mod = (float*)(F.ws + WS_MOD);
    for (int it = F.bid; it < 192; it += F.G) {
        const int l = it / 96, col0 = (it % 96) * 64;
        for (int idx = F.tid; idx < 17 * 1024; idx += 512) { const int r = idx >> 10, k = idx & 1023; const float v = r < 16 ? F.a->in[1][r * 1024 + k] : F.a->in[3][k]; sil[idx] = silu_f(v); }
        __syncthreads();
        float a[17];
#pragma unroll
        for (int r = 0; r < 17; ++r) a[r] = 0.f;
        const int k0 = F.wave * 128;
        const float* wp = F.a->in[4] + ((size_t)l * 1024 + k0) * 6144 + col0 + F.lane;
#pragma unroll 4
        for (int kk = 0; kk < 128; ++kk) { const float w = wp[(size_t)kk * 6144];
#pragma unroll
            for (int r = 0; r < 17; ++r) a[r] += sil[r * 1024 + k0 + kk] * w; }
#pragma unroll
        for (int r = 0; r < 17; ++r) red[(F.wave * 17 + r) * 64 + F.lane] = a[r];
        __syncthreads();
        for (int idx = F.tid; idx < 17 * 64; idx += 512) { const int r = idx >> 6, cc = idx & 63; float s = F.a->in[5][l * 6144 + col0 + cc];
#pragma unroll
            for (int w8 = 0; w8 < 8; ++w8) s += red[(w8 * 17 + r) * 64 + cc];
            mod[(size_t)(l * 17 + r) * 6144 + col0 + cc] = s; }
        __syncthreads();
    }
    __syncthreads();
    LAS float* scr = (LAS float*)(F.lds + F.wave * 16384);
    const int gw = F.bid * 8 + F.wave, NGW = F.G * 8;
    const int nexp_items = (F.G == 256) ? I_E1 : 2 * I_E1;
    const int NITEMS = nexp_items + I_IN + I_OUT + I_POOL;
#define CV_GEN0(i_) cv_phase0(F, (i_), nexp_items)
    CV_RUN(gw, NITEMS, NGW, CV_GEN0);
#undef CV_GEN0
}
__device__ __forceinline__ void convert_tail(const Ctx& F, int vc, int first, int lo, int hi) {
    if (F.G != 256) return;
    if (first >= F.G) first = 0;
    if (vc < first) return;
    LAS float* scr = (LAS float*)(F.lds + F.wave * 16384);
    const int nw = (F.G - first) * 8;
#define CV_GEN1(i_) cv_expert(F, 1, (i_))
    CV_RUN(lo + (vc - first) * 8 + F.wave, hi, nw, CV_GEN1);
#undef CV_GEN1
}

__device__ __forceinline__ void p1_load(const Ctx& F, int row, f32x4 (&b)[4]) {
    const float* src = row < T ? F.a->in[0] + (size_t)row * D : F.a->in[2] + (size_t)(row - T) * D;
#pragma unroll
    for (int j = 0; j < 4; ++j) b[j] = *(const f32x4*)(src + 4 * F.lane + 256 * j);
}
__device__ __forceinline__ void p1_row(const Ctx& F, int row, const f32x4 (&v)[4], f32x4 (&sh)[4], f32x4 (&sc)[4], int& mr_cur) {
    const int mr = row < T ? (row >> 11) : 16;
    if (mr != mr_cur) { mr_cur = mr;
#pragma unroll
        for (int j = 0; j < 4; ++j) { sh[j] = *(const f32x4*)(modp(F, 0, mr, 0) + 4 * F.lane + 256 * j); sc[j] = *(const f32x4*)(modp(F, 0, mr, 1) + 4 * F.lane + 256 * j) + 1.0f; } }
    unsigned long long* o8 = (unsigned long long*)((bf16*)(F.ws + WS_XA) + (size_t)row * D) + F.lane;
#pragma unroll
    for (int j = 0; j < 4; ++j) { const f32x4 y = v[j] * sc[j] + sh[j];
        o8[64 * j] = (unsigned long long)pk2(y.x, y.y) | ((unsigned long long)pk2(y.z, y.w) << 32); }
}
__device__ __forceinline__ void phase1(const Ctx& F) {
    const int gw = F.bid * 8 + F.wave, NGW = F.G * 8;
    const int per = (T + TC + NGW - 1) / NGW, r_lo = gw * per, r_hi = min(r_lo + per, T + TC);
    if (r_lo >= r_hi) return;
    f32x4 A[4], B[4], sh[4], sc[4]; int mr_cur = -1;
    p1_load(F, r_lo, A);
    for (int row = r_lo; row < r_hi; row += 2) {
        if (row + 1 < r_hi) p1_load(F, row + 1, B);
        asm volatile("" ::: "memory");
        p1_row(F, row, A, sh, sc, mr_cur);
        if (row + 1 < r_hi) {
            if (row + 2 < r_hi) p1_load(F, row + 2, A);
            asm volatile("" ::: "memory");
            p1_row(F, row + 1, B, sh, sc, mr_cur);
        }
    }
}

struct SchedIn {
    int G, c; const char* Wt;
    __device__ __forceinline__ bool next(int i, g8::Unit& u) const {
        const int L = i * G + c; if (L >= 1792 + 128) return false;
        int pm, pn; if (L < 1792) g8::tile_of(L, 128, 14, pm, pn); else { g8::tile_of(L - 1792, 16, 8, pm, pn); pm += 128; }
        u.pm = pm; u.pn = pn; u.e = 0; u.aux = 0; u.B = Wt + (size_t)pn * 256 * 1024 * 2; return true; }
    __device__ __forceinline__ unsigned rowoff(const g8::Unit& u, int r) const { return (unsigned)(u.pm * 256 + r) * 2048u; }
};
struct EpiIn {
    unsigned char* ws; unsigned char* dout; LAS unsigned char* lds;
    __device__ __forceinline__ void tstore(const f32x4 (&v)[4], LAS bf16* scr, bf16* dst0, size_t colpitch, int lane, int fr, int fq) const {
#pragma unroll
        for (int m = 0; m < 4; ++m)
#pragma unroll
            for (int j = 0; j < 4; j += 2) { const unsigned w = pk2(v[m][j], v[m][j + 1]); scr[(4 * fq + j) * 72 + 16 * m + fr] = (bf16)(w & 0xffffu); scr[(4 * fq + j + 1) * 72 + 16 * m + fr] = (bf16)(w >> 16); }
        LDS_WAIT(); asm volatile("" ::: "memory");
#pragma unroll
        for (int i = 0; i < 2; ++i) { const int q = lane + 64 * i, cc = q >> 3, ch = q & 7;
            const u32x4 w = *(const LAS u32x4*)(scr + cc * 72 + ch * 8);
            *(u32x4*)(dst0 + (size_t)cc * colpitch + ch * 8) = w; }
        LDS_WAIT(); asm volatile("" ::: "memory");
    }
    __device__ __forceinline__ void operator()(const f32x4 (&acc)[2][2][4][2], const g8::Unit& u, int wr, int wc, int fr, int fq) const {
        const bool isctx = u.pm >= 128;
        const int lane = fr + 16 * fq, wid = wr * 4 + wc;
        LAS bf16* scr = (LAS bf16*)(lds + LDS_SCR_OFF + wid * 2304);
        const int row0 = u.pm * 256 + wr * 64 + fr;
        const int bb = isctx ? (u.pm - 128) : (u.pm >> 3);
        const int tt0 = isctx ? 0 : ((u.pm & 7) * 256);
        const size_t tp = isctx ? CTXL : TPITCH;
        const int pn = u.pn;
        if (pn < 2 || pn == 8 || pn == 9) {
            const float scale = (pn >= 8) ? 0.08838834764831845f : 1.0f;
            const int dd = 16 * wc + 4 * fq;
            f32x4 invf;
#pragma unroll
            for (int j = 0; j < 4; ++j) invf[j] = fexp2(-(float)((dd & 31) + j) * (13.287712379549449f / 32.0f));
#pragma unroll
            for (int ai = 0; ai < 2; ++ai)
#pragma unroll
                for (int bj = 0; bj < 2; ++bj) {
                    f32x4 o1[4], o2[4];
#pragma unroll
                    for (int m = 0; m < 4; ++m) { const int row = row0 + ai * 128 + m * 16;
                        f32x4 cs = (f32x4){1.f, 1.f, 1.f, 1.f}, sn = (f32x4){0.f, 0.f, 0.f, 0.f};
                        if (!isctx) { const float pos = (float)((wc < 2) ? (4 * (u.pm & 7) + wr + 2 * ai) : (fr + 16 * m));
#pragma unroll
                            for (int j = 0; j < 4; ++j) { const float ang = pos * invf[j]; cs[j] = __cosf(ang); sn[j] = __sinf(ang); } }
                        const f32x4 x1 = acc[ai][bj][m][0], x2 = acc[ai][bj][m][1];
                        o1[m] = (x1 * cs - x2 * sn) * scale; o2[m] = (x1 * sn + x2 * cs) * scale;
                        if (!isctx) { bf16* rp = (bf16*)(ws + WS_P) + (size_t)row * PW + (pn < 2 ? PO_RK + pn * 256 : PO_RQ + (pn - 8) * 256) + bj * 128 + dd;
                            *(u32x2*)(rp) = (u32x2){pk2(o1[m].x, o1[m].y), pk2(o1[m].z, o1[m].w)};
                            *(u32x2*)(rp + 64) = (u32x2){pk2(o2[m].x, o2[m].y), pk2(o2[m].z, o2[m].w)}; } }
                    if (pn < 2) {
                        const int head = pn * 2 + bj;
                        bf16* d0 = (bf16*)(dout + (isctx ? DO_KTRC : DO_KTR)) + ((size_t)(bb * 4 + head) * 128 + 16 * wc) * tp + tt0 + ai * 128 + wr * 64;
                        tstore(o1, scr, d0, tp, lane, fr, fq);
                        tstore(o2, scr, d0 + (size_t)64 * tp, tp, lane, fr, fq);
                    }
                }
        } else if (pn == 2 || pn == 3 || pn == 6 || pn == 7) {
#pragma unroll
            for (int ai = 0; ai < 2; ++ai)
#pragma unroll
                for (int bj = 0; bj < 2; ++bj)
#pragma unroll
                    for (int n = 0; n < 2; ++n) {
                        const int col = (pn & 1) * 256 + bj * 128 + wc * 32 + n * 16;
                        const size_t boff = (pn < 4) ? (isctx ? WS_VTRC : WS_VTR) : (isctx ? WS_VTNC : WS_VTN);
                        const size_t roff = (pn < 4) ? ((size_t)(bb * 4 + (col >> 7)) * 128 + (col & 127)) : ((size_t)(bb * 8 + (col >> 6)) * 64 + (col & 63));
                        bf16* d0 = (bf16*)(ws + boff) + roff * tp;
                        f32x4 v[4];
#pragma unroll
                        for (int m = 0; m < 4; ++m) v[m] = acc[ai][bj][m][n];
                        tstore(v, scr, d0 + tt0 + ai * 128 + wr * 64, tp, lane, fr, fq);
                    }
        } else {
            const float scale = (pn >= 12) ? 0.125f : 1.0f;
            int ld = PW, c0; size_t boff = WS_P;
            if (pn < 6) { if (isctx) { boff = WS_PC; ld = PCW; } c0 = (isctx ? 0 : PO_NK) + (pn - 4) * 256; }
            else if (pn < 12) { c0 = PO_RG + (pn - 10) * 256; }
            else { c0 = PO_NQ + (pn - 12) * 256; }
            bf16* base = (bf16*)(ws + boff);
            const int rsub = isctx ? T : 0;
            const int col0 = c0 + wc * 32 + 8 * fq;
#pragma unroll
            for (int ai = 0; ai < 2; ++ai)
#pragma unroll
                for (int m = 0; m < 4; ++m) { bf16* rp = base + (size_t)(row0 + ai * 128 + m * 16 - rsub) * ld + col0;
#pragma unroll
                    for (int bj = 0; bj < 2; ++bj) { const f32x4 v0 = acc[ai][bj][m][0] * scale, v1 = acc[ai][bj][m][1] * scale;
                        *(u32x4*)(rp + bj * 128) = (u32x4){pk2(v0.x, v0.y), pk2(v0.z, v0.w), pk2(v1.x, v1.y), pk2(v1.z, v1.w)}; } }
        }
    }
};

__device__ __forceinline__ void dma16(const void* g, LAS unsigned char* l) { __builtin_amdgcn_global_load_lds((const unsigned*)g, (LAS unsigned*)l, 16, 0, 0); }
__device__ __forceinline__ bf16x8 frag256(const LAS unsigned char* tile, int row, int chunk) { return *(const LAS bf16x8*)(tile + row * 256 + ((chunk ^ (row & 15)) << 4)); }
__device__ __forceinline__ void phase3(const Ctx& F) {
    const bf16* KTr = (const bf16*)((const char*)F.H + DO_KTR); const bf16* KTrc = (const bf16*)((const char*)F.H + DO_KTRC);
    const bf16* VTr = (const bf16*)(F.ws + WS_VTR); const bf16* VTrc = (const bf16*)(F.ws + WS_VTRC);
    bf16* ST = (bf16*)((char*)F.H + DO_ST);
    const int lane = F.lane, r = lane & 31, hh = lane >> 5, dkt = F.wave & 3, dvs = F.wave >> 2, w = F.wave;
    for (int u0 = F.bid; u0 < 256; u0 += F.G) {
        const int unit = (F.G == 256) ? ((u0 & 7) * 32 + (u0 >> 3)) : u0;
        const int bh = unit >> 2, dvh = (unit >> 1) & 1, dir = unit & 1, h = bh & 3;
        const float lg2 = __log2f(1.0f - __expf(F.a->in[10][dir * 4 + h]));
        const float gstep = fexp2(dir == 0 ? -lg2 : lg2);
        const float cdec = fexp2(lg2 * 128.0f);
        f32x16 acc;
#pragma unroll
        for (int i = 0; i < 16; ++i) acc[i] = 0.f;
        __syncthreads();
#define P3_STAGE(s_) do { const int s__ = (s_); const bool cx = s__ < 2; const int ci = cx ? (dir == 0 ? s__ : 1 - s__) : (dir == 0 ? s__ - 2 : 17 - s__); \
            const bf16* kb = cx ? KTrc + (size_t)bh * 128 * CTXL + ci * 128 : KTr + (size_t)bh * 128 * TPITCH + ci * 128; \
            const bf16* vb = cx ? VTrc + ((size_t)bh * 128 + dvh * 64) * CTXL + ci * 128 : VTr + ((size_t)bh * 128 + dvh * 64) * TPITCH + ci * 128; \
            const size_t pitch = cx ? (size_t)CTXL : (size_t)TPITCH; \
            _Pragma("unroll") for (int i = 0; i < 6; ++i) { const int idx = (i < 4 ? i : i - 4) * 512 + w * 64 + lane, R = idx >> 4, cc = (idx & 15) ^ (R & 15); \
                dma16((i < 4 ? kb : vb) + (size_t)R * pitch + 8 * cc, F.lds + (s__ % 3) * 49152 + (i * 512 + w * 64) * 16); } } while (0)
        P3_STAGE(0); P3_STAGE(1);
#pragma unroll 1
        for (int s = 0; s < 18; ++s) {
            if (s >= 2) {
                const int c = dir == 0 ? s - 2 : 17 - s;
                bf16* sp = ST + ((((size_t)dir * 64 + bh) * 16 + c) * 128 + dvh * 64 + dvs * 32 + r) * 128 + dkt * 32 + 4 * hh;
#pragma unroll
                for (int g = 0; g < 4; ++g) *(u32x2*)(sp + 8 * g) = (u32x2){pk2(acc[4 * g], acc[4 * g + 1]), pk2(acc[4 * g + 2], acc[4 * g + 3])};
            }
            if (s < 2) asm volatile("s_waitcnt vmcnt(6)" ::: "memory"); else if (s < 17) asm volatile("s_waitcnt vmcnt(10)" ::: "memory"); else asm volatile("s_waitcnt vmcnt(0)" ::: "memory");
            __builtin_amdgcn_s_barrier(); asm volatile("" ::: "memory");
            if (s < 16) P3_STAGE(s + 2);
            if (s < 17) {
#pragma unroll
                for (int i = 0; i < 16; ++i) acc[i] *= cdec;
                const LAS unsigned char* kt = F.lds + (s % 3) * 49152; const LAS unsigned char* vt = kt + 32768;
#pragma unroll
                for (int ks = 0; ks < 8; ++ks) {
                    const bf16x8 af = frag256(kt, 32 * dkt + r, 2 * ks + hh); const bf16x8 vv = frag256(vt, 32 * dvs + r, 2 * ks + hh); bf16x8 bfr;
                    const int tk = 16 * ks + 8 * hh; float wgt = fexp2(lg2 * (float)(dir == 0 ? (127 - tk) : tk));
                    float wv8[8];
#pragma unroll
                    for (int j = 0; j < 8; ++j) { wv8[j] = bf2f((unsigned short)vv[j]) * wgt; wgt *= gstep; }
                    bfr = pack8((f32x4){wv8[0], wv8[1], wv8[2], wv8[3]}, (f32x4){wv8[4], wv8[5], wv8[6], wv8[7]});
                    acc = __builtin_amdgcn_mfma_f32_32x32x16_bf16(af, bfr, acc, 0, 0, 0);
                }
            }
        }
        asm volatile("s_waitcnt vmcnt(0) lgkmcnt(0)" ::: "memory");
        __syncthreads();
#undef P3_STAGE
    }
}

__device__ __forceinline__ void ret_unit(const Ctx& F, int unit) {
    const bf16* P = (const bf16*)(F.ws + WS_P); const bf16* ST = (const bf16*)((const char*)F.H + DO_ST); const bf16* VTr = (const bf16*)(F.ws + WS_VTR); bf16* Y = (bf16*)(F.ws + WS_XA);
    int lane = F.lane; asm volatile("" : "+v"(lane));
    const int li = lane & 15, kq = lane >> 4, w = F.wave;
    const int b = unit >> 6, h = (unit >> 4) & 3, c = unit & 15, bh = b * 4 + h;
    const size_t tok0 = (size_t)b * SEQ + c * 128;
    const int i0 = 16 * w;
    const float lgf = __log2f(1.0f - __expf(F.a->in[10][h])), lgb = __log2f(1.0f - __expf(F.a->in[10][4 + h]));
    constexpr int T_ST0 = 0, T_K = 65536, T_V = 98304;
    __syncthreads();
#pragma unroll
    for (int i = 0; i < 16; ++i) { const int tile = i >> 2; const int idx = (i & 3) * 512 + w * 64 + lane, R = idx >> 4, cc = (idx & 15) ^ (R & 15);
        const bf16* src;
        if (tile < 2) src = ST + ((((size_t)tile * 64 + bh) * 16 + c) * 128 + R) * 128 + 8 * cc;
        else if (tile == 2) src = P + (tok0 + R) * PW + PO_RK + h * 128 + 8 * cc;
        else src = VTr + ((size_t)bh * 128 + R) * TPITCH + c * 128 + 8 * cc;
        dma16(src, F.lds + (i * 512 + w * 64) * 16); }
    bf16x8 qf[4];
    { const bf16* qp = P + (tok0 + i0 + li) * PW + PO_RQ + h * 128 + 8 * kq;
#pragma unroll
      for (int ks = 0; ks < 4; ++ks) qf[ks] = *(const bf16x8*)(qp + 32 * ks); }
    asm volatile("s_waitcnt vmcnt(0)" ::: "memory");
    __syncthreads();
    f32x4 O[8];
#pragma unroll
    for (int dirn = 0; dirn < 2; ++dirn) {
        const LAS unsigned char* tl = F.lds + T_ST0 + dirn * 32768;
        float rs[4];
#pragma unroll
        for (int jj = 0; jj < 4; ++jj) { const int i = i0 + 4 * kq + jj; rs[jj] = dirn == 0 ? fexp2(lgf * (float)(i + 1)) : fexp2(lgb * (float)(128 - i)); }
#pragma unroll
        for (int nt = 0; nt < 8; ++nt) { f32x4 a = (f32x4){0.f, 0.f, 0.f, 0.f};
#pragma unroll
            for (int ks = 0; ks < 4; ++ks) a = __builtin_amdgcn_mfma_f32_16x16x32_bf16(qf[ks], frag256(tl, 16 * nt + li, 4 * ks + kq), a, 0, 0, 0);
#pragma unroll
            for (int jj = 0; jj < 4; ++jj) { const float v = a[jj] * rs[jj]; if (dirn == 0) O[nt][jj] = v; else O[nt][jj] += v; } }
    }
    bf16x8 pf[4];
    const int krow = 8 * (li >> 2) + (li & 3);
#pragma unroll
    for (int u = 0; u < 4; ++u) {
        f32x4 s2[2];
#pragma unroll
        for (int hf = 0; hf < 2; ++hf) { f32x4 a = (f32x4){0.f, 0.f, 0.f, 0.f};
#pragma unroll
            for (int ks = 0; ks < 4; ++ks) a = __builtin_amdgcn_mfma_f32_16x16x32_bf16(frag256(F.lds + T_K, 32 * u + krow + 4 * hf, 4 * ks + kq), qf[ks], a, 0, 0, 0);
#pragma unroll
            for (int jj = 0; jj < 4; ++jj) { const int dlt = (i0 + li) - (32 * u + 8 * kq + 4 * hf + jj);
                const float ex = fexp2((dlt > 0 ? lgf : lgb) * fabsf((float)dlt));
                a[jj] *= (dlt == 0) ? 2.0f : ex; }
            s2[hf] = a; }
        pf[u] = pack8(s2[0], s2[1]);
    }
#pragma unroll
    for (int u = 0; u < 4; ++u)
#pragma unroll
        for (int nt = 0; nt < 8; ++nt) O[nt] = __builtin_amdgcn_mfma_f32_16x16x32_bf16(pf[u], frag256(F.lds + T_V, 16 * nt + li, 4 * u + kq), O[nt], 0, 0, 0);
    __syncthreads();
    LAS float* osc = (LAS float*)(F.lds + w * 8448);
#pragma unroll
    for (int jj = 0; jj < 4; ++jj) {
        float sm = 0.f;
#pragma unroll
        for (int nt = 0; nt < 8; ++nt) sm += O[nt][jj];
        sm += __shfl_xor(sm, 1); sm += __shfl_xor(sm, 2); sm += __shfl_xor(sm, 4); sm += __shfl_xor(sm, 8);
        const float mean = sm * (1.0f / 128.0f); float q = 0.f;
#pragma unroll
        for (int nt = 0; nt < 8; ++nt) { const float d = O[nt][jj] - mean; q += d * d; }
        q += __shfl_xor(q, 1); q += __shfl_xor(q, 2); q += __shfl_xor(q, 4); q += __shfl_xor(q, 8);
        const float rstd = 1.0f / sqrtf(q * (1.0f / 128.0f) + LN_EPS);
#pragma unroll
        for (int nt = 0; nt < 8; ++nt) osc[(4 * kq + jj) * 132 + 16 * nt + li] = (O[nt][jj] - mean) * rstd;
    }
    LDS_WAIT(); asm volatile("" ::: "memory");
#pragma unroll
    for (int i = 0; i < 4; ++i) { const int q = lane + 64 * i, row = q >> 4, ch = q & 15; const size_t tk = tok0 + i0 + row;
        const f32x4 a = *(const LAS f32x4*)(osc + row * 132 + 8 * ch), c2 = *(const LAS f32x4*)(osc + row * 132 + 8 * ch + 4);
        const u32x4 g = *(const u32x4*)(P + tk * PW + PO_RG + h * 128 + 8 * ch);
        u32x4 o;
        o.x = pk2(silu_f(bflo(g.x)) * a.x, silu_f(bfhi(g.x)) * a.y); o.y = pk2(silu_f(bflo(g.y)) * a.z, silu_f(bfhi(g.y)) * a.w);
        o.z = pk2(silu_f(bflo(g.z)) * c2.x, silu_f(bfhi(g.z)) * c2.y); o.w = pk2(silu_f(bflo(g.w)) * c2.z, silu_f(bfhi(g.w)) * c2.w);
        if (ABL & 32) o = (u32x4){0u, 0u, 0u, 0u};
        *(u32x4*)(Y + tk * D + h * 128 + 8 * ch) = o; }
    LDS_WAIT(); asm volatile("" ::: "memory");
}
__device__ __forceinline__ void na_unit(const Ctx& F, int unit, bool load_ctx) {
    const bf16* P = (const bf16*)(F.ws + WS_P); const bf16* Pc = (const bf16*)(F.ws + WS_PC); bf16* Y = (bf16*)(F.ws + WS_XA);
    const bf16* VTn = (const bf16*)(F.ws + WS_VTN); const bf16* VTnc = (const bf16*)(F.ws + WS_VTNC);
    int lane = F.lane; asm volatile("" : "+v"(lane));
    const int li = lane & 15, kq = lane >> 4, w = F.wave;
    const int b = unit >> 7, nh = (unit >> 4) & 7, rp = unit & 15;
    const int r = 2 * rp + (w >> 2), cb = w & 3;
    const int rmin = min(max(2 * rp - 4, 0), GROWS - 8);
    const int r0 = min(max(r - 4, 0), GROWS - 8), kstart = min(max(16 * cb - 8, 0), GRIDW - 32);
    const int qc = 16 * cb + li; const int wstart = min(max(qc - 8, 0), GRIDW - 16);
    const size_t tokb = (size_t)b * SEQ;
    const int krow = 8 * (li >> 2) + (li & 3);
    constexpr int L_CTX = 73728, L_TBL = 106496, L_CTXV = 108544;
    __syncthreads();
#pragma unroll
    for (int i = 0; i < 13; ++i) { const int idx = i * 512 + w * 64 + lane; const bf16* src;
        if (i < 9) { const int R = idx >> 3, cc = (idx & 7) ^ (R & 7); const int kr = min(rmin + (R >> 6), GROWS - 1);
            src = P + (tokb + kr * 64 + (R & 63)) * PW + PO_NK + nh * 64 + 8 * cc; }
        else { if (!load_ctx) continue; const int id2 = idx - 4608, R = id2 >> 3, cc = (id2 & 7) ^ (R & 7); src = Pc + ((size_t)b * CTXL + R) * PCW + nh * 64 + 8 * cc; }
        dma16(src, F.lds + (i * 512 + w * 64) * 16); }
    if (load_ctx) {
#pragma unroll
        for (int i = 0; i < 4; ++i) { const int id2 = i * 512 + w * 64 + lane, Rd = id2 >> 5, cc = (id2 & 31) ^ (Rd & 7);
            dma16(VTnc + ((size_t)(b * 8 + nh) * 64 + Rd) * CTXL + 8 * cc, F.lds + L_CTXV + (i * 512 + w * 64) * 16); } }
    LAS float* tbl = (LAS float*)(F.lds + L_TBL);
    for (int q = F.tid; q < 15 * 32; q += 512) { const int rr = q >> 5, cc = q & 31; tbl[q] = cc < 31 ? F.a->in[11][(size_t)(nh * 15 + rr) * 31 + cc] : -3.0e38f; }
    bf16x8 qf[2];
    { const bf16* qp = P + (tokb + r * 64 + qc) * PW + PO_NQ + nh * 64 + 8 * kq; qf[0] = *(const bf16x8*)qp; qf[1] = *(const bf16x8*)(qp + 32); }
    asm volatile("s_waitcnt vmcnt(0)" ::: "memory");
    __syncthreads();
    f32x4 sw[16], sc[16];
    float mx = -3.0e38f;
#pragma unroll
    for (int wt = 0; wt < 16; ++wt) {
        const int kr = r0 + (wt >> 1);
        f32x4 a;
#pragma unroll
        for (int jj = 0; jj < 4; ++jj) { const int kc = kstart + 8 * kq + 4 * (wt & 1) + jj; const bool ok = (kc >= wstart) && (kc < wstart + 16);
            const int cbi = ok ? (kc - qc + 15) : 31; a[jj] = tbl[(kr - r + 7) * 32 + cbi]; }
        const int R = (kr - rmin) * 64 + kstart + krow + 4 * (wt & 1);
        const LAS unsigned char* rowp = F.lds + R * 128;
        a = __builtin_amdgcn_mfma_f32_16x16x32_bf16(*(const LAS bf16x8*)(rowp + ((kq ^ (R & 7)) << 4)), qf[0], a, 0, 0, 0);
        a = __builtin_amdgcn_mfma_f32_16x16x32_bf16(*(const LAS bf16x8*)(rowp + (((4 + kq) ^ (R & 7)) << 4)), qf[1], a, 0, 0, 0);
#pragma unroll
        for (int jj = 0; jj < 4; ++jj) mx = fmaxf(mx, a[jj]);
        sw[wt] = a;
    }
#pragma unroll
    for (int ct = 0; ct < 16; ++ct) {
        const int R = 32 * (ct >> 1) + krow + 4 * (ct & 1);
        const LAS unsigned char* rowp = F.lds + L_CTX + R * 128;
        f32x4 a = (f32x4){0.f, 0.f, 0.f, 0.f};
        a = __builtin_amdgcn_mfma_f32_16x16x32_bf16(*(const LAS bf16x8*)(rowp + ((kq ^ (R & 7)) << 4)), qf[0], a, 0, 0, 0);
        a = __builtin_amdgcn_mfma_f32_16x16x32_bf16(*(const LAS bf16x8*)(rowp + (((4 + kq) ^ (R & 7)) << 4)), qf[1], a, 0, 0, 0);
#pragma unroll
        for (int jj = 0; jj < 4; ++jj) mx = fmaxf(mx, a[jj]);
        sc[ct] = a;
    }
    __syncthreads();
#pragma unroll
    for (int i = 0; i < 13; ++i) { const int idx = i * 512 + w * 64 + lane; const bf16* src;
        if (i < 9) { const int Rd = idx / 72, q = idx - Rd * 72, cc = q ^ (Rd & 7); const int kr = min(rmin + (cc >> 3), GROWS - 1);
            src = VTn + ((size_t)(b * 8 + nh) * 64 + Rd) * TPITCH + kr * 64 + (cc & 7) * 8; }
        else continue;
        dma16(src, F.lds + (i * 512 + w * 64) * 16); }
    mx = fmaxf(mx, __shfl_xor(mx, 16)); mx = fmaxf(mx, __shfl_xor(mx, 32));
    float sum = 0.f;
#pragma unroll
    for (int wt = 0; wt < 16; ++wt)
#pragma unroll
        for (int jj = 0; jj < 4; ++jj) { const float e = __expf(sw[wt][jj] - mx); sw[wt][jj] = e; sum += e; }
#pragma unroll
    for (int ct = 0; ct < 16; ++ct)
#pragma unroll
        for (int jj = 0; jj < 4; ++jj) { const float e = __expf(sc[ct][jj] - mx); sc[ct][jj] = e; sum += e; }
    sum += __shfl_xor(sum, 16); sum += __shfl_xor(sum, 32);
    asm volatile("s_waitcnt vmcnt(0)" ::: "memory");
    __syncthreads();
    f32x4 O[4];
#pragma unroll
    for (int nt = 0; nt < 4; ++nt) O[nt] = (f32x4){0.f, 0.f, 0.f, 0.f};
#pragma unroll
    for (int u = 0; u < 8; ++u) { bf16x8 pf;
        pf = pack8(sw[2 * u], sw[2 * u + 1]);
        const int cch = (r0 + u - rmin) * 8 + (kstart >> 3) + kq;
#pragma unroll
        for (int nt = 0; nt < 4; ++nt) { const int Rd = 16 * nt + li;
            O[nt] = __builtin_amdgcn_mfma_f32_16x16x32_bf16(pf, *(const LAS bf16x8*)(F.lds + Rd * 1152 + ((cch ^ (Rd & 7)) << 4)), O[nt], 0, 0, 0); } }
#pragma unroll
    for (int u = 0; u < 8; ++u) { bf16x8 pf;
        pf = pack8(sc[2 * u], sc[2 * u + 1]);
#pragma unroll
        for (int nt = 0; nt < 4; ++nt) { const int Rd = 16 * nt + li;
            O[nt] = __builtin_amdgcn_mfma_f32_16x16x32_bf16(pf, *(const LAS bf16x8*)(F.lds + L_CTXV + Rd * 512 + (((4 * u + kq) ^ (Rd & 7)) << 4)), O[nt], 0, 0, 0); } }
    __syncthreads();
    LAS float* osc = (LAS float*)(F.lds + w * 4352);
#pragma unroll
    for (int jj = 0; jj < 4; ++jj) {
        const float sq = __shfl(sum, 4 * kq + jj); const float inv = 1.0f / sq;
#pragma unroll
        for (int nt = 0; nt < 4; ++nt) osc[(4 * kq + jj) * 68 + 16 * nt + li] = O[nt][jj] * inv;
    }
    LDS_WAIT(); asm volatile("" ::: "memory");
#pragma unroll
    for (int i = 0; i < 2; ++i) { const int q = lane + 64 * i, row = q >> 3, ch = q & 7;
        const f32x4 a = *(const LAS f32x4*)(osc + row * 68 + 8 * ch), c2 = *(const LAS f32x4*)(osc + row * 68 + 8 * ch + 4);
        u32x4 o = (u32x4){pk2(a.x, a.y), pk2(a.z, a.w), pk2(c2.x, c2.y), pk2(c2.z, c2.w)};
        if (ABL & 16) o = (u32x4){0u, 0u, 0u, 0u};
        *(u32x4*)(Y + (tokb + r * 64 + 16 * cb + row) * D + 512 + nh * 64 + 8 * ch) = o; }
    LDS_WAIT(); asm volatile("" ::: "memory");
}
__device__ __forceinline__ void phase4(const Ctx& F) {
#ifndef P4MASK
#define P4MASK 3
#endif
    if (P4MASK & 1) for (int u = F.bid; u < 1024; u += F.G) ret_unit(F, u);
    if (P4MASK & 2) {
        if (F.G == 256) { const int vb = (F.bid & 7) * 32 + (F.bid >> 3);
            for (int k = 0; k < 8; ++k) na_unit(F, vb * 8 + k, k == 0); }
        else for (int u = F.bid; u < 2048; u += F.G) na_unit(F, u, true);
    }
}

struct SchedOut {
    int G, c; const char* Wt;
    __device__ __forceinline__ bool next(int i, g8::Unit& u) const {
        const int L = i * G + c; if (L >= 512) return false;
        int pm, pn; g8::tile_of(L, 128, 4, pm, pn); u.pm = pm; u.pn = pn; u.e = 0; u.aux = 0; u.B = Wt + (size_t)pn * 256 * 1024 * 2; return true; }
    __device__ __forceinline__ unsigned rowoff(const g8::Unit& u, int r) const { return (unsigned)(u.pm * 256 + r) * 2048u; }
};
struct EpiY {
    static constexpr bool IDEMP = true;
    bf16* Yg; const float* gate0; const float* cs; float abl;
    __device__ __forceinline__ void operator()(const f32x4 (&acc)[2][2][4][2], const g8::Unit& u, int wr, int wc, int fr, int fq) const {
        const int row0 = u.pm * 256 + wr * 64 + fr, col0 = u.pn * 256 + wc * 32 + 8 * fq;
        const float* gp = gate0 + (size_t)(row0 >> 11) * 6144 + col0;
        f32x4 gv[2][2];
#pragma unroll
        for (int bj = 0; bj < 2; ++bj)
#pragma unroll
            for (int n = 0; n < 2; ++n) { gv[bj][n] = *(const f32x4*)(gp + bj * 128 + n * 4) * abl; if (cs) gv[bj][n] *= *(const f32x4*)(cs + col0 + bj * 128 + n * 4); }
#pragma unroll
        for (int ai = 0; ai < 2; ++ai)
#pragma unroll
            for (int m = 0; m < 4; ++m) { bf16* rp = Yg + (size_t)(row0 + ai * 128 + m * 16) * D + col0;
#pragma unroll
                for (int bj = 0; bj < 2; ++bj) { const f32x4 v0 = acc[ai][bj][m][0] * gv[bj][0], v1 = acc[ai][bj][m][1] * gv[bj][1];
                    *(u32x4*)(rp + bj * 128) = (u32x4){pk2(v0.x, v0.y), pk2(v0.z, v0.w), pk2(v1.x, v1.y), pk2(v1.z, v1.w)}; } }
    }
};

struct LnVecs { f32x4 lg[4], lb[4], sh[4], sc1[4]; f32x4 br1; };
__device__ __forceinline__ void ln_load(const float* R32, const bf16* R16, const bf16* Yg, int t, int lane, f32x4 (&nr)[4], u32x2 (&ny)[4]) {
    const u32x2* yr = (const u32x2*)(Yg + (size_t)t * D) + lane;
    if (R32) { const float* rr = R32 + (size_t)t * D;
#pragma unroll
        for (int j = 0; j < 4; ++j) nr[j] = *(const f32x4*)(rr + 4 * lane + 256 * j); }
    else { const u32x2* rr = (const u32x2*)(R16 + (size_t)t * D) + lane;
#pragma unroll
        for (int j = 0; j < 4; ++j) { const u32x2 h = rr[64 * j]; nr[j] = (f32x4){bflo(h.x), bfhi(h.x), bflo(h.y), bfhi(h.y)}; } }
#pragma unroll
    for (int j = 0; j < 4; ++j) ny[j] = yr[64 * j];
}
__device__ __forceinline__ void ln_row(const Ctx& F, int l, int t, const f32x4 (&nr)[4], const u32x2 (&ny)[4], const LnVecs& V, LAS f32x4* wl, LAS u32x4* rec_slot) {
    const int lane = F.lane; const LAS float* br2l = (const LAS float*)(F.lds + 149760);
    bf16* hm = (bf16*)(F.ws + WS_XA);
    unsigned long long* hr8 = (unsigned long long*)((bf16*)(F.ws + WS_H16) + (size_t)t * D) + lane;
    f32x4 v[4]; float s = 0.f;
#pragma unroll
    for (int j = 0; j < 4; ++j) { const u32x2 y = ny[j]; v[j] = nr[j] * ALPHA + (f32x4){bflo(y.x), bfhi(y.x), bflo(y.y), bfhi(y.y)}; s += (v[j].x + v[j].y) + (v[j].z + v[j].w); }
    const float mean = wave_sum(s) * (1.0f / D); float s2 = 0.f;
#pragma unroll
    for (int j = 0; j < 4; ++j) { v[j] = v[j] - mean; s2 += (v[j].x * v[j].x + v[j].y * v[j].y) + (v[j].z * v[j].z + v[j].w * v[j].w); }
    const float rstd = 1.0f / sqrtf(wave_sum(s2) * (1.0f / D) + LN_EPS);
    unsigned long long* o8 = (unsigned long long*)(hm + (size_t)t * D) + lane;
    float pg[4] = {0.f, 0.f, 0.f, 0.f};
#pragma unroll
    for (int j = 0; j < 4; ++j) { const int ci = 4 * lane + 256 * j;
        const f32x4 h1 = v[j] * rstd * V.lg[j] + V.lb[j];
        hr8[64 * j] = (unsigned long long)pk2(h1.x, h1.y) | ((unsigned long long)pk2(h1.z, h1.w) << 32);
        const f32x4 m = h1 * V.sc1[j] + V.sh[j];
        v[j] = m;
        o8[64 * j] = (unsigned long long)pk2(m.x, m.y) | ((unsigned long long)pk2(m.z, m.w) << 32);
#pragma unroll
        for (int e = 0; e < 4; ++e) { const f32x4 w = wl[(4 * j + e) * 64 + lane];
#pragma unroll
            for (int g = 0; g < 4; ++g) pg[g] += m[e] * w[g]; } }
    float lgt[4];
#pragma unroll
    for (int g = 0; g < 4; ++g) lgt[g] = wave_sum(pg[g]) + V.br1[g];
    int grp = 0; float gm = lgt[0];
#pragma unroll
    for (int g = 1; g < 4; ++g) if (lgt[g] > gm) { gm = lgt[g]; grp = g; }
    float gs = 0.f;
#pragma unroll
    for (int g = 0; g < 4; ++g) gs += __expf(lgt[g] - gm);
    const float gate_g = 1.0f / gs;
    float pe[8] = {0.f, 0.f, 0.f, 0.f, 0.f, 0.f, 0.f, 0.f};
#pragma unroll
    for (int j = 0; j < 4; ++j) {
#pragma unroll
        for (int e = 0; e < 4; ++e) { const f32x4 wa = wl[1024 + 2048 * grp + ((4 * j + e) * 2) * 64 + lane], wb = wl[1024 + 2048 * grp + ((4 * j + e) * 2 + 1) * 64 + lane];
#pragma unroll
            for (int q = 0; q < 4; ++q) { pe[q] += v[j][e] * wa[q]; pe[4 + q] += v[j][e] * wb[q]; } } }
    float le[8];
    {
        float a4[4], a2[2], a1;
#pragma unroll
        for (int q = 0; q < 4; ++q) { const float mine = (lane & 1) ? pe[q + 4] : pe[q], send = (lane & 1) ? pe[q] : pe[q + 4]; a4[q] = mine + __shfl_xor(send, 1); }
#pragma unroll
        for (int q = 0; q < 2; ++q) { const float mine = (lane & 2) ? a4[q + 2] : a4[q], send = (lane & 2) ? a4[q] : a4[q + 2]; a2[q] = mine + __shfl_xor(send, 2); }
        { const float mine = (lane & 4) ? a2[1] : a2[0], send = (lane & 4) ? a2[0] : a2[1]; a1 = mine + __shfl_xor(send, 4); }
        a1 += __shfl_xor(a1, 8); a1 += __shfl_xor(a1, 16); a1 += __shfl_xor(a1, 32);
#pragma unroll
        for (int q = 0; q < 8; ++q) { const int src = ((q >> 2) & 1) | (((q >> 1) & 1) << 1) | ((q & 1) << 2); le[q] = __shfl(a1, src) + br2l[grp * 8 + q]; }

    }
    int i0 = 0; float v0 = le[0];
#pragma unroll
    for (int q = 1; q < 8; ++q) if (le[q] > v0) { v0 = le[q]; i0 = q; }
    int i1 = -1; float v1 = -3.0e38f;
#pragma unroll
    for (int q = 0; q < 8; ++q) if (q != i0 && le[q] > v1) { v1 = le[q]; i1 = q; }
    const float e1 = __expf(v1 - v0); const float w0 = (ABL & 128) ? 0.f : gate_g / (1.0f + e1), w1 = (ABL & 1024) ? 1.0f : ((ABL & 64) ? 0.f : gate_g * e1 / (1.0f + e1));
    if (lane == 0) *rec_slot = (u32x4){(unsigned)(grp * 8 + i0), (unsigned)(grp * 8 + i1), __builtin_bit_cast(unsigned, w0), __builtin_bit_cast(unsigned, w1)};
}
__device__ __forceinline__ void phase_ln_router(const Ctx& F, int l, const float* R32, const bf16* Yg) {
    const bf16* R16 = (const bf16*)(F.ws + WS_H16);
    const int gw = F.bid * 8 + F.wave, lane = F.lane;
    int* tokinfo = (int*)(F.ws + WS_TOKINFO); int* list = (int*)(F.ws + WS_LIST);
    unsigned* cnt = (unsigned*)(F.ws + WS_CTL) + CW_CNT + 64 * (l * 32);
    LAS f32x4* wl = (LAS f32x4*)F.lds;
    __syncthreads();
    for (int k = F.tid; k < 1024; k += 512) { const int ln = (k & 255) >> 2, e = k & 3, j = k >> 8;
        wl[(4 * j + e) * 64 + ln] = *(const f32x4*)(F.a->in[14] + ((size_t)l * D + k) * 4);
#pragma unroll
        for (int g = 0; g < 4; ++g)
#pragma unroll
            for (int q = 0; q < 2; ++q) wl[1024 + 2048 * g + ((4 * j + e) * 2 + q) * 64 + ln] = *(const f32x4*)(F.a->in[16] + (((size_t)l * 4 + g) * D + k) * 8 + 4 * q); }
    if (F.tid < 32) ((LAS float*)(F.lds + 149760))[F.tid] = F.a->in[17][l * 32 + F.tid];
    __syncthreads();
    LAS u32x4* recs = (LAS u32x4*)(F.lds + 147456);
    const int t_lo = gw * 16;
    for (int tb = t_lo; tb < T; tb += F.G * 8 * 16) {
        const int b = tb >> 11;
        LnVecs V;
#pragma unroll
        for (int j = 0; j < 4; ++j) { const int ci = 4 * lane + 256 * j;
            V.lg[j] = *(const f32x4*)(F.a->in[6] + (l * 2 + 0) * D + ci); V.lb[j] = *(const f32x4*)(F.a->in[7] + (l * 2 + 0) * D + ci);
            V.sh[j] = *(const f32x4*)(modp(F, l, b, 3) + ci); V.sc1[j] = *(const f32x4*)(modp(F, l, b, 4) + ci) + 1.0f; }
        V.br1 = *(const f32x4*)(F.a->in[15] + l * 4);
        f32x4 rA[4], rB[4]; u32x2 yA[4], yB[4];
        ln_load(R32, R16, Yg, tb, lane, rA, yA);
#pragma unroll 1
        for (int k = 0; k < 16; k += 2) {
            ln_load(R32, R16, Yg, tb + k + 1, lane, rB, yB);
            asm volatile("" ::: "memory");
            ln_row(F, l, tb + k, rA, yA, V, wl, recs + F.wave * 16 + k);
            if (k + 2 < 16) ln_load(R32, R16, Yg, tb + k + 2, lane, rA, yA);
            asm volatile("" ::: "memory");
            ln_row(F, l, tb + k + 1, rB, yB, V, wl, recs + F.wave * 16 + k + 1);
        }
        LAS int* lcnt = (LAS int*)(F.lds + 149504);
        __syncthreads();
        if (F.tid < 64) lcnt[F.tid] = 0;
        __syncthreads();
        int e = 0, lp = 0; unsigned wa = 0u, wb = 0u; const int which = F.tid & 1;
        const int r = F.tid >> 1; const int t = (tb - F.wave * 16) + r;
        if (F.tid < 256) { const u32x4 rec = recs[r]; e = which ? (int)rec.y : (int)rec.x; wa = rec.z; wb = rec.w;
            lp = __hip_atomic_fetch_add(&lcnt[e], 1, __ATOMIC_RELAXED, __HIP_MEMORY_SCOPE_WORKGROUP); }
        __syncthreads();
        if (F.tid < 32) lcnt[32 + F.tid] = (int)atomicAdd(cnt + 64 * F.tid, (unsigned)lcnt[F.tid]);
        __syncthreads();
        if (F.tid < 256) { const int pos = lcnt[32 + e] + lp;
            list[(size_t)e * LISTCAP + pos] = t;
            int* ti = tokinfo + (size_t)t * 8;
            *(u32x2*)(ti + 2 * which) = (u32x2){(unsigned)e, (unsigned)pos};
            if (which == 0) *(u32x2*)(ti + 4) = (u32x2){wa, wb}; }
    }
}

__device__ __forceinline__ void moe_table(const Ctx& F, int l) {
    LAS int* tab = (LAS int*)(F.lds + LDS_TAB_OFF);
    __syncthreads();
    if (F.tid < 32) tab[40 + F.tid] = (int)__hip_atomic_load((unsigned*)(F.ws + WS_CTL) + CW_CNT + 64 * (l * 32 + F.tid), __ATOMIC_RELAXED, __HIP_MEMORY_SCOPE_AGENT);
    __syncthreads();
    if (F.tid == 0) { int s = 0; for (int e = 0; e < 32; ++e) { tab[e] = s; s += (tab[40 + e] + 255) >> 8; } tab[32] = s; }
    __syncthreads();
}
__device__ __forceinline__ int moe_vc(int c, int G) { return (G == 256) ? (((c & 7) * 8 + (c >> 5)) * 4 + ((c >> 3) & 3)) : c; }
struct SchedMoe {
    int G, c; const char* Wt; size_t wstride; size_t pnstride; const LAS int* tab; const LAS int* tokl; int gather; unsigned lda2;
    __device__ __forceinline__ bool next(int i, g8::Unit& u) const {
        const int L = i * G + moe_vc(c, G); const int nrt = __builtin_amdgcn_readfirstlane(tab[32]); if (L >= 4 * nrt) return false;
        const int rt = L >> 2, pn = L & 3; int e = 0;
        for (int q = 1; q < 32; ++q) e = (tab[q] <= rt) ? q : e;
        e = __builtin_amdgcn_readfirstlane(e);
        u.pm = rt; u.pn = pn; u.e = e; u.aux = i; u.B = Wt + (size_t)e * wstride + (size_t)pn * pnstride; return true; }
    __device__ __forceinline__ unsigned rowoff(const g8::Unit& u, int r) const {
        if (gather) return (unsigned)tokl[u.aux * 256 + r] * lda2;
        return (unsigned)(u.pm * 256 + r) * lda2; }
};
constexpr int MOE_MAXU = 8, LDS_TOKL_OFF = LDSCTL_OFF + 1024;
static_assert(LDS_TOKL_OFF + MOE_MAXU * 256 * 4 <= LDS_BYTES && LDS_SCR_OFF + 8 * 2304 <= LDSCTL_OFF, "LDS map");
__device__ __forceinline__ void moe_tokl(const Ctx& F) {
    const LAS int* tab = (const LAS int*)(F.lds + LDS_TAB_OFF); LAS int* tokl = (LAS int*)(F.lds + LDS_TOKL_OFF);
    const int* list = (const int*)(F.ws + WS_LIST);
    for (int q = F.tid; q < MOE_MAXU * 256; q += 512) { const int i = q >> 8, r = q & 255; const int L = i * F.G + moe_vc(F.bid, F.G); int tk = 0;
        if (L < 4 * tab[32]) { const int rt = L >> 2; int e = 0; for (int k = 1; k < 32; ++k) e = (tab[k] <= rt) ? k : e;
            const int idx = (rt - tab[e]) * 256 + r; tk = list[(size_t)e * LISTCAP + (idx < tab[40 + e] ? idx : 0)]; }
        tokl[q] = tk; }
    __syncthreads();
}
struct EpiAct {
    bf16* act;
    __device__ __forceinline__ void operator()(const f32x4 (&acc)[2][2][4][2], const g8::Unit& u, int wr, int wc, int fr, int fq) const {
        const int row0 = u.pm * 256 + wr * 64 + fr, col0 = u.pn * 128 + wc * 32 + 8 * fq;
#pragma unroll
        for (int ai = 0; ai < 2; ++ai)
#pragma unroll
            for (int m = 0; m < 4; ++m) { bf16* rp = act + (size_t)(row0 + ai * 128 + m * 16) * HID + col0;
                const f32x4 g0 = acc[ai][0][m][0], u0 = acc[ai][0][m][1], g1 = acc[ai][1][m][0], u1 = acc[ai][1][m][1];
                *(u32x4*)rp = (u32x4){pk2(silu_f(g0.x) * u0.x, silu_f(g0.y) * u0.y), pk2(silu_f(g0.z) * u0.z, silu_f(g0.w) * u0.w),
                                      pk2(silu_f(g1.x) * u1.x, silu_f(g1.y) * u1.y), pk2(silu_f(g1.z) * u1.z, silu_f(g1.w) * u1.w)}; }
    }
};
struct EpiEo {
    bf16* eo;
    __device__ __forceinline__ void operator()(const f32x4 (&acc)[2][2][4][2], const g8::Unit& u, int wr, int wc, int fr, int fq) const {
        const int row0 = u.pm * 256 + wr * 64 + fr, col0 = u.pn * 256 + wc * 32 + 8 * fq;
#pragma unroll
        for (int ai = 0; ai < 2; ++ai)
#pragma unroll
            for (int m = 0; m < 4; ++m) { bf16* rp = eo + (size_t)(row0 + ai * 128 + m * 16) * D + col0;
#pragma unroll
                for (int bj = 0; bj < 2; ++bj) { const f32x4 v0 = acc[ai][bj][m][0], v1 = acc[ai][bj][m][1];
                    *(u32x4*)(rp + bj * 128) = (u32x4){pk2(v0.x, v0.y), pk2(v0.z, v0.w), pk2(v1.x, v1.y), pk2(v1.z, v1.w)}; } }
    }
};

struct CmbRow { u32x2 h[4]; u32x2 ea[4], eb[4]; };
__device__ __forceinline__ void cmb_load(const Ctx& F, const LAS int* tab, int t, const u32x4& ti, CmbRow& r) {
    const unsigned e0i = ti.x, p0i = ti.y, e1i = ti.z, p1i = ti.w;
    const size_t s0 = (size_t)tab[e0i] * 256 + p0i, s1 = (size_t)tab[e1i] * 256 + p1i;
    const bf16* eo = (const bf16*)(F.ws + WS_EO);
    const u32x2* e0 = (const u32x2*)(eo + s0 * D) + F.lane; const u32x2* e1 = (const u32x2*)(eo + s1 * D) + F.lane; const u32x2* hp = (const u32x2*)((const bf16*)(F.ws + WS_H16) + (size_t)t * D) + F.lane;
#pragma unroll
    for (int j = 0; j < 4; ++j) { r.ea[j] = e0[64 * j]; r.eb[j] = e1[64 * j]; r.h[j] = hp[64 * j]; }
}
__device__ __forceinline__ void cmb_row(const Ctx& F, int l, int t, const CmbRow& r, const u32x2& tw, const f32x4 (&gt)[4], const f32x4 (&lg)[4], const f32x4 (&lb)[4]) {
    const float ab = ((ABL >> (1 + 2 * l)) & 1) ? 0.f : 1.f;
    const unsigned twx = tw.x, twy = tw.y;
    const float w0 = ab * __uint_as_float(twx), w1 = ab * __uint_as_float(twy);
    f32x4 v[4]; float s = 0.f;
#pragma unroll
    for (int j = 0; j < 4; ++j) { const u32x2 a = r.ea[j], c2 = r.eb[j];
        f32x4 y; y.x = w0 * bflo(a.x) + w1 * bflo(c2.x); y.y = w0 * bfhi(a.x) + w1 * bfhi(c2.x); y.z = w0 * bflo(a.y) + w1 * bflo(c2.y); y.w = w0 * bfhi(a.y) + w1 * bfhi(c2.y);
        const u32x2 hh = r.h[j]; v[j] = (f32x4){bflo(hh.x), bfhi(hh.x), bflo(hh.y), bfhi(hh.y)} * ALPHA + gt[j] * y; s += (v[j].x + v[j].y) + (v[j].z + v[j].w); }
    const float mean = wave_sum(s) * (1.0f / D); float s2 = 0.f;
#pragma unroll
    for (int j = 0; j < 4; ++j) { v[j] = v[j] - mean; s2 += (v[j].x * v[j].x + v[j].y * v[j].y) + (v[j].z * v[j].z + v[j].w * v[j].w); }
    const float rstd = 1.0f / sqrtf(wave_sum(s2) * (1.0f / D) + LN_EPS);
    if (l == 1) { float* hr = F.H + (size_t)t * D;
#pragma unroll
        for (int j = 0; j < 4; ++j) *(f32x4*)(hr + 4 * F.lane + 256 * j) = v[j] * rstd * lg[j] + lb[j]; }
    else { unsigned long long* hr8 = (unsigned long long*)((bf16*)(F.ws + WS_H16) + (size_t)t * D) + F.lane;
#pragma unroll
        for (int j = 0; j < 4; ++j) { const f32x4 o = v[j] * rstd * lg[j] + lb[j]; hr8[64 * j] = (unsigned long long)pk2(o.x, o.y) | ((unsigned long long)pk2(o.z, o.w) << 32); } }
}
__device__ __forceinline__ void phase_combine(const Ctx& F, int l) {
    moe_table(F, l);
    const LAS int* tab = (const LAS int*)(F.lds + LDS_TAB_OFF);
    const int gw = F.bid * 8 + F.wave, lane = F.lane;
    const int* tokinfo = (const int*)(F.ws + WS_TOKINFO);
    for (int tb = gw * 16; tb < T; tb += F.G * 8 * 16) {
        const int b = tb >> 11;
        f32x4 gt[4], lg[4], lb[4];
#pragma unroll
        for (int j = 0; j < 4; ++j) { const int ci = 4 * lane + 256 * j; gt[j] = *(const f32x4*)(modp(F, l, b, 5) + ci);
            lg[j] = *(const f32x4*)(F.a->in[6] + (l * 2 + 1) * D + ci); lb[j] = *(const f32x4*)(F.a->in[7] + (l * 2 + 1) * D + ci); }
        u32x4 tiv = (u32x4){0u, 0u, 0u, 0u}; u32x2 twv = (u32x2){0u, 0u};
        if (lane < 16) { tiv = *(const u32x4*)(tokinfo + (size_t)(tb + lane) * 8); twv = *(const u32x2*)(tokinfo + (size_t)(tb + lane) * 8 + 4); }
#define CMB_TI(k_) ((u32x4){(unsigned)__shfl((int)tiv.x, (k_)), (unsigned)__shfl((int)tiv.y, (k_)), (unsigned)__shfl((int)tiv.z, (k_)), (unsigned)__shfl((int)tiv.w, (k_))})
#define CMB_TW(k_) ((u32x2){(unsigned)__shfl((int)twv.x, (k_)), (unsigned)__shfl((int)twv.y, (k_))})
        CmbRow A, B;
        cmb_load(F, tab, tb, CMB_TI(0), A);
#pragma unroll 1
        for (int k = 0; k < 16; k += 2) {
            cmb_load(F, tab, tb + k + 1, CMB_TI(k + 1), B);
            asm volatile("" ::: "memory");
            cmb_row(F, l, tb + k, A, CMB_TW(k), gt, lg, lb);
            if (k + 2 < 16) cmb_load(F, tab, tb + k + 2, CMB_TI(k + 2), A);
            asm volatile("" ::: "memory");
            cmb_row(F, l, tb + k + 1, B, CMB_TW(k + 1), gt, lg, lb);
        }
#undef CMB_TI
#undef CMB_TW
    }
}

template <int WH> __device__ __forceinline__ void pool_item(const Ctx& F, bf16* zp, int b, int p0, int ch) {
    const bf16* hb = (const bf16*)(F.ws + WS_H16) + (size_t)b * SEQ * D + ch;
    const f32x4 sc1 = *(const f32x4*)(modp(F, 1, b, 1) + ch) + 1.0f;
    u32x2 rw[8 + 2 * WH];
#pragma unroll
    for (int i = 0; i < 8 + 2 * WH; ++i) { const int p = p0 - WH + i; const bool ok = (p >= 0) && (p < SEQ); const u32x2 v = *(const u32x2*)(hb + (size_t)(ok ? p : p0) * D); rw[i] = ok ? v : (u32x2){0u, 0u}; }
#define PZ_ROW(i_) ((f32x4){bflo(rw[i_].x), bfhi(rw[i_].x), bflo(rw[i_].y), bfhi(rw[i_].y)})
    f32x4 sum = (f32x4){0.f, 0.f, 0.f, 0.f};
#pragma unroll
    for (int i = 0; i < 2 * WH; ++i) sum += PZ_ROW(i);
#pragma unroll
    for (int j = 0; j < 8; ++j) { const int p = p0 + j; const int cnt = min(p + WH, SEQ) - max(p - WH, 0);
        const f32x4 z = (sum * (1.0f / (float)cnt) - PZ_ROW(j + WH)) * sc1;
        *(u32x2*)(zp + ((size_t)b * SEQ + p) * D + ch) = (u32x2){pk2(z.x, z.y), pk2(z.z, z.w)};
        sum += PZ_ROW(j + 2 * WH) - PZ_ROW(j); }
#undef PZ_ROW
}
__device__ __forceinline__ void phase_pool(const Ctx& F) {
    bf16* zp = (bf16*)(F.ws + WS_XA);
    for (int item = F.bid * 512 + F.tid; item < 4096 * 256; item += F.G * 512) {
        const int strip = item >> 8, ct = item & 255, b = strip >> 8, p0 = (strip & 255) * 8, ch = 4 * ct;
        const int g = __builtin_amdgcn_readfirstlane(ct >> 6);
        if (g == 0) pool_item<1>(F, zp, b, p0, ch); else if (g == 1) pool_item<2>(F, zp, b, p0, ch); else if (g == 2) pool_item<4>(F, zp, b, p0, ch); else pool_item<8>(F, zp, b, p0, ch);
    }
}
struct SchedPool {
    int G, c; const char* Wt;
    __device__ __forceinline__ bool next(int i, g8::Unit& u) const {
        const int L = i * G + c; if (L >= 512) return false;
        int pm, pn; g8::tile_of(L, 128, 4, pm, pn); u.pm = pm; u.pn = pn; u.e = 0; u.aux = 0; u.B = Wt + (size_t)pn * 256 * 256 * 2; return true; }
    __device__ __forceinline__ unsigned rowoff(const g8::Unit& u, int r) const { return (unsigned)(u.pm * 256 + r) * 2048u + (unsigned)u.pn * 512u; }
};

__global__ void __launch_bounds__(512, 2) mk_fwd(Args args) {
    extern __shared__ __attribute__((aligned(16))) unsigned char lds_raw[];
    Ctx F;
    F.lds = (LAS unsigned char*)lds_raw;
    F.tid = threadIdx.x; F.lane = F.tid & 63; F.wave = __builtin_amdgcn_readfirstlane(F.tid >> 6); F.G = gridDim.x; F.bid = blockIdx.x;
    F.a = (KArgs)__builtin_amdgcn_kernarg_segment_ptr();
    F.H = args.out; F.ws = args.ws;
    for (int u = F.tid; u < (LDS_BYTES - LDSCTL_OFF) / 4; u += 512) ((LAS unsigned*)(F.lds + LDSCTL_OFF))[u] = 0u;
    __syncthreads();
    XcdBarrier bar; bar.bar = (unsigned*)(F.ws + WS_CTL) + CW_BAR; bar.x = 0; bar.st = nullptr;
    if (MK_N_LAUNCHES == 1) bar = xcd_barrier_post((unsigned*)(F.ws + WS_CTL) + CW_BAR, (volatile LAS unsigned*)(F.lds + LDSCTL_OFF));
    const int lo = args.ph_lo, hi = args.ph_hi;
#ifndef PHMASK
#define PHMASK 0xFFFF
#endif
#define IN(k) (((PHMASK >> (k)) & 1) && lo <= (k) && (k) < hi)
#define FRESH() do { asm volatile("" : "+s"(F.a)); } while (0)
#define SEAM(k) do { if (IN(k) && IN((k) + 1)) xcd_barrier(bar); } while (0)

    if (IN(0)) { FRESH(); phase0(F); if (RPT & 1) { __syncthreads(); phase0(F); } } SEAM(0);
    if (IN(1)) { FRESH(); phase1(F); if (RPT & 2) { __syncthreads(); phase1(F); } } SEAM(1);
    if (IN(2)) { FRESH();
        SchedIn S{F.G, F.bid, (const char*)(F.ws + WS_WIN)};
        EpiIn E{F.ws, (unsigned char*)F.H, F.lds};
        g8::gemm_phase(F.lds, (const char*)(F.ws + WS_XA), 1024, S, E);
        convert_tail(F, F.bid, (1792 + 128) % 256, 0, 10240);
    } SEAM(2);
    if (IN(3)) { FRESH(); phase3(F); if (RPT & 8) { __syncthreads(); phase3(F); } } SEAM(3);
    if (IN(4)) { FRESH(); phase4(F); if (RPT & 16) { __syncthreads(); phase4(F); } } SEAM(4);
    if (IN(5)) { FRESH();
        SchedOut S{F.G, F.bid, (const char*)(F.ws + WS_WOUT)};
        EpiY E{(bf16*)(F.ws + WS_P), modp(F, 0, 0, 2), nullptr, (ABL & 1) ? 0.f : 1.f};
        g8::gemm_phase(F.lds, (const char*)(F.ws + WS_XA), 1024, S, E); if ((RPT >> 5) & 1) { __syncthreads(); g8::gemm_phase(F.lds, (const char*)(F.ws + WS_XA), 1024, S, E); }
    } SEAM(5);
    if (IN(6)) { FRESH(); phase_ln_router(F, 0, F.a->in[0], (const bf16*)(F.ws + WS_P)); } SEAM(6);
    if (IN(7)) { FRESH();
        moe_table(F, 0); moe_tokl(F);
        SchedMoe S{F.G, F.bid, (const char*)(F.ws + WS_WGU), (size_t)1024 * 1024 * 2, (size_t)256 * 1024 * 2, (const LAS int*)(F.lds + LDS_TAB_OFF), (const LAS int*)(F.lds + LDS_TOKL_OFF), 1, 2048u};
        EpiAct E{(bf16*)(F.ws + WS_ACT)};
        g8::gemm_phase(F.lds, (const char*)(F.ws + WS_XA), 1024, S, E);
        convert_tail(F, moe_vc(F.bid, F.G), (4 * ((const LAS int*)(F.lds + LDS_TAB_OFF))[32]) % 256, 10240, 20480); if ((RPT >> 7) & 1) { __syncthreads(); g8::gemm_phase(F.lds, (const char*)(F.ws + WS_XA), 1024, S, E); }
    } SEAM(7);
    if (IN(8)) { FRESH();
        moe_table(F, 0);
        SchedMoe S{F.G, F.bid, (const char*)(F.ws + WS_WDN), (size_t)1024 * 512 * 2, (size_t)256 * 512 * 2, (const LAS int*)(F.lds + LDS_TAB_OFF), (const LAS int*)(F.lds + LDS_TOKL_OFF), 0, 1024u};
        EpiEo E{(bf16*)(F.ws + WS_EO)};
        g8::gemm_phase(F.lds, (const char*)(F.ws + WS_ACT), 512, S, E);
        convert_tail(F, moe_vc(F.bid, F.G), (4 * ((const LAS int*)(F.lds + LDS_TAB_OFF))[32]) % 256, 20480, I_E1); if ((RPT >> 8) & 1) { __syncthreads(); g8::gemm_phase(F.lds, (const char*)(F.ws + WS_ACT), 512, S, E); }
    } SEAM(8);
    if (IN(9)) { FRESH(); phase_combine(F, 0); } SEAM(9);
    if (IN(10)) { FRESH(); phase_pool(F); if (RPT & 1024) { __syncthreads(); phase_pool(F); } } SEAM(10);
    if (IN(11)) { FRESH();
        SchedPool S{F.G, F.bid, (const char*)(F.ws + WS_WPOOL)};
        EpiY E{(bf16*)(F.ws + WS_ACT), modp(F, 1, 0, 2), F.a->in[13], (ABL & 4) ? 0.f : 1.f};
        g8::gemm_phase(F.lds, (const char*)(F.ws + WS_XA), 256, S, E);
    } SEAM(11);
    if (IN(12)) { FRESH(); phase_ln_router(F, 1, nullptr, (const bf16*)(F.ws + WS_ACT)); } SEAM(12);
    if (IN(13)) { FRESH();
        moe_table(F, 1); moe_tokl(F);
        SchedMoe S{F.G, F.bid, (const char*)(F.ws + WS_WGU) + (size_t)32 * 1024 * 1024 * 2, (size_t)1024 * 1024 * 2, (size_t)256 * 1024 * 2, (const LAS int*)(F.lds + LDS_TAB_OFF), (const LAS int*)(F.lds + LDS_TOKL_OFF), 1, 2048u};
        EpiAct E{(bf16*)(F.ws + WS_ACT)};
        g8::gemm_phase(F.lds, (const char*)(F.ws + WS_XA), 1024, S, E);
    } SEAM(13);
    if (IN(14)) { FRESH();
        moe_table(F, 1);
        SchedMoe S{F.G, F.bid, (const char*)(F.ws + WS_WDN) + (size_t)32 * 1024 * 512 * 2, (size_t)1024 * 512 * 2, (size_t)256 * 512 * 2, (const LAS int*)(F.lds + LDS_TAB_OFF), (const LAS int*)(F.lds + LDS_TOKL_OFF), 0, 1024u};
        EpiEo E{(bf16*)(F.ws + WS_EO)};
        g8::gemm_phase(F.lds, (const char*)(F.ws + WS_ACT), 512, S, E);
    } SEAM(14);
    if (IN(15)) { FRESH(); phase_combine(F, 1); }
#undef IN
#undef SEAM
}

extern "C" void kernel_launch(void* const* d_in, const int* in_sizes, int n_in, void* d_out, int out_size, void* d_ws, size_t ws_size, hipStream_t stream) {
    static int grid = 0;
    if (grid == 0) {
        if (n_in != 21 || in_sizes[0] != T * D || out_size != T * D || ws_size < WS_END) { fprintf(stderr, "kernel_launch: unexpected shapes (n_in %d, ws %zu); nothing launched\n", n_in, ws_size); grid = -1; return; }
        int dev = 0, cus = 0, per_cu = 0;
        if (hipGetDevice(&dev) != hipSuccess || hipDeviceGetAttribute(&cus, hipDeviceAttributeMultiprocessorCount, dev) != hipSuccess) { grid = -1; return; }
        if (hipFuncSetAttribute((const void*)mk_fwd, hipFuncAttributeMaxDynamicSharedMemorySize, LDS_BYTES) != hipSuccess) { fprintf(stderr, "kernel_launch: hipFuncSetAttribute failed\n"); grid = -1; return; }
        if (hipOccupancyMaxActiveBlocksPerMultiprocessor(&per_cu, (const void*)mk_fwd, 512, LDS_BYTES) != hipSuccess || per_cu < 1) { fprintf(stderr, "kernel_launch: occupancy query reports %d\n", per_cu); }
        (void)hipGetLastError();
        grid = cus;
    }
    if (grid < 0) return;
    if (hipMemsetAsync((char*)d_ws + WS_CTL, 0, CTL_ZERO_BYTES, stream) != hipSuccess) return;
    Args a{};
    for (int i = 0; i < 21; ++i) a.in[i] = (const float*)d_in[i];
    a.out = (float*)d_out; a.ws = (unsigned char*)d_ws;
    if (MK_N_LAUNCHES == 1) { a.ph_lo = 0; a.ph_hi = NPHASE; hipLaunchKernelGGL(mk_fwd, dim3(grid), dim3(512), LDS_BYTES, stream, a); }
    else for (int p = 0; p < NPHASE; ++p) { a.ph_lo = p; a.ph_hi = p + 1; hipLaunchKernelGGL(mk_fwd, dim3(grid), dim3(512), LDS_BYTES, stream, a); }
}
```

```cpp
#include <hip/hip_runtime.h>
#include <cstdio>
#include <cstdint>

#ifndef ABL
#define ABL 0
#endif
#ifndef RPT
#define RPT 0
#endif
#ifndef MK_N_LAUNCHES
#define MK_N_LAUNCHES 1
#endif

#define GAS __attribute__((address_space(1)))
#define LAS __attribute__((address_space(3)))
typedef unsigned short bf16;
typedef short bf16x8 __attribute__((ext_vector_type(8)));
typedef float f32x4 __attribute__((ext_vector_type(4)));
typedef float f32x16 __attribute__((ext_vector_type(16)));
typedef unsigned u32x4 __attribute__((ext_vector_type(4)));
typedef unsigned u32x2 __attribute__((ext_vector_type(2)));

constexpr int D = 1024, NB = 16, SEQ = 2048, T = NB * SEQ, CTXL = 256, TC = NB * CTXL;
constexpr int GRIDW = 64, GROWS = SEQ / GRIDW;
constexpr int OFF_RK = 0, OFF_RV = 512, OFF_NK = 1024, OFF_NV = 1536, KV_COLS = 2048, OFF_RQ = 2048, OFF_RG = 2560, OFF_NQ = 3072, IN_COLS = 3584;
constexpr int NEXP = 32, HID = 512, LISTCAP = T;
constexpr int MAXSLOT = 73728;
constexpr float LN_EPS = 1e-5f;
constexpr float ALPHA = 1.41421356237309515f;
constexpr int NPHASE = 16;

constexpr size_t MiB = 1u << 20;
constexpr size_t WS_CTL = 0, CTL_ZERO_BYTES = 128 * 1024;
constexpr size_t WS_MOD = 1 * MiB;
constexpr size_t WS_TOKINFO = 2 * MiB;
constexpr size_t WS_LIST = 3 * MiB;
constexpr size_t WS_WIN = 8 * MiB, WS_WOUT = 15 * MiB, WS_WPOOL = 17 * MiB, WS_WGU = 18 * MiB, WS_WDN = 146 * MiB;
constexpr size_t WS_XA = 210 * MiB;
constexpr size_t WS_P = 282 * MiB;
constexpr size_t WS_ACT = 282 * MiB, WS_EO = 354 * MiB;
constexpr int TPITCH = SEQ + 64;
constexpr size_t WS_VTR = 446 * MiB, WS_VTRC = 480 * MiB;
constexpr size_t WS_VTN = 484 * MiB, WS_VTNC = 518 * MiB;
constexpr size_t WS_PC = 522 * MiB;
constexpr size_t WS_H16 = 526 * MiB;
constexpr size_t WS_END = 590 * MiB;
constexpr size_t DO_ST = 0;
constexpr size_t DO_KTR = 64 * MiB, DO_KTRC = 98 * MiB;
constexpr int PW = 2624, PO_RK = 0, PO_NK = 512, PO_RQ = 1024, PO_RG = 1536, PO_NQ = 2048, PCW = 512;
static_assert(WS_EO + (size_t)MAXSLOT * 1024 * 2 <= 498 * MiB && WS_ACT + (size_t)MAXSLOT * 512 * 2 <= WS_EO, "ws map");
static_assert(WS_P + (size_t)T * PW * 2 <= WS_VTR && WS_VTR + (size_t)64 * 128 * TPITCH * 2 <= WS_VTRC && WS_VTN + (size_t)128 * 64 * TPITCH * 2 <= WS_VTNC && DO_KTR + (size_t)64 * 128 * TPITCH * 2 <= DO_KTRC && WS_XA + (size_t)(T + TC) * D * 2 <= WS_P, "ws map");
constexpr int CW_BAR = 4096, XCD_BAR_WORDS_C = 3456;
constexpr int CW_CNT = 16384;
static_assert((CW_CNT + 64 * 64) * 4 <= (int)CTL_ZERO_BYTES && (CW_BAR + XCD_BAR_WORDS_C) * 4 <= (int)CTL_ZERO_BYTES, "ctl words inside the memset");

constexpr int RING_BYTES = 131072, LDS_SCR_OFF = RING_BYTES, LDSCTL_OFF = 154112, LDS_TAB_OFF = LDSCTL_OFF + 256, LDS_BYTES = 163840;

__device__ __forceinline__ unsigned f2bf(float f) { unsigned u = __builtin_bit_cast(unsigned, f); return (u + 0x7fffu + ((u >> 16) & 1u)) >> 16; }
__device__ __forceinline__ unsigned pk2(float lo, float hi) { unsigned r; asm("v_cvt_pk_bf16_f32 %0, %1, %2" : "=v"(r) : "v"(lo), "v"(hi)); return r; }
__device__ __forceinline__ bf16x8 pack8(const f32x4& a, const f32x4& b) { const u32x4 w = (u32x4){pk2(a.x, a.y), pk2(a.z, a.w), pk2(b.x, b.y), pk2(b.z, b.w)}; return __builtin_bit_cast(bf16x8, w); }
__device__ __forceinline__ float bf2f(unsigned h) { return __builtin_bit_cast(float, h << 16); }
__device__ __forceinline__ float bflo(unsigned w) { return __builtin_bit_cast(float, w << 16); }
__device__ __forceinline__ float bfhi(unsigned w) { return __builtin_bit_cast(float, w & 0xffff0000u); }
__device__ __forceinline__ float wave_sum(float v) {
    int x = __builtin_bit_cast(int, v);
#define WS_STEP(ctrl, rmask) do { const int t_ = __builtin_amdgcn_update_dpp(0, x, (ctrl), (rmask), 0xF, false); x = __builtin_bit_cast(int, __builtin_bit_cast(float, x) + __builtin_bit_cast(float, t_)); } while (0)
    WS_STEP(0xB1, 0xF);
    WS_STEP(0x4E, 0xF);
    WS_STEP(0x141, 0xF);
    WS_STEP(0x140, 0xF);
    WS_STEP(0x142, 0xA);
    WS_STEP(0x143, 0xC);
#undef WS_STEP
    return __builtin_bit_cast(float, __builtin_amdgcn_readlane(x, 63));
}
__device__ __forceinline__ float frcp(float x) { return __builtin_amdgcn_rcpf(x); }
__device__ __forceinline__ float silu_f(float v) { return v * frcp(1.0f + __expf(-v)); }
__device__ __forceinline__ float fexp2(float x) { return __builtin_amdgcn_exp2f(x); }
#define LDS_WAIT() asm volatile("s_waitcnt lgkmcnt(0)" ::: "memory")

#define XB_TMO      128
#define XB_XCNT(j)  (256  + 64 * (j))
#define XB_XSUB(j)  (1280 + 64 * (j))
#define XB_XGEN(j)  (2304 + 64 * (j))
#define XB_TOP      3328
#define XB_TOPGEN   3392
#define XCD_BAR_WORDS 3456
#define XB_SPIN_CAP (1u << 18)
__device__ __forceinline__ unsigned xb_ld(unsigned* p)              { return __hip_atomic_load(p, __ATOMIC_RELAXED, __HIP_MEMORY_SCOPE_AGENT); }
__device__ __forceinline__ unsigned xb_add(unsigned* p, unsigned v) { return __hip_atomic_fetch_add(p, v, __ATOMIC_RELAXED, __HIP_MEMORY_SCOPE_AGENT); }
__device__ __forceinline__ unsigned xb_xcc_id() { return (unsigned)__builtin_amdgcn_s_getreg((3 << 11) | 20) & 0xFu; }
#define XB_SPIN(cond, bar) do { unsigned _sp = 0; while (cond) { __builtin_amdgcn_s_sleep(1); \
    if ((++_sp & 255u) == 0u) { if (xb_ld(&(bar)[XB_TMO])) break; if (_sp > XB_SPIN_CAP) { atomicAdd(&(bar)[XB_TMO], 1u); break; } } } } while (0)
struct XcdBarrier { unsigned* bar; unsigned x; volatile LAS unsigned* st; };
__device__ __forceinline__ XcdBarrier xcd_barrier_post(unsigned* bar, volatile LAS unsigned* st) {
    XcdBarrier b; b.bar = bar; b.x = xb_xcc_id(); b.st = st;
    if (threadIdx.x == 0) (void)xb_add(&bar[XB_XCNT(b.x)], 1u);
    return b;
}
__device__ __forceinline__ void xcd_barrier_complete(unsigned* bar, unsigned x, unsigned& nloc, unsigned& nx) {
    const unsigned G = gridDim.x * gridDim.y * gridDim.z;
    unsigned sum, cnt, mine, sp = 0u;
    for (;;) {
        sum = 0u; cnt = 0u; mine = 0u;
#pragma unroll
        for (unsigned j = 0; j < 16; ++j) { const unsigned c = xb_ld(&bar[XB_XCNT(j)]); sum += c; cnt += (c > 0u) ? 1u : 0u; mine = (j == x) ? c : mine; }
        if (sum == G) break;
        __builtin_amdgcn_s_sleep(1);
        if ((++sp & 255u) == 0u) { if (xb_ld(&bar[XB_TMO])) break; if (sp > XB_SPIN_CAP) { atomicAdd(&bar[XB_TMO], 1u); break; } }
    }
    nloc = mine > 0u ? mine : 1u; nx = cnt > 0u ? cnt : 1u;
}
__device__ __forceinline__ void xcd_barrier(const XcdBarrier& b) {
    asm volatile("s_waitcnt vmcnt(0)" ::: "memory");
    __syncthreads();
    if (threadIdx.x == 0) {
        unsigned* bar = b.bar;
        __builtin_amdgcn_s_waitcnt(0);
        unsigned nloc = b.st[0], nx = b.st[1];
        if (nloc == 0u) { xcd_barrier_complete(bar, b.x, nloc, nx); b.st[0] = nloc; b.st[1] = nx; }
        const unsigned old = xb_add(&bar[XB_XSUB(b.x)], 1u);
        const unsigned gen = old / nloc;
        if (old + 1u == (gen + 1u) * nloc) {
            __builtin_amdgcn_fence(__ATOMIC_RELEASE, "agent");
            asm volatile("s_waitcnt vmcnt(0)" ::: "memory");
            const unsigned og = xb_add(&bar[XB_TOP], 1u);
            const unsigned tg = og / nx;
            if (og + 1u == (tg + 1u) * nx) xb_add(&bar[XB_TOPGEN], 1u);
            else XB_SPIN(xb_ld(&bar[XB_TOPGEN]) == tg, bar);
            __builtin_amdgcn_fence(__ATOMIC_ACQUIRE, "agent");
            xb_add(&bar[XB_XGEN(b.x)], 1u);
            asm volatile("s_waitcnt vmcnt(0)" ::: "memory");
        } else {
            XB_SPIN(xb_ld(&bar[XB_XGEN(b.x)]) == gen, bar);
            __builtin_amdgcn_fence(__ATOMIC_ACQUIRE, "agent");
            asm volatile("s_waitcnt vmcnt(0)" ::: "memory");
        }
    }
    __syncthreads();
}

struct Args { const float* in[21]; float* out; unsigned char* ws; int ph_lo, ph_hi; };
typedef const __attribute__((address_space(4))) Args* KArgs;
struct Ctx {
    LAS unsigned char* lds;
    int tid, lane, wave, G, bid;
    KArgs a;
    float* H;
    unsigned char* ws;
};
__device__ __forceinline__ const float* modp(const Ctx& F, int l, int row, int part) { return (const float*)(F.ws + WS_MOD) + (size_t)(l * 17 + row) * 6144 + part * 1024; }

namespace g8 {
constexpr int BM = 256, BK = 64, HALF = 128, HTB = HALF * BK * 2, STAGE_BYTES = 8 * HTB;
__device__ __forceinline__ int lds_byte(int r, int c) { const int st = (r >> 4) * 2 + (c >> 5), rr = r & 15, cc = c & 31, ob = rr * 64 + cc * 2; return st * 1024 + (ob ^ (((ob >> 9) & 1) << 5)); }
__device__ __forceinline__ void stage_rc(int b, int& R, int& C) { const int st = b / 1024, sb = b % 1024, swz = sb ^ (((sb >> 9) & 1) << 5); R = (st >> 1) * 16 + swz / 64; C = (st & 1) * 32 + (swz % 64) / 2; }
struct Unit { const char* B; int pm, pn, e, aux; };
__device__ __forceinline__ void tile_of(int L, int nM, int nN, int& pm, int& pn) {
    const int nwg = nM * nN; int wgid = L; { const int q = nwg / 8, r = nwg % 8, xcd = wgid % 8, off = wgid / 8; wgid = (xcd < r ? xcd * (q + 1) : r * (q + 1) + (xcd - r) * q) + off; }
    const int nig = 8 * nN, gid = wgid / nig, fm = gid * 8, gsz = (nM - fm) < 8 ? (nM - fm) : 8;
    pm = fm + ((wgid % nig) % gsz); pn = (wgid % nig) / gsz;
}
template <class Epi, class Sched>
__device__ __forceinline__ void gemm_phase(LAS unsigned char* lds, const char* Abase, const int K, const Sched& S, const Epi& E) {
    const int tid = threadIdx.x, wid = __builtin_amdgcn_readfirstlane(tid >> 6), lane = tid & 63, wr = wid >> 2, wc = wid & 3, fr = lane & 15, fq = lane >> 4;
    const int nt = K / BK;
    int R0, C0, R1, C1; stage_rc(tid * 16, R0, C0); stage_rc(tid * 16 + 8192, R1, C1);
    unsigned voffB[2]; voffB[0] = (unsigned)(R0 * K + C0) * 2u; voffB[1] = (unsigned)(R1 * K + C1) * 2u;
    const unsigned kstep = (unsigned)(BK * 2);
    const size_t hstepB = (size_t)HALF * K * 2;
    const unsigned ldsw = (unsigned)wid * 1024u;
    const int aoff = lds_byte(wr * 64 + fr, fq * 8), boff = lds_byte(wc * 32 + fr, fq * 8);
#define G8_SA(b, h) (((b) * 2 + (h)) * HTB)
#define G8_SB(b, h) ((4 + (b) * 2 + (h)) * HTB)
#define G8_STAGEB(bufoff, gbase) do { _Pragma("unroll") for (int _i = 0; _i < 2; ++_i) \
        __builtin_amdgcn_global_load_lds((const unsigned*)((const char*)(gbase) + voffB[_i]), (LAS unsigned*)(lds + (bufoff) + ldsw + _i * 8192), 16, 0, 0); } while (0)
#define G8_STAGEA(bufoff, offs, h, koff) do { _Pragma("unroll") for (int _i = 0; _i < 2; ++_i) \
        __builtin_amdgcn_global_load_lds((const unsigned*)((Abase + (koff)) + (offs)[h][_i]), (LAS unsigned*)(lds + (bufoff) + ldsw + _i * 8192), 16, 0, 0); } while (0)
#define G8_LDA(dst, b, h) do { _Pragma("unroll") for (int m = 0; m < 4; ++m) _Pragma("unroll") for (int k = 0; k < 2; ++k) dst[m][k] = *(const LAS bf16x8*)(lds + G8_SA(b, h) + aoff + m * 2048 + k * 1024); } while (0)
#define G8_LDB(dst, b, h) do { _Pragma("unroll") for (int n = 0; n < 2; ++n) _Pragma("unroll") for (int k = 0; k < 2; ++k) dst[n][k] = *(const LAS bf16x8*)(lds + G8_SB(b, h) + boff + n * 2048 + k * 1024); } while (0)
#define G8_MMA(ai, bj, At, Bt) do { __builtin_amdgcn_s_setprio(1); _Pragma("unroll") for (int m = 0; m < 4; ++m) _Pragma("unroll") for (int n = 0; n < 2; ++n) _Pragma("unroll") for (int k = 0; k < 2; ++k) \
        acc[ai][bj][m][n] = __builtin_amdgcn_mfma_f32_16x16x32_bf16(Bt[n][k], At[m][k], acc[ai][bj][m][n], 0, 0, 0); __builtin_amdgcn_s_setprio(0); } while (0)
#define G8_WAIT_V(n) asm volatile("s_waitcnt vmcnt(" #n ")" ::: "memory")
#define G8_WAIT_L(n) asm volatile("s_waitcnt lgkmcnt(" #n ")" ::: "memory")
#define G8_BAR __builtin_amdgcn_s_barrier()
#define G8_SCHED __builtin_amdgcn_sched_barrier(0)
    Unit cur, nxt; int ui = 0;
    if (!S.next(0, cur)) return;
    f32x4 acc[2][2][4][2];
#pragma unroll
    for (int a = 0; a < 2; ++a)
#pragma unroll
        for (int b = 0; b < 2; ++b)
#pragma unroll
            for (int m = 0; m < 4; ++m)
#pragma unroll
                for (int n = 0; n < 2; ++n) acc[a][b][m][n] = (f32x4){0.f, 0.f, 0.f, 0.f};
    bf16x8 At[4][2], B0[2][2], B1[2][2];
    unsigned ac[2][2];
    ac[0][0] = S.rowoff(cur, R0) + (unsigned)C0 * 2u; ac[0][1] = S.rowoff(cur, R1) + (unsigned)C1 * 2u;
    ac[1][0] = S.rowoff(cur, HALF + R0) + (unsigned)C0 * 2u; ac[1][1] = S.rowoff(cur, HALF + R1) + (unsigned)C1 * 2u;
    const char* cB = cur.B;
    G8_STAGEB(G8_SB(0, 0), cB); G8_STAGEB(G8_SB(0, 1), cB + hstepB); G8_STAGEA(G8_SA(0, 0), ac, 0, 0); G8_STAGEA(G8_SA(0, 1), ac, 1, 0);
    if (wr == 1) G8_BAR;
    G8_WAIT_V(2); G8_BAR;
    G8_STAGEB(G8_SB(1, 0), cB + kstep); G8_STAGEA(G8_SA(1, 0), ac, 0, kstep); G8_STAGEB(G8_SB(1, 1), cB + hstepB + kstep);
    G8_WAIT_V(6); G8_BAR;
    for (;;) {
        const bool has_next = S.next(ui + 1, nxt);
        const char* nB = has_next ? nxt.B : cB;
#pragma unroll 1
        for (int t = 0; t < nt; t += 2) {
            const bool last = (t == nt - 2);
            const unsigned k1 = (unsigned)(t + 1) * kstep;
            const unsigned k2 = last ? 0u : (unsigned)(t + 2) * kstep;
            const unsigned k3 = k2 + kstep;
            const char* b2 = last ? nB : cB + k2; const char* b3 = b2 + kstep;
            G8_LDB(B0, 0, 0); G8_LDB(B1, 0, 1); G8_SCHED; G8_LDA(At, 0, 0); G8_STAGEA(G8_SA(1, 1), ac, 1, k1);
            if (last && has_next) {
                ac[0][0] = S.rowoff(nxt, R0) + (unsigned)C0 * 2u; ac[0][1] = S.rowoff(nxt, R1) + (unsigned)C1 * 2u;
                ac[1][0] = S.rowoff(nxt, HALF + R0) + (unsigned)C0 * 2u; ac[1][1] = S.rowoff(nxt, HALF + R1) + (unsigned)C1 * 2u;
            }
            G8_WAIT_V(8); G8_WAIT_L(0); G8_BAR; G8_MMA(0, 0, At, B0); G8_MMA(0, 1, At, B1); G8_BAR; G8_SCHED;
            G8_LDA(At, 0, 1); G8_STAGEB(G8_SB(0, 0), b2); G8_STAGEB(G8_SB(0, 1), b2 + hstepB); G8_STAGEA(G8_SA(0, 0), ac, 0, k2);
            G8_WAIT_V(8); G8_WAIT_L(0); G8_BAR; G8_MMA(1, 0, At, B0); G8_MMA(1, 1, At, B1); G8_BAR; G8_SCHED;
            G8_LDB(B0, 1, 0); G8_LDB(B1, 1, 1); G8_SCHED; G8_LDA(At, 1, 0); G8_STAGEA(G8_SA(0, 1), ac, 1, k2);
            G8_WAIT_V(8); G8_WAIT_L(0); G8_BAR; G8_MMA(0, 0, At, B0); G8_MMA(0, 1, At, B1); G8_BAR; G8_SCHED;
            G8_LDA(At, 1, 1); G8_STAGEB(G8_SB(1, 0), b3); G8_STAGEB(G8_SB(1, 1), b3 + hstepB); G8_STAGEA(G8_SA(1, 0), ac, 0, k3);
            G8_WAIT_V(8); G8_WAIT_L(0); G8_BAR; G8_MMA(1, 0, At, B0); G8_MMA(1, 1, At, B1); G8_BAR; G8_SCHED;
        }
        if (wr == 0) G8_BAR;
        E(acc, cur, wr, wc, fr, fq);
        if (!has_next) break;
#pragma unroll
        for (int a = 0; a < 2; ++a)
#pragma unroll
            for (int b = 0; b < 2; ++b)
#pragma unroll
                for (int m = 0; m < 4; ++m)
#pragma unroll
                    for (int n = 0; n < 2; ++n) acc[a][b][m][n] = (f32x4){0.f, 0.f, 0.f, 0.f};
        cur = nxt; cB = nB; ++ui;
        if (wr == 1) G8_BAR;
    }
    G8_WAIT_V(0);
    G8_BAR;
#undef G8_SA
#undef G8_SB
#undef G8_STAGEA
#undef G8_STAGEB
#undef G8_LDA
#undef G8_LDB
#undef G8_MMA
#undef G8_WAIT_V
#undef G8_WAIT_L
#undef G8_BAR
#undef G8_SCHED
}
}

struct CvDesc { const float* W; bf16* WT; int ldw, ldo, k0, n0, kind, aux; };
struct RmId   { __device__ __forceinline__ int operator()(int n) const { return n; } };
struct RmGate { int up; __device__ __forceinline__ int operator()(int h) const { return 256 * (h >> 7) + 128 * ((h >> 2) & 1) + 32 * ((h >> 5) & 3) + 16 * up + 4 * ((h >> 3) & 3) + (h & 3); } };
struct RmPerm { __device__ __forceinline__ int operator()(int c) const { const int q = c & 31; return (c & ~31) + 16 * ((q >> 2) & 1) + 4 * (q >> 3) + (q & 3); } };
struct RmIn   { __device__ __forceinline__ int operator()(int n) const {
    const bool rope = (n < 512) || (n >= OFF_RQ && n < OFF_RQ + 512);
    const bool tokmaj = (n >= OFF_NK && n < OFF_NV) || (n >= OFF_RG);
    const int d = n & 127; return rope ? ((n & ~127) + 32 * ((d >> 4) & 3) + 16 * (d >> 6) + (d & 15)) : (tokmaj ? RmPerm{}(n) : n); } };

__device__ __forceinline__ int cv_rowmap(const CvDesc& d, int n) { return d.kind == 1 ? RmGate{d.aux}(n) : (d.kind == 2 ? RmPerm{}(n) : (d.kind == 3 ? RmIn{}(n) : n)); }
__device__ __forceinline__ void cv_load(const CvDesc& d, int lane, float (&buf)[32]) {
    const float* p = d.W + (size_t)(d.k0 + (lane >> 5)) * d.ldw + d.n0 + (lane & 31);
#pragma unroll
    for (int i = 0; i < 32; ++i) buf[i] = __builtin_nontemporal_load(p + (size_t)(2 * i) * d.ldw);
}
__device__ __forceinline__ void cv_store(const CvDesc& d, int lane, const float (&buf)[32], LAS float* scr) {
#pragma unroll
    for (int i = 0; i < 32; ++i) scr[(2 * i + (lane >> 5)) * 33 + (lane & 31)] = buf[i];
    LDS_WAIT(); asm volatile("" ::: "memory");
    const int c = lane & 7;
#pragma unroll
    for (int j = 0; j < 4; ++j) { const int n = (lane >> 3) + 8 * j; const LAS float* sp = scr + (8 * c) * 33 + n;
        u32x4 o; o.x = pk2(sp[0 * 33], sp[1 * 33]); o.y = pk2(sp[2 * 33], sp[3 * 33]); o.z = pk2(sp[4 * 33], sp[5 * 33]); o.w = pk2(sp[6 * 33], sp[7 * 33]);
        *(u32x4*)(d.WT + (size_t)cv_rowmap(d, d.n0 + n) * d.ldo + d.k0 + 8 * c) = o; }
    LDS_WAIT(); asm volatile("" ::: "memory");
}
constexpr int I_E1 = 3 * 32 * 256;
__device__ __forceinline__ CvDesc cv_expert(const Ctx& F, int l, int q) {
    const int mat = q >> 13, r = q & 8191, le = l * 32 + (r >> 8), w = r & 255; CvDesc d;
    if (mat < 2) { d.W = (mat ? F.a->in[19] : F.a->in[18]) + (size_t)le * 1024 * 512; d.ldw = 512; d.WT = (bf16*)(F.ws + WS_WGU) + (size_t)le * 1024 * 1024; d.ldo = 1024; d.kind = 1; d.aux = mat; d.k0 = 64 * (w >> 4); d.n0 = 32 * (w & 15); }
    else { d.W = F.a->in[20] + (size_t)le * 512 * 1024; d.ldw = 1024; d.WT = (bf16*)(F.ws + WS_WDN) + (size_t)le * 1024 * 512; d.ldo = 512; d.kind = 2; d.aux = 0; d.k0 = 64 * (w >> 5); d.n0 = 32 * (w & 31); }
    return d;
}
constexpr int I_IN = 16 * 112, I_OUT = 16 * 32, I_POOL = 4 * 32;
__device__ __forceinline__ CvDesc cv_phase0(const Ctx& F, int r, int nexp) {
    if (r < nexp) return cv_expert(F, r < I_E1 ? 0 : 1, r < I_E1 ? r : r - I_E1);
    r -= nexp; CvDesc d; d.aux = 0;
    if (r < I_IN) { d.W = F.a->in[8]; d.ldw = IN_COLS; d.WT = (bf16*)(F.ws + WS_WIN); d.ldo = 1024; d.kind = 3; d.k0 = 64 * (r / 112); d.n0 = 32 * (r % 112); return d; }
    r -= I_IN;
    if (r < I_OUT) { d.W = F.a->in[9]; d.ldw = 1024; d.WT = (bf16*)(F.ws + WS_WOUT); d.ldo = 1024; d.kind = 2; d.k0 = 64 * (r >> 5); d.n0 = 32 * (r & 31); return d; }
    r -= I_OUT;
    { const int g = r >> 5, q = r & 31; d.W = F.a->in[12] + (size_t)g * 65536; d.ldw = 256; d.WT = (bf16*)(F.ws + WS_WPOOL) + (size_t)g * 65536; d.ldo = 256; d.kind = 2; d.k0 = 64 * (q >> 3); d.n0 = 32 * (q & 7); return d; }
}
#define CV_RUN(first, end, stride, GEN) do { float bA_[32], bB_[32]; const int end_ = (end), st_ = (stride); \
    for (int it_ = (first); it_ < end_; it_ += 2 * st_) { const bool h1_ = it_ + st_ < end_; \
        const CvDesc dA_ = GEN(it_); const CvDesc dB_ = GEN(h1_ ? it_ + st_ : it_); \
        cv_load(dA_, F.lane, bA_); cv_load(dB_, F.lane, bB_);     \
        cv_store(dA_, F.lane, bA_, scr); if (h1_) cv_store(dB_, F.lane, bB_, scr); } } while (0)
__device__ __forceinline__ void phase0(const Ctx& F) {
    LAS float* sil = (LAS float*)F.lds;
    LAS float* red = (LAS float*)(F.lds + 17 * 1024 * 4);
    float* mod = (float*)(F.ws + WS_MOD);
    for (int it = F.bid; it < 192; it += F.G) {
        const int l = it / 96, col0 = (it % 96) * 64;
        for (int idx = F.tid; idx < 17 * 1024; idx += 512) { const int r = idx >> 10, k = idx & 1023; const float v = r < 16 ? F.a->in[1][r * 1024 + k] : F.a->in[3][k]; sil[idx] = silu_f(v); }
        __syncthreads();
        float a[17];
#pragma unroll
        for (int r = 0; r < 17; ++r) a[r] = 0.f;
        const int k0 = F.wave * 128;
        const float* wp = F.a->in[4] + ((size_t)l * 1024 + k0) * 6144 + col0 + F.lane;
#pragma unroll 4
        for (int kk = 0; kk < 128; ++kk) { const float w = wp[(size_t)kk * 6144];
#pragma unroll
            for (int r = 0; r < 17; ++r) a[r] += sil[r * 1024 + k0 + kk] * w; }
#pragma unroll
        for (int r = 0; r < 17; ++r) red[(F.wave * 17 + r) * 64 + F.lane] = a[r];
        __syncthreads();
        for (int idx = F.tid; idx < 17 * 64; idx += 512) { const int r = idx >> 6, cc = idx & 63; float s = F.a->in[5][l * 6144 + col0 + cc];
#pragma unroll
            for (int w8 = 0; w8 < 8; ++w8) s += red[(w8 * 17 + r) * 64 + cc];
            mod[(size_t)(l * 17 + r) * 6144 + col0 + cc] = s; }
        __syncthreads();
    }
    __syncthreads();
    LAS float* scr = (LAS float*)(F.lds + F.wave * 16384);
    const int gw = F.bid * 8 + F.wave, NGW = F.G * 8;
    const int nexp_items = (F.G == 256) ? I_E1 : 2 * I_E1;
    const int NITEMS = nexp_items + I_IN + I_OUT + I_POOL;
#define CV_GEN0(i_) cv_phase0(F, (i_), nexp_items)
    CV_RUN(gw, NITEMS, NGW, CV_GEN0);
#undef CV_GEN0
}
__device__ __forceinline__ void convert_tail(const Ctx& F, int vc, int first, int lo, int hi) {
    if (F.G != 256) return;
    if (first >= F.G) first = 0;
    if (vc < first) return;
    LAS float* scr = (LAS float*)(F.lds + F.wave * 16384);
    const int nw = (F.G - first) * 8;
#define CV_GEN1(i_) cv_expert(F, 1, (i_))
    CV_RUN(lo + (vc - first) * 8 + F.wave, hi, nw, CV_GEN1);
#undef CV_GEN1
}

__device__ __forceinline__ void p1_load(const Ctx& F, int row, f32x4 (&b)[4]) {
    const float* src = row < T ? F.a->in[0] + (size_t)row * D : F.a->in[2] + (size_t)(row - T) * D;
#pragma unroll
    for (int j = 0; j < 4; ++j) b[j] = *(const f32x4*)(src + 4 * F.lane + 256 * j);
}
__device__ __forceinline__ void p1_row(const Ctx& F, int row, const f32x4 (&v)[4], f32x4 (&sh)[4], f32x4 (&sc)[4], int& mr_cur) {
    const int mr = row < T ? (row >> 11) : 16;
    if (mr != mr_cur) { mr_cur = mr;
#pragma unroll
        for (int j = 0; j < 4; ++j) { sh[j] = *(const f32x4*)(modp(F, 0, mr, 0) + 4 * F.lane + 256 * j); sc[j] = *(const f32x4*)(modp(F, 0, mr, 1) + 4 * F.lane + 256 * j) + 1.0f; } }
    unsigned long long* o8 = (unsigned long long*)((bf16*)(F.ws + WS_XA) + (size_t)row * D) + F.lane;
#pragma unroll
    for (int j = 0; j < 4; ++j) { const f32x4 y = v[j] * sc[j] + sh[j];
        o8[64 * j] = (unsigned long long)pk2(y.x, y.y) | ((unsigned long long)pk2(y.z, y.w) << 32); }
}
__device__ __forceinline__ void phase1(const Ctx& F) {
    const int gw = F.bid * 8 + F.wave, NGW = F.G * 8;
    const int per = (T + TC + NGW - 1) / NGW, r_lo = gw * per, r_hi = min(r_lo + per, T + TC);
    if (r_lo >= r_hi) return;
    f32x4 A[4], B[4], sh[4], sc[4]; int mr_cur = -1;
    p1_load(F, r_lo, A);
    for (int row = r_lo; row < r_hi; row += 2) {
        if (row + 1 < r_hi) p1_load(F, row + 1, B);
        asm volatile("" ::: "memory");
        p1_row(F, row, A, sh, sc, mr_cur);
        if (row + 1 < r_hi) {
            if (row + 2 < r_hi) p1_load(F, row + 2, A);
            asm volatile("" ::: "memory");
            p1_row(F, row + 1, B, sh, sc, mr_cur);
        }
    }
}

struct SchedIn {
    int G, c; const char* Wt;
    __device__ __forceinline__ bool next(int i, g8::Unit& u) const {
        const int L = i * G + c; if (L >= 1792 + 128) return false;
        int pm, pn; if (L < 1792) g8::tile_of(L, 128, 14, pm, pn); else { g8::tile_of(L - 1792, 16, 8, pm, pn); pm += 128; }
        u.pm = pm; u.pn = pn; u.e = 0; u.aux = 0; u.B = Wt + (size_t)pn * 256 * 1024 * 2; return true; }
    __device__ __forceinline__ unsigned rowoff(const g8::Unit& u, int r) const { return (unsigned)(u.pm * 256 + r) * 2048u; }
};
struct EpiIn {
    unsigned char* ws; unsigned char* dout; LAS unsigned char* lds;
    __device__ __forceinline__ void tstore(const f32x4 (&v)[4], LAS bf16* scr, bf16* dst0, size_t colpitch, int lane, int fr, int fq) const {
#pragma unroll
        for (int m = 0; m < 4; ++m)
#pragma unroll
            for (int j = 0; j < 4; j += 2) { const unsigned w = pk2(v[m][j], v[m][j + 1]); scr[(4 * fq + j) * 72 + 16 * m + fr] = (bf16)(w & 0xffffu); scr[(4 * fq + j + 1) * 72 + 16 * m + fr] = (bf16)(w >> 16); }
        LDS_WAIT(); asm volatile("" ::: "memory");
#pragma unroll
        for (int i = 0; i < 2; ++i) { const int q = lane + 64 * i, cc = q >> 3, ch = q & 7;
            const u32x4 w = *(const LAS u32x4*)(scr + cc * 72 + ch * 8);
            *(u32x4*)(dst0 + (size_t)cc * colpitch + ch * 8) = w; }
        LDS_WAIT(); asm volatile("" ::: "memory");
    }
    __device__ __forceinline__ void operator()(const f32x4 (&acc)[2][2][4][2], const g8::Unit& u, int wr, int wc, int fr, int fq) const {
        const bool isctx = u.pm >= 128;
        const int lane = fr + 16 * fq, wid = wr * 4 + wc;
        LAS bf16* scr = (LAS bf16*)(lds + LDS_SCR_OFF + wid * 2304);
        const int row0 = u.pm * 256 + wr * 64 + fr;
        const int bb = isctx ? (u.pm - 128) : (u.pm >> 3);
        const int tt0 = isctx ? 0 : ((u.pm & 7) * 256);
        const size_t tp = isctx ? CTXL : TPITCH;
        const int pn = u.pn;
        if (pn < 2 || pn == 8 || pn == 9) {
            const float scale = (pn >= 8) ? 0.08838834764831845f : 1.0f;
            const int dd = 16 * wc + 4 * fq;
            f32x4 invf;
#pragma unroll
            for (int j = 0; j < 4; ++j) invf[j] = fexp2(-(float)((dd & 31) + j) * (13.287712379549449f / 32.0f));
#pragma unroll
            for (int ai = 0; ai < 2; ++ai)
#pragma unroll
                for (int bj = 0; bj < 2; ++bj) {
                    f32x4 o1[4], o2[4];
#pragma unroll
                    for (int m = 0; m < 4; ++m) { const int row = row0 + ai * 128 + m * 16;
                        f32x4 cs = (f32x4){1.f, 1.f, 1.f, 1.f}, sn = (f32x4){0.f, 0.f, 0.f, 0.f};
                        if (!isctx) { const float pos = (float)((wc < 2) ? (4 * (u.pm & 7) + wr + 2 * ai) : (fr + 16 * m));
#pragma unroll
                            for (int j = 0; j < 4; ++j) { const float ang = pos * invf[j]; cs[j] = __cosf(ang); sn[j] = __sinf(ang); } }
                        const f32x4 x1 = acc[ai][bj][m][0], x2 = acc[ai][bj][m][1];
                        o1[m] = (x1 * cs - x2 * sn) * scale; o2[m] = (x1 * sn + x2 * cs) * scale;
                        if (!isctx) { bf16* rp = (bf16*)(ws + WS_P) + (size_t)row * PW + (pn < 2 ? PO_RK + pn * 256 : PO_RQ + (pn - 8) * 256) + bj * 128 + dd;
                            *(u32x2*)(rp) = (u32x2){pk2(o1[m].x, o1[m].y), pk2(o1[m].z, o1[m].w)};
                            *(u32x2*)(rp + 64) = (u32x2){pk2(o2[m].x, o2[m].y), pk2(o2[m].z, o2[m].w)}; } }
                    if (pn < 2) {
                        const int head = pn * 2 + bj;
                        bf16* d0 = (bf16*)(dout + (isctx ? DO_KTRC : DO_KTR)) + ((size_t)(bb * 4 + head) * 128 + 16 * wc) * tp + tt0 + ai * 128 + wr * 64;
                        tstore(o1, scr, d0, tp, lane, fr, fq);
                        tstore(o2, scr, d0 + (size_t)64 * tp, tp, lane, fr, fq);
                    }
                }
        } else if (pn == 2 || pn == 3 || pn == 6 || pn == 7) {
#pragma unroll
            for (int ai = 0; ai < 2; ++ai)
#pragma unroll
                for (int bj = 0; bj < 2; ++bj)
#pragma unroll
                    for (int n = 0; n < 2; ++n) {
                        const int col = (pn & 1) * 256 + bj * 128 + wc * 32 + n * 16;
                        const size_t boff = (pn < 4) ? (isctx ? WS_VTRC : WS_VTR) : (isctx ? WS_VTNC : WS_VTN);
                        const size_t roff = (pn < 4) ? ((size_t)(bb * 4 + (col >> 7)) * 128 + (col & 127)) : ((size_t)(bb * 8 + (col >> 6)) * 64 + (col & 63));
                        bf16* d0 = (bf16*)(ws + boff) + roff * tp;
                        f32x4 v[4];
#pragma unroll
                        for (int m = 0; m < 4; ++m) v[m] = acc[ai][bj][m][n];
                        tstore(v, scr, d0 + tt0 + ai * 128 + wr * 64, tp, lane, fr, fq);
                    }
        } else {
            const float scale = (pn >= 12) ? 0.125f : 1.0f;
            int ld = PW, c0; size_t boff = WS_P;
            if (pn < 6) { if (isctx) { boff = WS_PC; ld = PCW; } c0 = (isctx ? 0 : PO_NK) + (pn - 4) * 256; }
            else if (pn < 12) { c0 = PO_RG + (pn - 10) * 256; }
            else { c0 = PO_NQ + (pn - 12) * 256; }
            bf16* base = (bf16*)(ws + boff);
            const int rsub = isctx ? T : 0;
            const int col0 = c0 + wc * 32 + 8 * fq;
#pragma unroll
            for (int ai = 0; ai < 2; ++ai)
#pragma unroll
                for (int m = 0; m < 4; ++m) { bf16* rp = base + (size_t)(row0 + ai * 128 + m * 16 - rsub) * ld + col0;
#pragma unroll
                    for (int bj = 0; bj < 2; ++bj) { const f32x4 v0 = acc[ai][bj][m][0] * scale, v1 = acc[ai][bj][m][1] * scale;
                        *(u32x4*)(rp + bj * 128) = (u32x4){pk2(v0.x, v0.y), pk2(v0.z, v0.w), pk2(v1.x, v1.y), pk2(v1.z, v1.w)}; } }
        }
    }
};

__device__ __forceinline__ void dma16(const void* g, LAS unsigned char* l) { __builtin_amdgcn_global_load_lds((const unsigned*)g, (LAS unsigned*)l, 16, 0, 0); }
__device__ __forceinline__ bf16x8 frag256(const LAS unsigned char* tile, int row, int chunk) { return *(const LAS bf16x8*)(tile + row * 256 + ((chunk ^ (row & 15)) << 4)); }
__device__ __forceinline__ void phase3(const Ctx& F) {
    const bf16* KTr = (const bf16*)((const char*)F.H + DO_KTR); const bf16* KTrc = (const bf16*)((const char*)F.H + DO_KTRC);
    const bf16* VTr = (const bf16*)(F.ws + WS_VTR); const bf16* VTrc = (const bf16*)(F.ws + WS_VTRC);
    bf16* ST = (bf16*)((char*)F.H + DO_ST);
    const int lane = F.lane, r = lane & 31, hh = lane >> 5, dkt = F.wave & 3, dvs = F.wave >> 2, w = F.wave;
    for (int u0 = F.bid; u0 < 256; u0 += F.G) {
        const int unit = (F.G == 256) ? ((u0 & 7) * 32 + (u0 >> 3)) : u0;
        const int bh = unit >> 2, dvh = (unit >> 1) & 1, dir = unit & 1, h = bh & 3;
        const float lg2 = __log2f(1.0f - __expf(F.a->in[10][dir * 4 + h]));
        const float gstep = fexp2(dir == 0 ? -lg2 : lg2);
        const float cdec = fexp2(lg2 * 128.0f);
        f32x16 acc;
#pragma unroll
        for (int i = 0; i < 16; ++i) acc[i] = 0.f;
        __syncthreads();
#define P3_STAGE(s_) do { const int s__ = (s_); const bool cx = s__ < 2; const int ci = cx ? (dir == 0 ? s__ : 1 - s__) : (dir == 0 ? s__ - 2 : 17 - s__); \
            const bf16* kb = cx ? KTrc + (size_t)bh * 128 * CTXL + ci * 128 : KTr + (size_t)bh * 128 * TPITCH + ci * 128; \
            const bf16* vb = cx ? VTrc + ((size_t)bh * 128 + dvh * 64) * CTXL + ci * 128 : VTr + ((size_t)bh * 128 + dvh * 64) * TPITCH + ci * 128; \
            const size_t pitch = cx ? (size_t)CTXL : (size_t)TPITCH; \
            _Pragma("unroll") for (int i = 0; i < 6; ++i) { const int idx = (i < 4 ? i : i - 4) * 512 + w * 64 + lane, R = idx >> 4, cc = (idx & 15) ^ (R & 15); \
                dma16((i < 4 ? kb : vb) + (size_t)R * pitch + 8 * cc, F.lds + (s__ % 3) * 49152 + (i * 512 + w * 64) * 16); } } while (0)
        P3_STAGE(0); P3_STAGE(1);
#pragma unroll 1
        for (int s = 0; s < 18; ++s) {
            if (s >= 2) {
                const int c = dir == 0 ? s - 2 : 17 - s;
                bf16* sp = ST + ((((size_t)dir * 64 + bh) * 16 + c) * 128 + dvh * 64 + dvs * 32 + r) * 128 + dkt * 32 + 4 * hh;
#pragma unroll
                for (int g = 0; g < 4; ++g) *(u32x2*)(sp + 8 * g) = (u32x2){pk2(acc[4 * g], acc[4 * g + 1]), pk2(acc[4 * g + 2], acc[4 * g + 3])};
            }
            if (s < 2) asm volatile("s_waitcnt vmcnt(6)" ::: "memory"); else if (s < 17) asm volatile("s_waitcnt vmcnt(10)" ::: "memory"); else asm volatile("s_waitcnt vmcnt(0)" ::: "memory");
            __builtin_amdgcn_s_barrier(); asm volatile("" ::: "memory");
            if (s < 16) P3_STAGE(s + 2);
            if (s < 17) {
#pragma unroll
                for (int i = 0; i < 16; ++i) acc[i] *= cdec;
                const LAS unsigned char* kt = F.lds + (s % 3) * 49152; const LAS unsigned char* vt = kt + 32768;
#pragma unroll
                for (int ks = 0; ks < 8; ++ks) {
                    const bf16x8 af = frag256(kt, 32 * dkt + r, 2 * ks + hh); const bf16x8 vv = frag256(vt, 32 * dvs + r, 2 * ks + hh); bf16x8 bfr;
                    const int tk = 16 * ks + 8 * hh; float wgt = fexp2(lg2 * (float)(dir == 0 ? (127 - tk) : tk));
                    float wv8[8];
#pragma unroll
                    for (int j = 0; j < 8; ++j) { wv8[j] = bf2f((unsigned short)vv[j]) * wgt; wgt *= gstep; }
                    bfr = pack8((f32x4){wv8[0], wv8[1], wv8[2], wv8[3]}, (f32x4){wv8[4], wv8[5], wv8[6], wv8[7]});
                    acc = __builtin_amdgcn_mfma_f32_32x32x16_bf16(af, bfr, acc, 0, 0, 0);
                }
            }
        }
        asm volatile("s_waitcnt vmcnt(0) lgkmcnt(0)" ::: "memory");
        __syncthreads();
#undef P3_STAGE
    }
}

__device__ __forceinline__ void ret_unit(const Ctx& F, int unit) {
    const bf16* P = (const bf16*)(F.ws + WS_P); const bf16* ST = (const bf16*)((const char*)F.H + DO_ST); const bf16* VTr = (const bf16*)(F.ws + WS_VTR); bf16* Y = (bf16*)(F.ws + WS_XA);
    int lane = F.lane; asm volatile("" : "+v"(lane));
    const int li = lane & 15, kq = lane >> 4, w = F.wave;
    const int b = unit >> 6, h = (unit >> 4) & 3, c = unit & 15, bh = b * 4 + h;
    const size_t tok0 = (size_t)b * SEQ + c * 128;
    const int i0 = 16 * w;
    const float lgf = __log2f(1.0f - __expf(F.a->in[10][h])), lgb = __log2f(1.0f - __expf(F.a->in[10][4 + h]));
    constexpr int T_ST0 = 0, T_K = 65536, T_V = 98304;
    __syncthreads();
#pragma unroll
    for (int i = 0; i < 16; ++i) { const int tile = i >> 2; const int idx = (i & 3) * 512 + w * 64 + lane, R = idx >> 4, cc = (idx & 15) ^ (R & 15);
        const bf16* src;
        if (tile < 2) src = ST + ((((size_t)tile * 64 + bh) * 16 + c) * 128 + R) * 128 + 8 * cc;
        else if (tile == 2) src = P + (tok0 + R) * PW + PO_RK + h * 128 + 8 * cc;
        else src = VTr + ((size_t)bh * 128 + R) * TPITCH + c * 128 + 8 * cc;
        dma16(src, F.lds + (i * 512 + w * 64) * 16); }
    bf16x8 qf[4];
    { const bf16* qp = P + (tok0 + i0 + li) * PW + PO_RQ + h * 128 + 8 * kq;
#pragma unroll
      for (int ks = 0; ks < 4; ++ks) qf[ks] = *(const bf16x8*)(qp + 32 * ks); }
    asm volatile("s_waitcnt vmcnt(0)" ::: "memory");
    __syncthreads();
    f32x4 O[8];
#pragma unroll
    for (int dirn = 0; dirn < 2; ++dirn) {
        const LAS unsigned char* tl = F.lds + T_ST0 + dirn * 32768;
        float rs[4];
#pragma unroll
        for (int jj = 0; jj < 4; ++jj) { const int i = i0 + 4 * kq + jj; rs[jj] = dirn == 0 ? fexp2(lgf * (float)(i + 1)) : fexp2(lgb * (float)(128 - i)); }
#pragma unroll
        for (int nt = 0; nt < 8; ++nt) { f32x4 a = (f32x4){0.f, 0.f, 0.f, 0.f};
#pragma unroll
            for (int ks = 0; ks < 4; ++ks) a = __builtin_amdgcn_mfma_f32_16x16x32_bf16(qf[ks], frag256(tl, 16 * nt + li, 4 * ks + kq), a, 0, 0, 0);
#pragma unroll
            for (int jj = 0; jj < 4; ++jj) { const float v = a[jj] * rs[jj]; if (dirn == 0) O[nt][jj] = v; else O[nt][jj] += v; } }
    }
    bf16x8 pf[4];
    const int krow = 8 * (li >> 2) + (li & 3);
#pragma unroll
    for (int u = 0; u < 4; ++u) {
        f32x4 s2[2];
#pragma unroll
        for (int hf = 0; hf < 2; ++hf) { f32x4 a = (f32x4){0.f, 0.f, 0.f, 0.f};
#pragma unroll
            for (int ks = 0; ks < 4; ++ks) a = __builtin_amdgcn_mfma_f32_16x16x32_bf16(frag256(F.lds + T_K, 32 * u + krow + 4 * hf, 4 * ks + kq), qf[ks], a, 0, 0, 0);
#pragma unroll
            for (int jj = 0; jj < 4; ++jj) { const int dlt = (i0 + li) - (32 * u + 8 * kq + 4 * hf + jj);
                const float ex = fexp2((dlt > 0 ? lgf : lgb) * fabsf((float)dlt));
                a[jj] *= (dlt == 0) ? 2.0f : ex; }
            s2[hf] = a; }
        pf[u] = pack8(s2[0], s2[1]);
    }
#pragma unroll
    for (int u = 0; u < 4; ++u)
#pragma unroll
        for (int nt = 0; nt < 8; ++nt) O[nt] = __builtin_amdgcn_mfma_f32_16x16x32_bf16(pf[u], frag256(F.lds + T_V, 16 * nt + li, 4 * u + kq), O[nt], 0, 0, 0);
    __syncthreads();
    LAS float* osc = (LAS float*)(F.lds + w * 8448);
#pragma unroll
    for (int jj = 0; jj < 4; ++jj) {
        float sm = 0.f;
#pragma unroll
        for (int nt = 0; nt < 8; ++nt) sm += O[nt][jj];
        sm += __shfl_xor(sm, 1); sm += __shfl_xor(sm, 2); sm += __shfl_xor(sm, 4); sm += __shfl_xor(sm, 8);
        const float mean = sm * (1.0f / 128.0f); float q = 0.f;
#pragma unroll
        for (int nt = 0; nt < 8; ++nt) { const float d = O[nt][jj] - mean; q += d * d; }
        q += __shfl_xor(q, 1); q += __shfl_xor(q, 2); q += __shfl_xor(q, 4); q += __shfl_xor(q, 8);
        const float rstd = __builtin_amdgcn_rsqf(q * (1.0f / 128.0f) + LN_EPS);
#pragma unroll
        for (int nt = 0; nt < 8; ++nt) osc[(4 * kq + jj) * 132 + 16 * nt + li] = (O[nt][jj] - mean) * rstd;
    }
    LDS_WAIT(); asm volatile("" ::: "memory");
#pragma unroll
    for (int i = 0; i < 4; ++i) { const int q = lane + 64 * i, row = q >> 4, ch = q & 15; const size_t tk = tok0 + i0 + row;
        const f32x4 a = *(const LAS f32x4*)(osc + row * 132 + 8 * ch), c2 = *(const LAS f32x4*)(osc + row * 132 + 8 * ch + 4);
        const u32x4 g = *(const u32x4*)(P + tk * PW + PO_RG + h * 128 + 8 * ch);
        u32x4 o;
        o.x = pk2(silu_f(bflo(g.x)) * a.x, silu_f(bfhi(g.x)) * a.y); o.y = pk2(silu_f(bflo(g.y)) * a.z, silu_f(bfhi(g.y)) * a.w);
        o.z = pk2(silu_f(bflo(g.z)) * c2.x, silu_f(bfhi(g.z)) * c2.y); o.w = pk2(silu_f(bflo(g.w)) * c2.z, silu_f(bfhi(g.w)) * c2.w);
        if (ABL & 32) o = (u32x4){0u, 0u, 0u, 0u};
        *(u32x4*)(Y + tk * D + h * 128 + 8 * ch) = o; }
    LDS_WAIT(); asm volatile("" ::: "memory");
}
__device__ __forceinline__ void na_unit(const Ctx& F, int unit, bool load_ctx) {
    const bf16* P = (const bf16*)(F.ws + WS_P); const bf16* Pc = (const bf16*)(F.ws + WS_PC); bf16* Y = (bf16*)(F.ws + WS_XA);
    const bf16* VTn = (const bf16*)(F.ws + WS_VTN); const bf16* VTnc = (const bf16*)(F.ws + WS_VTNC);
    int lane = F.lane; asm volatile("" : "+v"(lane));
    const int li = lane & 15, kq = lane >> 4, w = F.wave;
    const int b = unit >> 7, nh = (unit >> 4) & 7, rp = unit & 15;
    const int r = 2 * rp + (w >> 2), cb = w & 3;
    const int rmin = min(max(2 * rp - 4, 0), GROWS - 8);
    const int r0 = min(max(r - 4, 0), GROWS - 8), kstart = min(max(16 * cb - 8, 0), GRIDW - 32);
    const int qc = 16 * cb + li; const int wstart = min(max(qc - 8, 0), GRIDW - 16);
    const size_t tokb = (size_t)b * SEQ;
    const int krow = 8 * (li >> 2) + (li & 3);
    constexpr int L_CTX = 73728, L_TBL = 106496, L_CTXV = 108544;
    __syncthreads();
#pragma unroll
    for (int i = 0; i < 13; ++i) { const int idx = i * 512 + w * 64 + lane; const bf16* src;
        if (i < 9) { const int R = idx >> 3, cc = (idx & 7) ^ (R & 7); const int kr = min(rmin + (R >> 6), GROWS - 1);
            src = P + (tokb + kr * 64 + (R & 63)) * PW + PO_NK + nh * 64 + 8 * cc; }
        else { if (!load_ctx) continue; const int id2 = idx - 4608, R = id2 >> 3, cc = (id2 & 7) ^ (R & 7); src = Pc + ((size_t)b * CTXL + R) * PCW + nh * 64 + 8 * cc; }
        dma16(src, F.lds + (i * 512 + w * 64) * 16); }
    if (load_ctx) {
#pragma unroll
        for (int i = 0; i < 4; ++i) { const int id2 = i * 512 + w * 64 + lane, Rd = id2 >> 5, cc = (id2 & 31) ^ (Rd & 7);
            dma16(VTnc + ((size_t)(b * 8 + nh) * 64 + Rd) * CTXL + 8 * cc, F.lds + L_CTXV + (i * 512 + w * 64) * 16); } }
    LAS float* tbl = (LAS float*)(F.lds + L_TBL);
    for (int q = F.tid; q < 15 * 32; q += 512) { const int rr = q >> 5, cc = q & 31; tbl[q] = cc < 31 ? F.a->in[11][(size_t)(nh * 15 + rr) * 31 + cc] : -3.0e38f; }
    bf16x8 qf[2];
    { const bf16* qp = P + (tokb + r * 64 + qc) * PW + PO_NQ + nh * 64 + 8 * kq; qf[0] = *(const bf16x8*)qp; qf[1] = *(const bf16x8*)(qp + 32); }
    asm volatile("s_waitcnt vmcnt(0)" ::: "memory");
    __syncthreads();
    f32x4 sw[16], sc[16];
    float mx = -3.0e38f;
#pragma unroll
    for (int wt = 0; wt < 16; ++wt) {
        const int kr = r0 + (wt >> 1);
        f32x4 a;
#pragma unroll
        for (int jj = 0; jj < 4; ++jj) { const int kc = kstart + 8 * kq + 4 * (wt & 1) + jj; const bool ok = (kc >= wstart) && (kc < wstart + 16);
            const int cbi = ok ? (kc - qc + 15) : 31; a[jj] = tbl[(kr - r + 7) * 32 + cbi]; }
        const int R = (kr - rmin) * 64 + kstart + krow + 4 * (wt & 1);
        const LAS unsigned char* rowp = F.lds + R * 128;
        a = __builtin_amdgcn_mfma_f32_16x16x32_bf16(*(const LAS bf16x8*)(rowp + ((kq ^ (R & 7)) << 4)), qf[0], a, 0, 0, 0);
        a = __builtin_amdgcn_mfma_f32_16x16x32_bf16(*(const LAS bf16x8*)(rowp + (((4 + kq) ^ (R & 7)) << 4)), qf[1], a, 0, 0, 0);
#pragma unroll
        for (int jj = 0; jj < 4; ++jj) mx = fmaxf(mx, a[jj]);
        sw[wt] = a;
    }
#pragma unroll
    for (int ct = 0; ct < 16; ++ct) {
        const int R = 32 * (ct >> 1) + krow + 4 * (ct & 1);
        const LAS unsigned char* rowp = F.lds + L_CTX + R * 128;
        f32x4 a = (f32x4){0.f, 0.f, 0.f, 0.f};
        a = __builtin_amdgcn_mfma_f32_16x16x32_bf16(*(const LAS bf16x8*)(rowp + ((kq ^ (R & 7)) << 4)), qf[0], a, 0, 0, 0);
        a = __builtin_amdgcn_mfma_f32_16x16x32_bf16(*(const LAS bf16x8*)(rowp + (((4 + kq) ^ (R & 7)) << 4)), qf[1], a, 0, 0, 0);
#pragma unroll
        for (int jj = 0; jj < 4; ++jj) mx = fmaxf(mx, a[jj]);
        sc[ct] = a;
    }
    __syncthreads();
#pragma unroll
    for (int i = 0; i < 13; ++i) { const int idx = i * 512 + w * 64 + lane; const bf16* src;
        if (i < 9) { const int Rd = idx / 72, q = idx - Rd * 72, cc = q ^ (Rd & 7); const int kr = min(rmin + (cc >> 3), GROWS - 1);
            src = VTn + ((size_t)(b * 8 + nh) * 64 + Rd) * TPITCH + kr * 64 + (cc & 7) * 8; }
        else continue;
        dma16(src, F.lds + (i * 512 + w * 64) * 16); }
    mx = fmaxf(mx, __shfl_xor(mx, 16)); mx = fmaxf(mx, __shfl_xor(mx, 32));
    float sum = 0.f;
#pragma unroll
    for (int wt = 0; wt < 16; ++wt)
#pragma unroll
        for (int jj = 0; jj < 4; ++jj) { const float e = __expf(sw[wt][jj] - mx); sw[wt][jj] = e; sum += e; }
#pragma unroll
    for (int ct = 0; ct < 16; ++ct)
#pragma unroll
        for (int jj = 0; jj < 4; ++jj) { const float e = __expf(sc[ct][jj] - mx); sc[ct][jj] = e; sum += e; }
    sum += __shfl_xor(sum, 16); sum += __shfl_xor(sum, 32);
    asm volatile("s_waitcnt vmcnt(0)" ::: "memory");
    __syncthreads();
    f32x4 O[4];
#pragma unroll
    for (int nt = 0; nt < 4; ++nt) O[nt] = (f32x4){0.f, 0.f, 0.f, 0.f};
#pragma unroll
    for (int u = 0; u < 8; ++u) { bf16x8 pf;
        pf = pack8(sw[2 * u], sw[2 * u + 1]);
        const int cch = (r0 + u - rmin) * 8 + (kstart >> 3) + kq;
#pragma unroll
        for (int nt = 0; nt < 4; ++nt) { const int Rd = 16 * nt + li;
            O[nt] = __builtin_amdgcn_mfma_f32_16x16x32_bf16(pf, *(const LAS bf16x8*)(F.lds + Rd * 1152 + ((cch ^ (Rd & 7)) << 4)), O[nt], 0, 0, 0); } }
#pragma unroll
    for (int u = 0; u < 8; ++u) { bf16x8 pf;
        pf = pack8(sc[2 * u], sc[2 * u + 1]);
#pragma unroll
        for (int nt = 0; nt < 4; ++nt) { const int Rd = 16 * nt + li;
            O[nt] = __builtin_amdgcn_mfma_f32_16x16x32_bf16(pf, *(const LAS bf16x8*)(F.lds + L_CTXV + Rd * 512 + (((4 * u + kq) ^ (Rd & 7)) << 4)), O[nt], 0, 0, 0); } }
    __syncthreads();
    LAS float* osc = (LAS float*)(F.lds + w * 4352);
#pragma unroll
    for (int jj = 0; jj < 4; ++jj) {
        const float sq = __shfl(sum, 4 * kq + jj); const float inv = frcp(sq);
#pragma unroll
        for (int nt = 0; nt < 4; ++nt) osc[(4 * kq + jj) * 68 + 16 * nt + li] = O[nt][jj] * inv;
    }
    LDS_WAIT(); asm volatile("" ::: "memory");
#pragma unroll
    for (int i = 0; i < 2; ++i) { const int q = lane + 64 * i, row = q >> 3, ch = q & 7;
        const f32x4 a = *(const LAS f32x4*)(osc + row * 68 + 8 * ch), c2 = *(const LAS f32x4*)(osc + row * 68 + 8 * ch + 4);
        u32x4 o = (u32x4){pk2(a.x, a.y), pk2(a.z, a.w), pk2(c2.x, c2.y), pk2(c2.z, c2.w)};
        if (ABL & 16) o = (u32x4){0u, 0u, 0u, 0u};
        *(u32x4*)(Y + (tokb + r * 64 + 16 * cb + row) * D + 512 + nh * 64 + 8 * ch) = o; }
    LDS_WAIT(); asm volatile("" ::: "memory");
}
__device__ __forceinline__ void phase4(const Ctx& F) {
#ifndef P4MASK
#define P4MASK 3
#endif
    if (P4MASK & 1) for (int u = F.bid; u < 1024; u += F.G) ret_unit(F, u);
    if (P4MASK & 2) {
        if (F.G == 256) { const int vb = (F.bid & 7) * 32 + (F.bid >> 3);
            for (int k = 0; k < 8; ++k) na_unit(F, vb * 8 + k, k == 0); }
        else for (int u = F.bid; u < 2048; u += F.G) na_unit(F, u, true);
    }
}

struct SchedOut {
    int G, c; const char* Wt;
    __device__ __forceinline__ bool next(int i, g8::Unit& u) const {
        const int L = i * G + c; if (L >= 512) return false;
        int pm, pn; g8::tile_of(L, 128, 4, pm, pn); u.pm = pm; u.pn = pn; u.e = 0; u.aux = 0; u.B = Wt + (size_t)pn * 256 * 1024 * 2; return true; }
    __device__ __forceinline__ unsigned rowoff(const g8::Unit& u, int r) const { return (unsigned)(u.pm * 256 + r) * 2048u; }
};
struct EpiY {
    static constexpr bool IDEMP = true;
    bf16* Yg; const float* gate0; const float* cs; float abl;
    __device__ __forceinline__ void operator()(const f32x4 (&acc)[2][2][4][2], const g8::Unit& u, int wr, int wc, int fr, int fq) const {
        const int row0 = u.pm * 256 + wr * 64 + fr, col0 = u.pn * 256 + wc * 32 + 8 * fq;
        const float* gp = gate0 + (size_t)(row0 >> 11) * 6144 + col0;
        f32x4 gv[2][2];
#pragma unroll
        for (int bj = 0; bj < 2; ++bj)
#pragma unroll
            for (int n = 0; n < 2; ++n) { gv[bj][n] = *(const f32x4*)(gp + bj * 128 + n * 4) * abl; if (cs) gv[bj][n] *= *(const f32x4*)(cs + col0 + bj * 128 + n * 4); }
#pragma unroll
        for (int ai = 0; ai < 2; ++ai)
#pragma unroll
            for (int m = 0; m < 4; ++m) { bf16* rp = Yg + (size_t)(row0 + ai * 128 + m * 16) * D + col0;
#pragma unroll
                for (int bj = 0; bj < 2; ++bj) { const f32x4 v0 = acc[ai][bj][m][0] * gv[bj][0], v1 = acc[ai][bj][m][1] * gv[bj][1];
                    *(u32x4*)(rp + bj * 128) = (u32x4){pk2(v0.x, v0.y), pk2(v0.z, v0.w), pk2(v1.x, v1.y), pk2(v1.z, v1.w)}; } }
    }
};

struct LnVecs { f32x4 lg[4], lb[4], sh[4], sc1[4]; f32x4 br1; };
__device__ __forceinline__ void ln_load(const float* R32, const bf16* R16, const bf16* Yg, int t, int lane, f32x4 (&nr)[4], u32x2 (&ny)[4]) {
    const u32x2* yr = (const u32x2*)(Yg + (size_t)t * D) + lane;
    if (R32) { const float* rr = R32 + (size_t)t * D;
#pragma unroll
        for (int j = 0; j < 4; ++j) nr[j] = *(const f32x4*)(rr + 4 * lane + 256 * j); }
    else { const u32x2* rr = (const u32x2*)(R16 + (size_t)t * D) + lane;
#pragma unroll
        for (int j = 0; j < 4; ++j) { const u32x2 h = rr[64 * j]; nr[j] = (f32x4){bflo(h.x), bfhi(h.x), bflo(h.y), bfhi(h.y)}; } }
#pragma unroll
    for (int j = 0; j < 4; ++j) ny[j] = yr[64 * j];
}
__device__ __forceinline__ void ln_row(const Ctx& F, int l, int t, const f32x4 (&nr)[4], const u32x2 (&ny)[4], const LnVecs& V, LAS f32x4* wl, LAS u32x4* rec_slot) {
    const int lane = F.lane; const LAS float* br2l = (const LAS float*)(F.lds + 149760);
    bf16* hm = (bf16*)(F.ws + WS_XA);
    unsigned long long* hr8 = (unsigned long long*)((bf16*)(F.ws + WS_H16) + (size_t)t * D) + lane;
    f32x4 v[4]; float s = 0.f;
#pragma unroll
    for (int j = 0; j < 4; ++j) { const u32x2 y = ny[j]; v[j] = nr[j] * ALPHA + (f32x4){bflo(y.x), bfhi(y.x), bflo(y.y), bfhi(y.y)}; s += (v[j].x + v[j].y) + (v[j].z + v[j].w); }
    const float mean = wave_sum(s) * (1.0f / D); float s2 = 0.f;
#pragma unroll
    for (int j = 0; j < 4; ++j) { v[j] = v[j] - mean; s2 += (v[j].x * v[j].x + v[j].y * v[j].y) + (v[j].z * v[j].z + v[j].w * v[j].w); }
    const float rstd = __builtin_amdgcn_rsqf(wave_sum(s2) * (1.0f / D) + LN_EPS);
    unsigned long long* o8 = (unsigned long long*)(hm + (size_t)t * D) + lane;
    float pg[4] = {0.f, 0.f, 0.f, 0.f};
#pragma unroll
    for (int j = 0; j < 4; ++j) { const int ci = 4 * lane + 256 * j;
        const f32x4 h1 = v[j] * rstd * V.lg[j] + V.lb[j];
        hr8[64 * j] = (unsigned long long)pk2(h1.x, h1.y) | ((unsigned long long)pk2(h1.z, h1.w) << 32);
        const f32x4 m = h1 * V.sc1[j] + V.sh[j];
        v[j] = m;
        o8[64 * j] = (unsigned long long)pk2(m.x, m.y) | ((unsigned long long)pk2(m.z, m.w) << 32);
#pragma unroll
        for (int e = 0; e < 4; ++e) { const f32x4 w = wl[(4 * j + e) * 64 + lane];
#pragma unroll
            for (int g = 0; g < 4; ++g) pg[g] += m[e] * w[g]; } }
    float lgt[4];
#pragma unroll
    for (int g = 0; g < 4; ++g) lgt[g] = wave_sum(pg[g]) + V.br1[g];
    int grp = 0; float gm = lgt[0];
#pragma unroll
    for (int g = 1; g < 4; ++g) if (lgt[g] > gm) { gm = lgt[g]; grp = g; }
    float gs = 0.f;
#pragma unroll
    for (int g = 0; g < 4; ++g) gs += __expf(lgt[g] - gm);
    const float gate_g = 1.0f / gs;
    float pe[8] = {0.f, 0.f, 0.f, 0.f, 0.f, 0.f, 0.f, 0.f};
#pragma unroll
    for (int j = 0; j < 4; ++j) {
#pragma unroll
        for (int e = 0; e < 4; ++e) { const f32x4 wa = wl[1024 + 2048 * grp + ((4 * j + e) * 2) * 64 + lane], wb = wl[1024 + 2048 * grp + ((4 * j + e) * 2 + 1) * 64 + lane];
#pragma unroll
            for (int q = 0; q < 4; ++q) { pe[q] += v[j][e] * wa[q]; pe[4 + q] += v[j][e] * wb[q]; } } }
    float le[8];
    {
        float a4[4], a2[2], a1;
#pragma unroll
        for (int q = 0; q < 4; ++q) { const float mine = (lane & 1) ? pe[q + 4] : pe[q], send = (lane & 1) ? pe[q] : pe[q + 4]; a4[q] = mine + __shfl_xor(send, 1); }
#pragma unroll
        for (int q = 0; q < 2; ++q) { const float mine = (lane & 2) ? a4[q + 2] : a4[q], send = (lane & 2) ? a4[q] : a4[q + 2]; a2[q] = mine + __shfl_xor(send, 2); }
        { const float mine = (lane & 4) ? a2[1] : a2[0], send = (lane & 4) ? a2[0] : a2[1]; a1 = mine + __shfl_xor(send, 4); }
        a1 += __shfl_xor(a1, 8); a1 += __shfl_xor(a1, 16); a1 += __shfl_xor(a1, 32);
#pragma unroll
        for (int q = 0; q < 8; ++q) { const int src = ((q >> 2) & 1) | (((q >> 1) & 1) << 1) | ((q & 1) << 2); le[q] = __shfl(a1, src) + br2l[grp * 8 + q]; }

    }
    int i0 = 0; float v0 = le[0];
#pragma unroll
    for (int q = 1; q < 8; ++q) if (le[q] > v0) { v0 = le[q]; i0 = q; }
    int i1 = -1; float v1 = -3.0e38f;
#pragma unroll
    for (int q = 0; q < 8; ++q) if (q != i0 && le[q] > v1) { v1 = le[q]; i1 = q; }
    const float e1 = __expf(v1 - v0); const float w0 = (ABL & 128) ? 0.f : gate_g / (1.0f + e1), w1 = (ABL & 1024) ? 1.0f : ((ABL & 64) ? 0.f : gate_g * e1 / (1.0f + e1));
    if (lane == 0) *rec_slot = (u32x4){(unsigned)(grp * 8 + i0), (unsigned)(grp * 8 + i1), __builtin_bit_cast(unsigned, w0), __builtin_bit_cast(unsigned, w1)};
}
__device__ __forceinline__ void phase_ln_router(const Ctx& F, int l, const float* R32, const bf16* Yg) {
    const bf16* R16 = (const bf16*)(F.ws + WS_H16);
    const int gw = F.bid * 8 + F.wave, lane = F.lane;
    int* tokinfo = (int*)(F.ws + WS_TOKINFO); int* list = (int*)(F.ws + WS_LIST);
    unsigned* cnt = (unsigned*)(F.ws + WS_CTL) + CW_CNT + 64 * (l * 32);
    LAS f32x4* wl = (LAS f32x4*)F.lds;
    __syncthreads();
    for (int k = F.tid; k < 1024; k += 512) { const int ln = (k & 255) >> 2, e = k & 3, j = k >> 8;
        wl[(4 * j + e) * 64 + ln] = *(const f32x4*)(F.a->in[14] + ((size_t)l * D + k) * 4);
#pragma unroll
        for (int g = 0; g < 4; ++g)
#pragma unroll
            for (int q = 0; q < 2; ++q) wl[1024 + 2048 * g + ((4 * j + e) * 2 + q) * 64 + ln] = *(const f32x4*)(F.a->in[16] + (((size_t)l * 4 + g) * D + k) * 8 + 4 * q); }
    if (F.tid < 32) ((LAS float*)(F.lds + 149760))[F.tid] = F.a->in[17][l * 32 + F.tid];
    __syncthreads();
    LAS u32x4* recs = (LAS u32x4*)(F.lds + 147456);
    const int t_lo = gw * 16;
    for (int tb = t_lo; tb < T; tb += F.G * 8 * 16) {
        const int b = tb >> 11;
        LnVecs V;
#pragma unroll
        for (int j = 0; j < 4; ++j) { const int ci = 4 * lane + 256 * j;
            V.lg[j] = *(const f32x4*)(F.a->in[6] + (l * 2 + 0) * D + ci); V.lb[j] = *(const f32x4*)(F.a->in[7] + (l * 2 + 0) * D + ci);
            V.sh[j] = *(const f32x4*)(modp(F, l, b, 3) + ci); V.sc1[j] = *(const f32x4*)(modp(F, l, b, 4) + ci) + 1.0f; }
        V.br1 = *(const f32x4*)(F.a->in[15] + l * 4);
        f32x4 rA[4], rB[4]; u32x2 yA[4], yB[4];
        ln_load(R32, R16, Yg, tb, lane, rA, yA);
#pragma unroll 1
        for (int k = 0; k < 16; k += 2) {
            ln_load(R32, R16, Yg, tb + k + 1, lane, rB, yB);
            asm volatile("" ::: "memory");
            ln_row(F, l, tb + k, rA, yA, V, wl, recs + F.wave * 16 + k);
            if (k + 2 < 16) ln_load(R32, R16, Yg, tb + k + 2, lane, rA, yA);
            asm volatile("" ::: "memory");
            ln_row(F, l, tb + k + 1, rB, yB, V, wl, recs + F.wave * 16 + k + 1);
        }
        LAS int* lcnt = (LAS int*)(F.lds + 149504);
        __syncthreads();
        if (F.tid < 64) lcnt[F.tid] = 0;
        __syncthreads();
        int e = 0, lp = 0; unsigned wa = 0u, wb = 0u; const int which = F.tid & 1;
        const int r = F.tid >> 1; const int t = (tb - F.wave * 16) + r;
        if (F.tid < 256) { const u32x4 rec = recs[r]; e = which ? (int)rec.y : (int)rec.x; wa = rec.z; wb = rec.w;
            lp = __hip_atomic_fetch_add(&lcnt[e], 1, __ATOMIC_RELAXED, __HIP_MEMORY_SCOPE_WORKGROUP); }
        __syncthreads();
        if (F.tid < 32) lcnt[32 + F.tid] = (int)atomicAdd(cnt + 64 * F.tid, (unsigned)lcnt[F.tid]);
        __syncthreads();
        if (F.tid < 256) { const int pos = lcnt[32 + e] + lp;
            list[(size_t)e * LISTCAP + pos] = t;
            int* ti = tokinfo + (size_t)t * 8;
            *(u32x2*)(ti + 2 * which) = (u32x2){(unsigned)e, (unsigned)pos};
            if (which == 0) *(u32x2*)(ti + 4) = (u32x2){wa, wb}; }
    }
}

__device__ __forceinline__ void moe_table(const Ctx& F, int l) {
    LAS int* tab = (LAS int*)(F.lds + LDS_TAB_OFF);
    __syncthreads();
    if (F.tid < 32) tab[40 + F.tid] = (int)__hip_atomic_load((unsigned*)(F.ws + WS_CTL) + CW_CNT + 64 * (l * 32 + F.tid), __ATOMIC_RELAXED, __HIP_MEMORY_SCOPE_AGENT);
    __syncthreads();
    if (F.tid == 0) { int s = 0; for (int e = 0; e < 32; ++e) { tab[e] = s; s += (tab[40 + e] + 255) >> 8; } tab[32] = s; }
    __syncthreads();
}
__device__ __forceinline__ int moe_vc(int c, int G) { return (G == 256) ? (((c & 7) * 8 + (c >> 5)) * 4 + ((c >> 3) & 3)) : c; }
struct SchedMoe {
    int G, c; const char* Wt; size_t wstride; size_t pnstride; const LAS int* tab; const LAS int* tokl; int gather; unsigned lda2;
    __device__ __forceinline__ bool next(int i, g8::Unit& u) const {
        const int L = i * G + moe_vc(c, G); const int nrt = __builtin_amdgcn_readfirstlane(tab[32]); if (L >= 4 * nrt) return false;
        const int rt = L >> 2, pn = L & 3; int e = 0;
        for (int q = 1; q < 32; ++q) e = (tab[q] <= rt) ? q : e;
        e = __builtin_amdgcn_readfirstlane(e);
        u.pm = rt; u.pn = pn; u.e = e; u.aux = i; u.B = Wt + (size_t)e * wstride + (size_t)pn * pnstride; return true; }
    __device__ __forceinline__ unsigned rowoff(const g8::Unit& u, int r) const {
        if (gather) return (unsigned)tokl[u.aux * 256 + r] * lda2;
        return (unsigned)(u.pm * 256 + r) * lda2; }
};
constexpr int MOE_MAXU = 8, LDS_TOKL_OFF = LDSCTL_OFF + 1024;
static_assert(LDS_TOKL_OFF + MOE_MAXU * 256 * 4 <= LDS_BYTES && LDS_SCR_OFF + 8 * 2304 <= LDSCTL_OFF, "LDS map");
__device__ __forceinline__ void moe_tokl(const Ctx& F) {
    const LAS int* tab = (const LAS int*)(F.lds + LDS_TAB_OFF); LAS int* tokl = (LAS int*)(F.lds + LDS_TOKL_OFF);
    const int* list = (const int*)(F.ws + WS_LIST);
    for (int q = F.tid; q < MOE_MAXU * 256; q += 512) { const int i = q >> 8, r = q & 255; const int L = i * F.G + moe_vc(F.bid, F.G); int tk = 0;
        if (L < 4 * tab[32]) { const int rt = L >> 2; int e = 0; for (int k = 1; k < 32; ++k) e = (tab[k] <= rt) ? k : e;
            const int idx = (rt - tab[e]) * 256 + r; tk = list[(size_t)e * LISTCAP + (idx < tab[40 + e] ? idx : 0)]; }
        tokl[q] = tk; }
    __syncthreads();
}
struct EpiAct {
    bf16* act;
    __device__ __forceinline__ void operator()(const f32x4 (&acc)[2][2][4][2], const g8::Unit& u, int wr, int wc, int fr, int fq) const {
        const int row0 = u.pm * 256 + wr * 64 + fr, col0 = u.pn * 128 + wc * 32 + 8 * fq;
#pragma unroll
        for (int ai = 0; ai < 2; ++ai)
#pragma unroll
            for (int m = 0; m < 4; ++m) { bf16* rp = act + (size_t)(row0 + ai * 128 + m * 16) * HID + col0;
                const f32x4 g0 = acc[ai][0][m][0], u0 = acc[ai][0][m][1], g1 = acc[ai][1][m][0], u1 = acc[ai][1][m][1];
                *(u32x4*)rp = (u32x4){pk2(silu_f(g0.x) * u0.x, silu_f(g0.y) * u0.y), pk2(silu_f(g0.z) * u0.z, silu_f(g0.w) * u0.w),
                                      pk2(silu_f(g1.x) * u1.x, silu_f(g1.y) * u1.y), pk2(silu_f(g1.z) * u1.z, silu_f(g1.w) * u1.w)}; }
    }
};
struct EpiEo {
    bf16* eo;
    __device__ __forceinline__ void operator()(const f32x4 (&acc)[2][2][4][2], const g8::Unit& u, int wr, int wc, int fr, int fq) const {
        const int row0 = u.pm * 256 + wr * 64 + fr, col0 = u.pn * 256 + wc * 32 + 8 * fq;
#pragma unroll
        for (int ai = 0; ai < 2; ++ai)
#pragma unroll
            for (int m = 0; m < 4; ++m) { bf16* rp = eo + (size_t)(row0 + ai * 128 + m * 16) * D + col0;
#pragma unroll
                for (int bj = 0; bj < 2; ++bj) { const f32x4 v0 = acc[ai][bj][m][0], v1 = acc[ai][bj][m][1];
                    *(u32x4*)(rp + bj * 128) = (u32x4){pk2(v0.x, v0.y), pk2(v0.z, v0.w), pk2(v1.x, v1.y), pk2(v1.z, v1.w)}; } }
    }
};

struct CmbRow { u32x2 h[4]; u32x2 ea[4], eb[4]; };
__device__ __forceinline__ void cmb_load(const Ctx& F, const LAS int* tab, int t, const u32x4& ti, CmbRow& r) {
    const unsigned e0i = ti.x, p0i = ti.y, e1i = ti.z, p1i = ti.w;
    const size_t s0 = (size_t)tab[e0i] * 256 + p0i, s1 = (size_t)tab[e1i] * 256 + p1i;
    const bf16* eo = (const bf16*)(F.ws + WS_EO);
    const u32x2* e0 = (const u32x2*)(eo + s0 * D) + F.lane; const u32x2* e1 = (const u32x2*)(eo + s1 * D) + F.lane; const u32x2* hp = (const u32x2*)((const bf16*)(F.ws + WS_H16) + (size_t)t * D) + F.lane;
#pragma unroll
    for (int j = 0; j < 4; ++j) { r.ea[j] = e0[64 * j]; r.eb[j] = e1[64 * j]; r.h[j] = hp[64 * j]; }
}
__device__ __forceinline__ void cmb_row(const Ctx& F, int l, int t, const CmbRow& r, const u32x2& tw, const f32x4 (&gt)[4], const f32x4 (&lg)[4], const f32x4 (&lb)[4]) {
    const float ab = ((ABL >> (1 + 2 * l)) & 1) ? 0.f : 1.f;
    const unsigned twx = tw.x, twy = tw.y;
    const float w0 = ab * __uint_as_float(twx), w1 = ab * __uint_as_float(twy);
    f32x4 v[4]; float s = 0.f;
#pragma unroll
    for (int j = 0; j < 4; ++j) { const u32x2 a = r.ea[j], c2 = r.eb[j];
        f32x4 y; y.x = w0 * bflo(a.x) + w1 * bflo(c2.x); y.y = w0 * bfhi(a.x) + w1 * bfhi(c2.x); y.z = w0 * bflo(a.y) + w1 * bflo(c2.y); y.w = w0 * bfhi(a.y) + w1 * bfhi(c2.y);
        const u32x2 hh = r.h[j]; v[j] = (f32x4){bflo(hh.x), bfhi(hh.x), bflo(hh.y), bfhi(hh.y)} * ALPHA + gt[j] * y; s += (v[j].x + v[j].y) + (v[j].z + v[j].w); }
    const float mean = wave_sum(s) * (1.0f / D); float s2 = 0.f;
#pragma unroll
    for (int j = 0; j < 4; ++j) { v[j] = v[j] - mean; s2 += (v[j].x * v[j].x + v[j].y * v[j].y) + (v[j].z * v[j].z + v[j].w * v[j].w); }
    const float rstd = __builtin_amdgcn_rsqf(wave_sum(s2) * (1.0f / D) + LN_EPS);
    if (l == 1) { float* hr = F.H + (size_t)t * D;
#pragma unroll
        for (int j = 0; j < 4; ++j) *(f32x4*)(hr + 4 * F.lane + 256 * j) = v[j] * rstd * lg[j] + lb[j]; }
    else { unsigned long long* hr8 = (unsigned long long*)((bf16*)(F.ws + WS_H16) + (size_t)t * D) + F.lane;
#pragma unroll
        for (int j = 0; j < 4; ++j) { const f32x4 o = v[j] * rstd * lg[j] + lb[j]; hr8[64 * j] = (unsigned long long)pk2(o.x, o.y) | ((unsigned long long)pk2(o.z, o.w) << 32); } }
}
__device__ __forceinline__ void phase_combine(const Ctx& F, int l) {
    moe_table(F, l);
    const LAS int* tab = (const LAS int*)(F.lds + LDS_TAB_OFF);
    const int gw = F.bid * 8 + F.wave, lane = F.lane;
    const int* tokinfo = (const int*)(F.ws + WS_TOKINFO);
    for (int tb = gw * 16; tb < T; tb += F.G * 8 * 16) {
        const int b = tb >> 11;
        f32x4 gt[4], lg[4], lb[4];
#pragma unroll
        for (int j = 0; j < 4; ++j) { const int ci = 4 * lane + 256 * j; gt[j] = *(const f32x4*)(modp(F, l, b, 5) + ci);
            lg[j] = *(const f32x4*)(F.a->in[6] + (l * 2 + 1) * D + ci); lb[j] = *(const f32x4*)(F.a->in[7] + (l * 2 + 1) * D + ci); }
        u32x4 tiv = (u32x4){0u, 0u, 0u, 0u}; u32x2 twv = (u32x2){0u, 0u};
        if (lane < 16) { tiv = *(const u32x4*)(tokinfo + (size_t)(tb + lane) * 8); twv = *(const u32x2*)(tokinfo + (size_t)(tb + lane) * 8 + 4); }
#define CMB_TI(k_) ((u32x4){(unsigned)__shfl((int)tiv.x, (k_)), (unsigned)__shfl((int)tiv.y, (k_)), (unsigned)__shfl((int)tiv.z, (k_)), (unsigned)__shfl((int)tiv.w, (k_))})
#define CMB_TW(k_) ((u32x2){(unsigned)__shfl((int)twv.x, (k_)), (unsigned)__shfl((int)twv.y, (k_))})
        CmbRow A, B;
        cmb_load(F, tab, tb, CMB_TI(0), A);
#pragma unroll 1
        for (int k = 0; k < 16; k += 2) {
            cmb_load(F, tab, tb + k + 1, CMB_TI(k + 1), B);
            asm volatile("" ::: "memory");
            cmb_row(F, l, tb + k, A, CMB_TW(k), gt, lg, lb);
            if (k + 2 < 16) cmb_load(F, tab, tb + k + 2, CMB_TI(k + 2), A);
            asm volatile("" ::: "memory");
            cmb_row(F, l, tb + k + 1, B, CMB_TW(k + 1), gt, lg, lb);
        }
#undef CMB_TI
#undef CMB_TW
    }
}

template <int WH> __device__ __forceinline__ void pool_item(const Ctx& F, bf16* zp, int b, int p0, int ch) {
    const bf16* hb = (const bf16*)(F.ws + WS_H16) + (size_t)b * SEQ * D + ch;
    const f32x4 sc1 = *(const f32x4*)(modp(F, 1, b, 1) + ch) + 1.0f;
    u32x2 rw[8 + 2 * WH];
#pragma unroll
    for (int i = 0; i < 8 + 2 * WH; ++i) { const int p = p0 - WH + i; const bool ok = (p >= 0) && (p < SEQ); const u32x2 v = *(const u32x2*)(hb + (size_t)(ok ? p : p0) * D); rw[i] = ok ? v : (u32x2){0u, 0u}; }
#define PZ_ROW(i_) ((f32x4){bflo(rw[i_].x), bfhi(rw[i_].x), bflo(rw[i_].y), bfhi(rw[i_].y)})
    f32x4 sum = (f32x4){0.f, 0.f, 0.f, 0.f};
#pragma unroll
    for (int i = 0; i < 2 * WH; ++i) sum += PZ_ROW(i);
#pragma unroll
    for (int j = 0; j < 8; ++j) { const int p = p0 + j; const int cnt = min(p + WH, SEQ) - max(p - WH, 0);
        const f32x4 z = (sum * frcp((float)cnt) - PZ_ROW(j + WH)) * sc1;
        *(u32x2*)(zp + ((size_t)b * SEQ + p) * D + ch) = (u32x2){pk2(z.x, z.y), pk2(z.z, z.w)};
        sum += PZ_ROW(j + 2 * WH) - PZ_ROW(j); }
#undef PZ_ROW
}
__device__ __forceinline__ void phase_pool(const Ctx& F) {
    bf16* zp = (bf16*)(F.ws + WS_XA);
    for (int item = F.bid * 512 + F.tid; item < 4096 * 256; item += F.G * 512) {
        const int strip = item >> 8, ct = item & 255, b = strip >> 8, p0 = (strip & 255) * 8, ch = 4 * ct;
        const int g = __builtin_amdgcn_readfirstlane(ct >> 6);
        if (g == 0) pool_item<1>(F, zp, b, p0, ch); else if (g == 1) pool_item<2>(F, zp, b, p0, ch); else if (g == 2) pool_item<4>(F, zp, b, p0, ch); else pool_item<8>(F, zp, b, p0, ch);
    }
}
struct SchedPool {
    int G, c; const char* Wt;
    __device__ __forceinline__ bool next(int i, g8::Unit& u) const {
        const int L = i * G + c; if (L >= 512) return false;
        int pm, pn; g8::tile_of(L, 128, 4, pm, pn); u.pm = pm; u.pn = pn; u.e = 0; u.aux = 0; u.B = Wt + (size_t)pn * 256 * 256 * 2; return true; }
    __device__ __forceinline__ unsigned rowoff(const g8::Unit& u, int r) const { return (unsigned)(u.pm * 256 + r) * 2048u + (unsigned)u.pn * 512u; }
};

__global__ void __launch_bounds__(512, 2) mk_fwd(Args args) {
    extern __shared__ __attribute__((aligned(16))) unsigned char lds_raw[];
    Ctx F;
    F.lds = (LAS unsigned char*)lds_raw;
    F.tid = threadIdx.x; F.lane = F.tid & 63; F.wave = __builtin_amdgcn_readfirstlane(F.tid >> 6); F.G = gridDim.x; F.bid = blockIdx.x;
    F.a = (KArgs)__builtin_amdgcn_kernarg_segment_ptr();
    F.H = args.out; F.ws = args.ws;
    for (int u = F.tid; u < (LDS_BYTES - LDSCTL_OFF) / 4; u += 512) ((LAS unsigned*)(F.lds + LDSCTL_OFF))[u] = 0u;
    __syncthreads();
    XcdBarrier bar; bar.bar = (unsigned*)(F.ws + WS_CTL) + CW_BAR; bar.x = 0; bar.st = nullptr;
    if (MK_N_LAUNCHES == 1) bar = xcd_barrier_post((unsigned*)(F.ws + WS_CTL) + CW_BAR, (volatile LAS unsigned*)(F.lds + LDSCTL_OFF));
    const int lo = args.ph_lo, hi = args.ph_hi;
#ifndef PHMASK
#define PHMASK 0xFFFF
#endif
#define IN(k) (((PHMASK >> (k)) & 1) && lo <= (k) && (k) < hi)
#define FRESH() do { asm volatile("" : "+s"(F.a)); } while (0)
#define SEAM(k) do { if (IN(k) && IN((k) + 1)) xcd_barrier(bar); } while (0)

    if (IN(0)) { FRESH(); phase0(F); if (RPT & 1) { __syncthreads(); phase0(F); } } SEAM(0);
    if (IN(1)) { FRESH(); phase1(F); if (RPT & 2) { __syncthreads(); phase1(F); } } SEAM(1);
    if (IN(2)) { FRESH();
        SchedIn S{F.G, F.bid, (const char*)(F.ws + WS_WIN)};
        EpiIn E{F.ws, (unsigned char*)F.H, F.lds};
        g8::gemm_phase(F.lds, (const char*)(F.ws + WS_XA), 1024, S, E);
        convert_tail(F, F.bid, (1792 + 128) % 256, 0, 10240);
    } SEAM(2);
    if (IN(3)) { FRESH(); phase3(F); if (RPT & 8) { __syncthreads(); phase3(F); } } SEAM(3);
    if (IN(4)) { FRESH(); phase4(F); if (RPT & 16) { __syncthreads(); phase4(F); } } SEAM(4);
    if (IN(5)) { FRESH();
        SchedOut S{F.G, F.bid, (const char*)(F.ws + WS_WOUT)};
        EpiY E{(bf16*)(F.ws + WS_P), modp(F, 0, 0, 2), nullptr, (ABL & 1) ? 0.f : 1.f};
        g8::gemm_phase(F.lds, (const char*)(F.ws + WS_XA), 1024, S, E); if ((RPT >> 5) & 1) { __syncthreads(); g8::gemm_phase(F.lds, (const char*)(F.ws + WS_XA), 1024, S, E); }
    } SEAM(5);
    if (IN(6)) { FRESH(); phase_ln_router(F, 0, F.a->in[0], (const bf16*)(F.ws + WS_P)); } SEAM(6);
    if (IN(7)) { FRESH();
        moe_table(F, 0); moe_tokl(F);
        SchedMoe S{F.G, F.bid, (const char*)(F.ws + WS_WGU), (size_t)1024 * 1024 * 2, (size_t)256 * 1024 * 2, (const LAS int*)(F.lds + LDS_TAB_OFF), (const LAS int*)(F.lds + LDS_TOKL_OFF), 1, 2048u};
        EpiAct E{(bf16*)(F.ws + WS_ACT)};
        g8::gemm_phase(F.lds, (const char*)(F.ws + WS_XA), 1024, S, E);
        convert_tail(F, moe_vc(F.bid, F.G), (4 * ((const LAS int*)(F.lds + LDS_TAB_OFF))[32]) % 256, 10240, 20480); if ((RPT >> 7) & 1) { __syncthreads(); g8::gemm_phase(F.lds, (const char*)(F.ws + WS_XA), 1024, S, E); }
    } SEAM(7);
    if (IN(8)) { FRESH();
        moe_table(F, 0);
        SchedMoe S{F.G, F.bid, (const char*)(F.ws + WS_WDN), (size_t)1024 * 512 * 2, (size_t)256 * 512 * 2, (const LAS int*)(F.lds + LDS_TAB_OFF), (const LAS int*)(F.lds + LDS_TOKL_OFF), 0, 1024u};
        EpiEo E{(bf16*)(F.ws + WS_EO)};
        g8::gemm_phase(F.lds, (const char*)(F.ws + WS_ACT), 512, S, E);
        convert_tail(F, moe_vc(F.bid, F.G), (4 * ((const LAS int*)(F.lds + LDS_TAB_OFF))[32]) % 256, 20480, I_E1); if ((RPT >> 8) & 1) { __syncthreads(); g8::gemm_phase(F.lds, (const char*)(F.ws + WS_ACT), 512, S, E); }
    } SEAM(8);
    if (IN(9)) { FRESH(); phase_combine(F, 0); } SEAM(9);
    if (IN(10)) { FRESH(); phase_pool(F); if (RPT & 1024) { __syncthreads(); phase_pool(F); } } SEAM(10);
    if (IN(11)) { FRESH();
        SchedPool S{F.G, F.bid, (const char*)(F.ws + WS_WPOOL)};
        EpiY E{(bf16*)(F.ws + WS_ACT), modp(F, 1, 0, 2), F.a->in[13], (ABL & 4) ? 0.f : 1.f};
        g8::gemm_phase(F.lds, (const char*)(F.ws + WS_XA), 256, S, E);
    } SEAM(11);
    if (IN(12)) { FRESH(); phase_ln_router(F, 1, nullptr, (const bf16*)(F.ws + WS_ACT)); } SEAM(12);
    if (IN(13)) { FRESH();
        moe_table(F, 1); moe_tokl(F);
        SchedMoe S{F.G, F.bid, (const char*)(F.ws + WS_WGU) + (size_t)32 * 1024 * 1024 * 2, (size_t)1024 * 1024 * 2, (size_t)256 * 1024 * 2, (const LAS int*)(F.lds + LDS_TAB_OFF), (const LAS int*)(F.lds + LDS_TOKL_OFF), 1, 2048u};
        EpiAct E{(bf16*)(F.ws + WS_ACT)};
        g8::gemm_phase(F.lds, (const char*)(F.ws + WS_XA), 1024, S, E);
    } SEAM(13);
    if (IN(14)) { FRESH();
        moe_table(F, 1);
        SchedMoe S{F.G, F.bid, (const char*)(F.ws + WS_WDN) + (size_t)32 * 1024 * 512 * 2, (size_t)1024 * 512 * 2, (size_t)256 * 512 * 2, (const LAS int*)(F.lds + LDS_TAB_OFF), (const LAS int*)(F.lds + LDS_TOKL_OFF), 0, 1024u};
        EpiEo E{(bf16*)(F.ws + WS_EO)};
        g8::gemm_phase(F.lds, (const char*)(F.ws + WS_ACT), 512, S, E);
    } SEAM(14);
    if (IN(15)) { FRESH(); phase_combine(F, 1); }
#undef IN
#undef SEAM
}

extern "C" void kernel_launch(void* const* d_in, const int* in_sizes, int n_in, void* d_out, int out_size, void* d_ws, size_t ws_size, hipStream_t stream) {
    static int grid = 0;
    if (grid == 0) {
        if (n_in != 21 || in_sizes[0] != T * D || out_size != T * D || ws_size < WS_END) { fprintf(stderr, "kernel_launch: unexpected shapes (n_in %d, ws %zu); nothing launched\n", n_in, ws_size); grid = -1; return; }
        int dev = 0, cus = 0, per_cu = 0;
        if (hipGetDevice(&dev) != hipSuccess || hipDeviceGetAttribute(&cus, hipDeviceAttributeMultiprocessorCount, dev) != hipSuccess) { grid = -1; return; }
        if (hipFuncSetAttribute((const void*)mk_fwd, hipFuncAttributeMaxDynamicSharedMemorySize, LDS_BYTES) != hipSuccess) { fprintf(stderr, "kernel_launch: hipFuncSetAttribute failed\n"); grid = -1; return; }
        if (hipOccupancyMaxActiveBlocksPerMultiprocessor(&per_cu, (const void*)mk_fwd, 512, LDS_BYTES) != hipSuccess || per_cu < 1) { fprintf(stderr, "kernel_launch: occupancy query reports %d\n", per_cu); }
        (void)hipGetLastError();
        grid = cus;
    }
    if (grid < 0) return;
    if (hipMemsetAsync((char*)d_ws + WS_CTL, 0, CTL_ZERO_BYTES, stream) != hipSuccess) return;
    Args a{};
    for (int i = 0; i < 21; ++i) a.in[i] = (const float*)d_in[i];
    a.out = (float*)d_out; a.ws = (unsigned char*)d_ws;
    if (MK_N_LAUNCHES == 1) { a.ph_lo = 0; a.ph_hi = NPHASE; hipLaunchKernelGGL(mk_fwd, dim3(grid), dim3(512), LDS_BYTES, stream, a); }
    else for (int p = 0; p < NPHASE; ++p) { a.ph_lo = p; a.ph_hi = p + 1; hipLaunchKernelGGL(mk_fwd, dim3(grid), dim3(512), LDS_BYTES, stream, a); }
}
```

```cpp
#include <hip/hip_runtime.h>
#include <cstdio>
#include <cstdint>

#ifndef ABL
#define ABL 0
#endif
#ifndef RPT
#define RPT 0
#endif
#ifndef MK_N_LAUNCHES
#define MK_N_LAUNCHES 1
#endif

#define GAS __attribute__((address_space(1)))
#define LAS __attribute__((address_space(3)))
typedef unsigned short bf16;
typedef short bf16x8 __attribute__((ext_vector_type(8)));
typedef float f32x4 __attribute__((ext_vector_type(4)));
typedef float f32x16 __attribute__((ext_vector_type(16)));
typedef unsigned u32x4 __attribute__((ext_vector_type(4)));
typedef unsigned u32x2 __attribute__((ext_vector_type(2)));

constexpr int D = 1024, NB = 16, SEQ = 2048, T = NB * SEQ, CTXL = 256, TC = NB * CTXL;
constexpr int GRIDW = 64, GROWS = SEQ / GRIDW;
constexpr int OFF_RK = 0, OFF_RV = 512, OFF_NK = 1024, OFF_NV = 1536, KV_COLS = 2048, OFF_RQ = 2048, OFF_RG = 2560, OFF_NQ = 3072, IN_COLS = 3584;
constexpr int NEXP = 32, HID = 512, LISTCAP = T;
constexpr int MAXSLOT = 73728;
constexpr float LN_EPS = 1e-5f;
constexpr float ALPHA = 1.41421356237309515f;
constexpr int NPHASE = 16;

constexpr size_t MiB = 1u << 20;
constexpr size_t WS_CTL = 0, CTL_ZERO_BYTES = 128 * 1024;
constexpr size_t WS_MOD = 1 * MiB;
constexpr size_t WS_TOKINFO = 2 * MiB;
constexpr size_t WS_LIST = 3 * MiB;
constexpr size_t WS_WIN = 8 * MiB, WS_WOUT = 15 * MiB, WS_WPOOL = 17 * MiB, WS_WGU = 18 * MiB, WS_WDN = 146 * MiB;
constexpr size_t WS_XA = 210 * MiB;
constexpr size_t WS_P = 282 * MiB;
constexpr size_t WS_ACT = 282 * MiB, WS_EO = 354 * MiB;
constexpr int TPITCH = SEQ + 64;
constexpr size_t WS_VTR = 446 * MiB, WS_VTRC = 480 * MiB;
constexpr size_t WS_VTN = 484 * MiB, WS_VTNC = 518 * MiB;
constexpr size_t WS_PC = 522 * MiB;
constexpr size_t WS_H16 = 526 * MiB;
constexpr size_t WS_END = 590 * MiB;
constexpr size_t DO_ST = 0;
constexpr size_t DO_KTR = 64 * MiB, DO_KTRC = 98 * MiB;
constexpr int PW = 2624, PO_RK = 0, PO_NK = 512, PO_RQ = 1024, PO_RG = 1536, PO_NQ = 2048, PCW = 512;
static_assert(WS_EO + (size_t)MAXSLOT * 1024 * 2 <= 498 * MiB && WS_ACT + (size_t)MAXSLOT * 512 * 2 <= WS_EO, "ws map");
static_assert(WS_P + (size_t)T * PW * 2 <= WS_VTR && WS_VTR + (size_t)64 * 128 * TPITCH * 2 <= WS_VTRC && WS_VTN + (size_t)128 * 64 * TPITCH * 2 <= WS_VTNC && DO_KTR + (size_t)64 * 128 * TPITCH * 2 <= DO_KTRC && WS_XA + (size_t)(T + TC) * D * 2 <= WS_P, "ws map");
constexpr int CW_BAR = 4096, XCD_BAR_WORDS_C = 3456;
constexpr int CW_CNT = 16384;
static_assert((CW_CNT + 64 * 64) * 4 <= (int)CTL_ZERO_BYTES && (CW_BAR + XCD_BAR_WORDS_C) * 4 <= (int)CTL_ZERO_BYTES, "ctl words inside the memset");

constexpr int RING_BYTES = 131072, LDS_SCR_OFF = RING_BYTES, LDSCTL_OFF = 154112, LDS_TAB_OFF = LDSCTL_OFF + 256, LDS_BYTES = 163840;

__device__ __forceinline__ unsigned f2bf(float f) { unsigned u = __builtin_bit_cast(unsigned, f); return (u + 0x7fffu + ((u >> 16) & 1u)) >> 16; }
__device__ __forceinline__ unsigned pk2(float lo, float hi) { unsigned r; asm("v_cvt_pk_bf16_f32 %0, %1, %2" : "=v"(r) : "v"(lo), "v"(hi)); return r; }
__device__ __forceinline__ bf16x8 pack8(const f32x4& a, const f32x4& b) { const u32x4 w = (u32x4){pk2(a.x, a.y), pk2(a.z, a.w), pk2(b.x, b.y), pk2(b.z, b.w)}; return __builtin_bit_cast(bf16x8, w); }
__device__ __forceinline__ float bf2f(unsigned h) { return __builtin_bit_cast(float, h << 16); }
__device__ __forceinline__ float bflo(unsigned w) { return __builtin_bit_cast(float, w << 16); }
__device__ __forceinline__ float bfhi(unsigned w) { return __builtin_bit_cast(float, w & 0xffff0000u); }
__device__ __forceinline__ float wave_sum(float v) {
    int x = __builtin_bit_cast(int, v);
#define WS_STEP(ctrl, rmask) do { const int t_ = __builtin_amdgcn_update_dpp(0, x, (ctrl), (rmask), 0xF, false); x = __builtin_bit_cast(int, __builtin_bit_cast(float, x) + __builtin_bit_cast(float, t_)); } while (0)
    WS_STEP(0xB1, 0xF);
    WS_STEP(0x4E, 0xF);
    WS_STEP(0x141, 0xF);
    WS_STEP(0x140, 0xF);
    WS_STEP(0x142, 0xA);
    WS_STEP(0x143, 0xC);
#undef WS_STEP
    return __builtin_bit_cast(float, __builtin_amdgcn_readlane(x, 63));
}
__device__ __forceinline__ float frcp(float x) { return __builtin_amdgcn_rcpf(x); }
__device__ __forceinline__ float silu_f(float v) { return v * frcp(1.0f + __expf(-v)); }
__device__ __forceinline__ float fexp2(float x) { return __builtin_amdgcn_exp2f(x); }
#define LDS_WAIT() asm volatile("s_waitcnt lgkmcnt(0)" ::: "memory")

#define XB_TMO      128
#define XB_XCNT(j)  (256  + 64 * (j))
#define XB_XSUB(j)  (1280 + 64 * (j))
#define XB_XGEN(j)  (2304 + 64 * (j))
#define XB_TOP      3328
#define XB_TOPGEN   3392
#define XCD_BAR_WORDS 3456
#define XB_SPIN_CAP (1u << 18)
__device__ __forceinline__ unsigned xb_ld(unsigned* p)              { return __hip_atomic_load(p, __ATOMIC_RELAXED, __HIP_MEMORY_SCOPE_AGENT); }
__device__ __forceinline__ unsigned xb_add(unsigned* p, unsigned v) { return __hip_atomic_fetch_add(p, v, __ATOMIC_RELAXED, __HIP_MEMORY_SCOPE_AGENT); }
__device__ __forceinline__ unsigned xb_xcc_id() { return (unsigned)__builtin_amdgcn_s_getreg((3 << 11) | 20) & 0xFu; }
#define XB_SPIN(cond, bar) do { unsigned _sp = 0; while (cond) { __builtin_amdgcn_s_sleep(1); \
    if ((++_sp & 255u) == 0u) { if (xb_ld(&(bar)[XB_TMO])) break; if (_sp > XB_SPIN_CAP) { atomicAdd(&(bar)[XB_TMO], 1u); break; } } } } while (0)
struct XcdBarrier { unsigned* bar; unsigned x; volatile LAS unsigned* st; };
__device__ __forceinline__ XcdBarrier xcd_barrier_post(unsigned* bar, volatile LAS unsigned* st) {
    XcdBarrier b; b.bar = bar; b.x = xb_xcc_id(); b.st = st;
    if (threadIdx.x == 0) (void)xb_add(&bar[XB_XCNT(b.x)], 1u);
    return b;
}
__device__ __forceinline__ void xcd_barrier_complete(unsigned* bar, unsigned x, unsigned& nloc, unsigned& nx) {
    const unsigned G = gridDim.x * gridDim.y * gridDim.z;
    unsigned sum, cnt, mine, sp = 0u;
    for (;;) {
        sum = 0u; cnt = 0u; mine = 0u;
#pragma unroll
        for (unsigned j = 0; j < 16; ++j) { const unsigned c = xb_ld(&bar[XB_XCNT(j)]); sum += c; cnt += (c > 0u) ? 1u : 0u; mine = (j == x) ? c : mine; }
        if (sum == G) break;
        __builtin_amdgcn_s_sleep(1);
        if ((++sp & 255u) == 0u) { if (xb_ld(&bar[XB_TMO])) break; if (sp > XB_SPIN_CAP) { atomicAdd(&bar[XB_TMO], 1u); break; } }
    }
    nloc = mine > 0u ? mine : 1u; nx = cnt > 0u ? cnt : 1u;
}
__device__ __forceinline__ void xcd_barrier(const XcdBarrier& b) {
    asm volatile("s_waitcnt vmcnt(0)" ::: "memory");
    __syncthreads();
    if (threadIdx.x == 0) {
        unsigned* bar = b.bar;
        __builtin_amdgcn_s_waitcnt(0);
        unsigned nloc = b.st[0], nx = b.st[1];
        if (nloc == 0u) { xcd_barrier_complete(bar, b.x, nloc, nx); b.st[0] = nloc; b.st[1] = nx; }
        const unsigned old = xb_add(&bar[XB_XSUB(b.x)], 1u);
        const unsigned gen = old / nloc;
        if (old + 1u == (gen + 1u) * nloc) {
            __builtin_amdgcn_fence(__ATOMIC_RELEASE, "agent");
            asm volatile("s_waitcnt vmcnt(0)" ::: "memory");
            const unsigned og = xb_add(&bar[XB_TOP], 1u);
            const unsigned tg = og / nx;
            if (og + 1u == (tg + 1u) * nx) xb_add(&bar[XB_TOPGEN], 1u);
            else XB_SPIN(xb_ld(&bar[XB_TOPGEN]) == tg, bar);
            __builtin_amdgcn_fence(__ATOMIC_ACQUIRE, "agent");
            xb_add(&bar[XB_XGEN(b.x)], 1u);
            asm volatile("s_waitcnt vmcnt(0)" ::: "memory");
        } else {
            XB_SPIN(xb_ld(&bar[XB_XGEN(b.x)]) == gen, bar);
            __builtin_amdgcn_fence(__ATOMIC_ACQUIRE, "agent");
            asm volatile("s_waitcnt vmcnt(0)" ::: "memory");
        }
    }
    __syncthreads();
}

struct Args { const float* in[21]; float* out; unsigned char* ws; int ph_lo, ph_hi; };
typedef const __attribute__((address_space(4))) Args* KArgs;
struct Ctx {
    LAS unsigned char* lds;
    int tid, lane, wave, G, bid;
    KArgs a;
    float* H;
    unsigned char* ws;
};
__device__ __forceinline__ const float* modp(const Ctx& F, int l, int row, int part) { return (const float*)(F.ws + WS_MOD) + (size_t)(l * 17 + row) * 6144 + part * 1024; }

namespace g8 {
constexpr int BM = 256, BK = 64, HALF = 128, HTB = HALF * BK * 2, STAGE_BYTES = 8 * HTB;
__device__ __forceinline__ int lds_byte(int r, int c) { const int st = (r >> 4) * 2 + (c >> 5), rr = r & 15, cc = c & 31, ob = rr * 64 + cc * 2; return st * 1024 + (ob ^ (((ob >> 9) & 1) << 5)); }
__device__ __forceinline__ void stage_rc(int b, int& R, int& C) { const int st = b / 1024, sb = b % 1024, swz = sb ^ (((sb >> 9) & 1) << 5); R = (st >> 1) * 16 + swz / 64; C = (st & 1) * 32 + (swz % 64) / 2; }
struct Unit { const char* B; int pm, pn, e, aux; };
__device__ __forceinline__ void tile_of(int L, int nM, int nN, int& pm, int& pn) {
    const int nwg = nM * nN; int wgid = L; { const int q = nwg / 8, r = nwg % 8, xcd = wgid % 8, off = wgid / 8; wgid = (xcd < r ? xcd * (q + 1) : r * (q + 1) + (xcd - r) * q) + off; }
    const int nig = 8 * nN, gid = wgid / nig, fm = gid * 8, gsz = (nM - fm) < 8 ? (nM - fm) : 8;
    pm = fm + ((wgid % nig) % gsz); pn = (wgid % nig) / gsz;
}
template <class Epi, class Sched>
__device__ __forceinline__ void gemm_phase(LAS unsigned char* lds, const char* Abase, const int K, const Sched& S, const Epi& E) {
    const int tid = threadIdx.x, wid = __builtin_amdgcn_readfirstlane(tid >> 6), lane = tid & 63, wr = wid >> 2, wc = wid & 3, fr = lane & 15, fq = lane >> 4;
    const int nt = K / BK;
    int R0, C0, R1, C1; stage_rc(tid * 16, R0, C0); stage_rc(tid * 16 + 8192, R1, C1);
    unsigned voffB[2]; voffB[0] = (unsigned)(R0 * K + C0) * 2u; voffB[1] = (unsigned)(R1 * K + C1) * 2u;
    const unsigned kstep = (unsigned)(BK * 2);
    const size_t hstepB = (size_t)HALF * K * 2;
    const unsigned ldsw = (unsigned)wid * 1024u;
    const int aoff = lds_byte(wr * 64 + fr, fq * 8), boff = lds_byte(wc * 32 + fr, fq * 8);
#define G8_SA(b, h) (((b) * 2 + (h)) * HTB)
#define G8_SB(b, h) ((4 + (b) * 2 + (h)) * HTB)
#define G8_STAGEB(bufoff, gbase) do { _Pragma("unroll") for (int _i = 0; _i < 2; ++_i) \
        __builtin_amdgcn_global_load_lds((const unsigned*)((const char*)(gbase) + voffB[_i]), (LAS unsigned*)(lds + (bufoff) + ldsw + _i * 8192), 16, 0, 0); } while (0)
#define G8_STAGEA(bufoff, offs, h, koff) do { _Pragma("unroll") for (int _i = 0; _i < 2; ++_i) \
        __builtin_amdgcn_global_load_lds((const unsigned*)((Abase + (koff)) + (offs)[h][_i]), (LAS unsigned*)(lds + (bufoff) + ldsw + _i * 8192), 16, 0, 0); } while (0)
#define G8_LDA(dst, b, h) do { _Pragma("unroll") for (int m = 0; m < 4; ++m) _Pragma("unroll") for (int k = 0; k < 2; ++k) dst[m][k] = *(const LAS bf16x8*)(lds + G8_SA(b, h) + aoff + m * 2048 + k * 1024); } while (0)
#define G8_LDB(dst, b, h) do { _Pragma("unroll") for (int n = 0; n < 2; ++n) _Pragma("unroll") for (int k = 0; k < 2; ++k) dst[n][k] = *(const LAS bf16x8*)(lds + G8_SB(b, h) + boff + n * 2048 + k * 1024); } while (0)
#define G8_MMA(ai, bj, At, Bt) do { __builtin_amdgcn_s_setprio(1); _Pragma("unroll") for (int m = 0; m < 4; ++m) _Pragma("unroll") for (int n = 0; n < 2; ++n) _Pragma("unroll") for (int k = 0; k < 2; ++k) \
        acc[ai][bj][m][n] = __builtin_amdgcn_mfma_f32_16x16x32_bf16(Bt[n][k], At[m][k], acc[ai][bj][m][n], 0, 0, 0); __builtin_amdgcn_s_setprio(0); } while (0)
#define G8_WAIT_V(n) asm volatile("s_waitcnt vmcnt(" #n ")" ::: "memory")
#define G8_WAIT_L(n) asm volatile("s_waitcnt lgkmcnt(" #n ")" ::: "memory")
#define G8_BAR __builtin_amdgcn_s_barrier()
#define G8_SCHED __builtin_amdgcn_sched_barrier(0)
    Unit cur, nxt; int ui = 0;
    if (!S.next(0, cur)) return;
    f32x4 acc[2][2][4][2];
#pragma unroll
    for (int a = 0; a < 2; ++a)
#pragma unroll
        for (int b = 0; b < 2; ++b)
#pragma unroll
            for (int m = 0; m < 4; ++m)
#pragma unroll
                for (int n = 0; n < 2; ++n) acc[a][b][m][n] = (f32x4){0.f, 0.f, 0.f, 0.f};
    bf16x8 At[4][2], B0[2][2], B1[2][2];
    unsigned ac[2][2];
    ac[0][0] = S.rowoff(cur, R0) + (unsigned)C0 * 2u; ac[0][1] = S.rowoff(cur, R1) + (unsigned)C1 * 2u;
    ac[1][0] = S.rowoff(cur, HALF + R0) + (unsigned)C0 * 2u; ac[1][1] = S.rowoff(cur, HALF + R1) + (unsigned)C1 * 2u;
    const char* cB = cur.B;
    G8_STAGEB(G8_SB(0, 0), cB); G8_STAGEB(G8_SB(0, 1), cB + hstepB); G8_STAGEA(G8_SA(0, 0), ac, 0, 0); G8_STAGEA(G8_SA(0, 1), ac, 1, 0);
    if (wr == 1) G8_BAR;
    G8_WAIT_V(2); G8_BAR;
    G8_STAGEB(G8_SB(1, 0), cB + kstep); G8_STAGEA(G8_SA(1, 0), ac, 0, kstep); G8_STAGEB(G8_SB(1, 1), cB + hstepB + kstep);
    G8_WAIT_V(6); G8_BAR;
    for (;;) {
        const bool has_next = S.next(ui + 1, nxt);
        const char* nB = has_next ? nxt.B : cB;
#pragma unroll 1
        for (int t = 0; t < nt; t += 2) {
            const bool last = (t == nt - 2);
            const unsigned k1 = (unsigned)(t + 1) * kstep;
            const unsigned k2 = last ? 0u : (unsigned)(t + 2) * kstep;
            const unsigned k3 = k2 + kstep;
            const char* b2 = last ? nB : cB + k2; const char* b3 = b2 + kstep;
            G8_LDB(B0, 0, 0); G8_LDB(B1, 0, 1); G8_SCHED; G8_LDA(At, 0, 0); G8_STAGEA(G8_SA(1, 1), ac, 1, k1);
            if (last && has_next) {
                ac[0][0] = S.rowoff(nxt, R0) + (unsigned)C0 * 2u; ac[0][1] = S.rowoff(nxt, R1) + (unsigned)C1 * 2u;
                ac[1][0] = S.rowoff(nxt, HALF + R0) + (unsigned)C0 * 2u; ac[1][1] = S.rowoff(nxt, HALF + R1) + (unsigned)C1 * 2u;
            }
            G8_WAIT_V(8); G8_WAIT_L(0); G8_BAR; G8_MMA(0, 0, At, B0); G8_MMA(0, 1, At, B1); G8_BAR; G8_SCHED;
            G8_LDA(At, 0, 1); G8_STAGEB(G8_SB(0, 0), b2); G8_STAGEB(G8_SB(0, 1), b2 + hstepB); G8_STAGEA(G8_SA(0, 0), ac, 0, k2);
            G8_WAIT_V(8); G8_WAIT_L(0); G8_BAR; G8_MMA(1, 0, At, B0); G8_MMA(1, 1, At, B1); G8_BAR; G8_SCHED;
            G8_LDB(B0, 1, 0); G8_LDB(B1, 1, 1); G8_SCHED; G8_LDA(At, 1, 0); G8_STAGEA(G8_SA(0, 1), ac, 1, k2);
            G8_WAIT_V(8); G8_WAIT_L(0); G8_BAR; G8_MMA(0, 0, At, B0); G8_MMA(0, 1, At, B1); G8_BAR; G8_SCHED;
            G8_LDA(At, 1, 1); G8_STAGEB(G8_SB(1, 0), b3); G8_STAGEB(G8_SB(1, 1), b3 + hstepB); G8_STAGEA(G8_SA(1, 0), ac, 0, k3);
            G8_WAIT_V(8); G8_WAIT_L(0); G8_BAR; G8_MMA(1, 0, At, B0); G8_MMA(1, 1, At, B1); G8_BAR; G8_SCHED;
        }
        if (wr == 0) G8_BAR;
        E(acc, cur, wr, wc, fr, fq);
        if (!has_next) break;
#pragma unroll
        for (int a = 0; a < 2; ++a)
#pragma unroll
            for (int b = 0; b < 2; ++b)
#pragma unroll
                for (int m = 0; m < 4; ++m)
#pragma unroll
                    for (int n = 0; n < 2; ++n) acc[a][b][m][n] = (f32x4){0.f, 0.f, 0.f, 0.f};
        cur = nxt; cB = nB; ++ui;
        if (wr == 1) G8_BAR;
    }
    G8_WAIT_V(0);
    G8_BAR;
#undef G8_SA
#undef G8_SB
#undef G8_STAGEA
#undef G8_STAGEB
#undef G8_LDA
#undef G8_LDB
#undef G8_MMA
#undef G8_WAIT_V
#undef G8_WAIT_L
#undef G8_BAR
#undef G8_SCHED
}
}

struct CvDesc { const float* W; bf16* WT; int ldw, ldo, k0, n0, kind, aux; };
struct RmId   { __device__ __forceinline__ int operator()(int n) const { return n; } };
struct RmGate { int up; __device__ __forceinline__ int operator()(int h) const { return 256 * (h >> 7) + 128 * ((h >> 2) & 1) + 32 * ((h >> 5) & 3) + 16 * up + 4 * ((h >> 3) & 3) + (h & 3); } };
struct RmPerm { __device__ __forceinline__ int operator()(int c) const { const int q = c & 31; return (c & ~31) + 16 * ((q >> 2) & 1) + 4 * (q >> 3) + (q & 3); } };
struct RmIn   { __device__ __forceinline__ int operator()(int n) const {
    const bool rope = (n < 512) || (n >= OFF_RQ && n < OFF_RQ + 512);
    const bool tokmaj = (n >= OFF_NK && n < OFF_NV) || (n >= OFF_RG);
    const int d = n & 127; return rope ? ((n & ~127) + 32 * ((d >> 4) & 3) + 16 * (d >> 6) + (d & 15)) : (tokmaj ? RmPerm{}(n) : n); } };

__device__ __forceinline__ int cv_rowmap(const CvDesc& d, int n) { return d.kind == 1 ? RmGate{d.aux}(n) : (d.kind == 2 ? RmPerm{}(n) : (d.kind == 3 ? RmIn{}(n) : n)); }
__device__ __forceinline__ void cv_load(const CvDesc& d, int lane, float (&buf)[32]) {
    const float* p = d.W + (size_t)(d.k0 + (lane >> 5)) * d.ldw + d.n0 + (lane & 31);
#pragma unroll
    for (int i = 0; i < 32; ++i) buf[i] = __builtin_nontemporal_load(p + (size_t)(2 * i) * d.ldw);
}
__device__ __forceinline__ void cv_store(const CvDesc& d, int lane, const float (&buf)[32], LAS float* scr) {
#pragma unroll
    for (int i = 0; i < 32; ++i) scr[(2 * i + (lane >> 5)) * 33 + (lane & 31)] = buf[i];
    LDS_WAIT(); asm volatile("" ::: "memory");
    const int c = lane & 7;
#pragma unroll
    for (int j = 0; j < 4; ++j) { const int n = (lane >> 3) + 8 * j; const LAS float* sp = scr + (8 * c) * 33 + n;
        u32x4 o; o.x = pk2(sp[0 * 33], sp[1 * 33]); o.y = pk2(sp[2 * 33], sp[3 * 33]); o.z = pk2(sp[4 * 33], sp[5 * 33]); o.w = pk2(sp[6 * 33], sp[7 * 33]);
        *(u32x4*)(d.WT + (size_t)cv_rowmap(d, d.n0 + n) * d.ldo + d.k0 + 8 * c) = o; }
    LDS_WAIT(); asm volatile("" ::: "memory");
}
constexpr int I_E1 = 3 * 32 * 256;
__device__ __forceinline__ CvDesc cv_expert(const Ctx& F, int l, int q) {
    const int mat = q >> 13, r = q & 8191, le = l * 32 + (r >> 8), w = r & 255; CvDesc d;
    if (mat < 2) { d.W = (mat ? F.a->in[19] : F.a->in[18]) + (size_t)le * 1024 * 512; d.ldw = 512; d.WT = (bf16*)(F.ws + WS_WGU) + (size_t)le * 1024 * 1024; d.ldo = 1024; d.kind = 1; d.aux = mat; d.k0 = 64 * (w >> 4); d.n0 = 32 * (w & 15); }
    else { d.W = F.a->in[20] + (size_t)le * 512 * 1024; d.ldw = 1024; d.WT = (bf16*)(F.ws + WS_WDN) + (size_t)le * 1024 * 512; d.ldo = 512; d.kind = 2; d.aux = 0; d.k0 = 64 * (w >> 5); d.n0 = 32 * (w & 31); }
    return d;
}
constexpr int I_IN = 16 * 112, I_OUT = 16 * 32, I_POOL = 4 * 32;
__device__ __forceinline__ CvDesc cv_phase0(const Ctx& F, int r, int nexp) {
    if (r < nexp) return cv_expert(F, r < I_E1 ? 0 : 1, r < I_E1 ? r : r - I_E1);
    r -= nexp; CvDesc d; d.aux = 0;
    if (r < I_IN) { d.W = F.a->in[8]; d.ldw = IN_COLS; d.WT = (bf16*)(F.ws + WS_WIN); d.ldo = 1024; d.kind = 3; d.k0 = 64 * (r / 112); d.n0 = 32 * (r % 112); return d; }
    r -= I_IN;
    if (r < I_OUT) { d.W = F.a->in[9]; d.ldw = 1024; d.WT = (bf16*)(F.ws + WS_WOUT); d.ldo = 1024; d.kind = 2; d.k0 = 64 * (r >> 5); d.n0 = 32 * (r & 31); return d; }
    r -= I_OUT;
    { const int g = r >> 5, q = r & 31; d.W = F.a->in[12] + (size_t)g * 65536; d.ldw = 256; d.WT = (bf16*)(F.ws + WS_WPOOL) + (size_t)g * 65536; d.ldo = 256; d.kind = 2; d.k0 = 64 * (q >> 3); d.n0 = 32 * (q & 7); return d; }
}
#define CV_RUN(first, end, stride, GEN) do { float bA_[32], bB_[32]; const int end_ = (end), st_ = (stride); \
    for (int it_ = (first); it_ < end_; it_ += 2 * st_) { const bool h1_ = it_ + st_ < end_; \
        const CvDesc dA_ = GEN(it_); const CvDesc dB_ = GEN(h1_ ? it_ + st_ : it_); \
        cv_load(dA_, F.lane, bA_); cv_load(dB_, F.lane, bB_);     \
        cv_store(dA_, F.lane, bA_, scr); if (h1_) cv_store(dB_, F.lane, bB_, scr); } } while (0)
__device__ __forceinline__ void phase0(const Ctx& F) {
    LAS float* sil = (LAS float*)F.lds;
    LAS float* red = (LAS float*)(F.lds + 17 * 1024 * 4);
    float* mod = (float*)(F.ws + WS_MOD);
    for (int it = F.bid; it < 192; it += F.G) {
        const int l = it / 96, col0 = (it % 96) * 64;
        for (int idx = F.tid; idx < 17 * 1024; idx += 512) { const int r = idx >> 10, k = idx & 1023; const float v = r < 16 ? F.a->in[1][r * 1024 + k] : F.a->in[3][k]; sil[idx] = silu_f(v); }
        __syncthreads();
        float a[17];
#pragma unroll
        for (int r = 0; r < 17; ++r) a[r] = 0.f;
        const int k0 = F.wave * 128;
        const float* wp = F.a->in[4] + ((size_t)l * 1024 + k0) * 6144 + col0 + F.lane;
#pragma unroll 4
        for (int kk = 0; kk < 128; ++kk) { const float w = wp[(size_t)kk * 6144];
#pragma unroll
            for (int r = 0; r < 17; ++r) a[r] += sil[r * 1024 + k0 + kk] * w; }
#pragma unroll
        for (int r = 0; r < 17; ++r) red[(F.wave * 17 + r) * 64 + F.lane] = a[r];
        __syncthreads();
        for (int idx = F.tid; idx < 17 * 64; idx += 512) { const int r = idx >> 6, cc = idx & 63; float s = F.a->in[5][l * 6144 + col0 + cc];
#pragma unroll
            for (int w8 = 0; w8 < 8; ++w8) s += red[(w8 * 17 + r) * 64 + cc];
            mod[(size_t)(l * 17 + r) * 6144 + col0 + cc] = s; }
        __syncthreads();
    }
    __syncthreads();
    LAS float* scr = (LAS float*)(F.lds + F.wave * 16384);
    const int gw = F.bid * 8 + F.wave, NGW = F.G * 8;
    const int nexp_items = (F.G == 256) ? I_E1 : 2 * I_E1;
    const int NITEMS = nexp_items + I_IN + I_OUT + I_POOL;
#define CV_GEN0(i_) cv_phase0(F, (i_), nexp_items)
    CV_RUN(gw, NITEMS, NGW, CV_GEN0);
#undef CV_GEN0
}
__device__ __forceinline__ void convert_tail(const Ctx& F, int vc, int first, int lo, int hi) {
    if (F.G != 256) return;
    if (first >= F.G) first = 0;
    if (vc < first) return;
    LAS float* scr = (LAS float*)(F.lds + F.wave * 16384);
    const int nw = (F.G - first) * 8;
#define CV_GEN1(i_) cv_expert(F, 1, (i_))
    CV_RUN(lo + (vc - first) * 8 + F.wave, hi, nw, CV_GEN1);
#undef CV_GEN1
}

__device__ __forceinline__ void p1_load(const Ctx& F, int row, f32x4 (&b)[4]) {
    const float* src = row < T ? F.a->in[0] + (size_t)row * D : F.a->in[2] + (size_t)(row - T) * D;
#pragma unroll
    for (int j = 0; j < 4; ++j) b[j] = *(const f32x4*)(src + 4 * F.lane + 256 * j);
}
__device__ __forceinline__ void p1_row(const Ctx& F, int row, const f32x4 (&v)[4], f32x4 (&sh)[4], f32x4 (&sc)[4], int& mr_cur) {
    const int mr = row < T ? (row >> 11) : 16;
    if (mr != mr_cur) { mr_cur = mr;
#pragma unroll
        for (int j = 0; j < 4; ++j) { sh[j] = *(const f32x4*)(modp(F, 0, mr, 0) + 4 * F.lane + 256 * j); sc[j] = *(const f32x4*)(modp(F, 0, mr, 1) + 4 * F.lane + 256 * j) + 1.0f; } }
    unsigned long long* o8 = (unsigned long long*)((bf16*)(F.ws + WS_XA) + (size_t)row * D) + F.lane;
#pragma unroll
    for (int j = 0; j < 4; ++j) { const f32x4 y = v[j] * sc[j] + sh[j];
        o8[64 * j] = (unsigned long long)pk2(y.x, y.y) | ((unsigned long long)pk2(y.z, y.w) << 32); }
}
__device__ __forceinline__ void phase1(const Ctx& F) {
    const int gw = F.bid * 8 + F.wave, NGW = F.G * 8;
    const int per = (T + TC + NGW - 1) / NGW, r_lo = gw * per, r_hi = min(r_lo + per, T + TC);
    if (r_lo >= r_hi) return;
    f32x4 A[4], B[4], sh[4], sc[4]; int mr_cur = -1;
    p1_load(F, r_lo, A);
    for (int row = r_lo; row < r_hi; row += 2) {
        if (row + 1 < r_hi) p1_load(F, row + 1, B);
        asm volatile("" ::: "memory");
        p1_row(F, row, A, sh, sc, mr_cur);
        if (row + 1 < r_hi) {
            if (row + 2 < r_hi) p1_load(F, row + 2, A);
            asm volatile("" ::: "memory");
            p1_row(F, row + 1, B, sh, sc, mr_cur);
        }
    }
}

struct SchedIn {
    int G, c; const char* Wt;
    __device__ __forceinline__ bool next(int i, g8::Unit& u) const {
        const int L = i * G + c; if (L >= 1792 + 128) return false;
        int pm, pn; if (L < 1792) g8::tile_of(L, 128, 14, pm, pn); else { g8::tile_of(L - 1792, 16, 8, pm, pn); pm += 128; }
        u.pm = pm; u.pn = pn; u.e = 0; u.aux = 0; u.B = Wt + (size_t)pn * 256 * 1024 * 2; return true; }
    __device__ __forceinline__ unsigned rowoff(const g8::Unit& u, int r) const { return (unsigned)(u.pm * 256 + r) * 2048u; }
};
struct EpiIn {
    unsigned char* ws; unsigned char* dout; LAS unsigned char* lds;
    __device__ __forceinline__ void tstore(const f32x4 (&v)[4], LAS bf16* scr, bf16* dst0, size_t colpitch, int lane, int fr, int fq) const {
#pragma unroll
        for (int m = 0; m < 4; ++m)
#pragma unroll
            for (int j = 0; j < 4; j += 2) { const unsigned w = pk2(v[m][j], v[m][j + 1]); scr[(4 * fq + j) * 72 + 16 * m + fr] = (bf16)(w & 0xffffu); scr[(4 * fq + j + 1) * 72 + 16 * m + fr] = (bf16)(w >> 16); }
        LDS_WAIT(); asm volatile("" ::: "memory");
#pragma unroll
        for (int i = 0; i < 2; ++i) { const int q = lane + 64 * i, cc = q >> 3, ch = q & 7;
            const u32x4 w = *(const LAS u32x4*)(scr + cc * 72 + ch * 8);
            *(u32x4*)(dst0 + (size_t)cc * colpitch + ch * 8) = w; }
        LDS_WAIT(); asm volatile("" ::: "memory");
    }
    __device__ __forceinline__ void operator()(const f32x4 (&acc)[2][2][4][2], const g8::Unit& u, int wr, int wc, int fr, int fq) const {
        const bool isctx = u.pm >= 128;
        const int lane = fr + 16 * fq, wid = wr * 4 + wc;
        LAS bf16* scr = (LAS bf16*)(lds + LDS_SCR_OFF + wid * 2304);
        const int row0 = u.pm * 256 + wr * 64 + fr;
        const int bb = isctx ? (u.pm - 128) : (u.pm >> 3);
        const int tt0 = isctx ? 0 : ((u.pm & 7) * 256);
        const size_t tp = isctx ? CTXL : TPITCH;
        const int pn = u.pn;
        if (pn < 2 || pn == 8 || pn == 9) {
            const float scale = (pn >= 8) ? 0.08838834764831845f : 1.0f;
            const int dd = 16 * wc + 4 * fq;
            f32x4 invf;
#pragma unroll
            for (int j = 0; j < 4; ++j) invf[j] = fexp2(-(float)((dd & 31) + j) * (13.287712379549449f / 32.0f));
#pragma unroll
            for (int ai = 0; ai < 2; ++ai)
#pragma unroll
                for (int bj = 0; bj < 2; ++bj) {
                    f32x4 o1[4], o2[4];
#pragma unroll
                    for (int m = 0; m < 4; ++m) { const int row = row0 + ai * 128 + m * 16;
                        f32x4 cs = (f32x4){1.f, 1.f, 1.f, 1.f}, sn = (f32x4){0.f, 0.f, 0.f, 0.f};
                        if (!isctx) { const float pos = (float)((wc < 2) ? (4 * (u.pm & 7) + wr + 2 * ai) : (fr + 16 * m));
#pragma unroll
                            for (int j = 0; j < 4; ++j) { const float ang = pos * invf[j]; cs[j] = __cosf(ang); sn[j] = __sinf(ang); } }
                        const f32x4 x1 = acc[ai][bj][m][0], x2 = acc[ai][bj][m][1];
                        o1[m] = (x1 * cs - x2 * sn) * scale; o2[m] = (x1 * sn + x2 * cs) * scale;
                        if (!isctx) { bf16* rp = (bf16*)(ws + WS_P) + (size_t)row * PW + (pn < 2 ? PO_RK + pn * 256 : PO_RQ + (pn - 8) * 256) + bj * 128 + dd;
                            *(u32x2*)(rp) = (u32x2){pk2(o1[m].x, o1[m].y), pk2(o1[m].z, o1[m].w)};
                            *(u32x2*)(rp + 64) = (u32x2){pk2(o2[m].x, o2[m].y), pk2(o2[m].z, o2[m].w)}; } }
                    if (pn < 2) {
                        const int head = pn * 2 + bj;
                        bf16* d0 = (bf16*)(dout + (isctx ? DO_KTRC : DO_KTR)) + ((size_t)(bb * 4 + head) * 128 + 16 * wc) * tp + tt0 + ai * 128 + wr * 64;
                        tstore(o1, scr, d0, tp, lane, fr, fq);
                        tstore(o2, scr, d0 + (size_t)64 * tp, tp, lane, fr, fq);
                    }
                }
        } else if (pn == 2 || pn == 3 || pn == 6 || pn == 7) {
#pragma unroll
            for (int ai = 0; ai < 2; ++ai)
#pragma unroll
                for (int bj = 0; bj < 2; ++bj)
#pragma unroll
                    for (int n = 0; n < 2; ++n) {
                        const int col = (pn & 1) * 256 + bj * 128 + wc * 32 + n * 16;
                        const size_t boff = (pn < 4) ? (isctx ? WS_VTRC : WS_VTR) : (isctx ? WS_VTNC : WS_VTN);
                        const size_t roff = (pn < 4) ? ((size_t)(bb * 4 + (col >> 7)) * 128 + (col & 127)) : ((size_t)(bb * 8 + (col >> 6)) * 64 + (col & 63));
                        bf16* d0 = (bf16*)(ws + boff) + roff * tp;
                        f32x4 v[4];
#pragma unroll
                        for (int m = 0; m < 4; ++m) v[m] = acc[ai][bj][m][n];
                        tstore(v, scr, d0 + tt0 + ai * 128 + wr * 64, tp, lane, fr, fq);
                    }
        } else {
            const float scale = (pn >= 12) ? 0.125f * 1.4426950408889634f : 1.0f;
            int ld = PW, c0; size_t boff = WS_P;
            if (pn < 6) { if (isctx) { boff = WS_PC; ld = PCW; } c0 = (isctx ? 0 : PO_NK) + (pn - 4) * 256; }
            else if (pn < 12) { c0 = PO_RG + (pn - 10) * 256; }
            else { c0 = PO_NQ + (pn - 12) * 256; }
            bf16* base = (bf16*)(ws + boff);
            const int rsub = isctx ? T : 0;
            const int col0 = c0 + wc * 32 + 8 * fq;
#pragma unroll
            for (int ai = 0; ai < 2; ++ai)
#pragma unroll
                for (int m = 0; m < 4; ++m) { bf16* rp = base + (size_t)(row0 + ai * 128 + m * 16 - rsub) * ld + col0;
#pragma unroll
                    for (int bj = 0; bj < 2; ++bj) { const f32x4 v0 = acc[ai][bj][m][0] * scale, v1 = acc[ai][bj][m][1] * scale;
                        *(u32x4*)(rp + bj * 128) = (u32x4){pk2(v0.x, v0.y), pk2(v0.z, v0.w), pk2(v1.x, v1.y), pk2(v1.z, v1.w)}; } }
        }
    }
};

__device__ __forceinline__ void dma16(const void* g, LAS unsigned char* l) { __builtin_amdgcn_global_load_lds((const unsigned*)g, (LAS unsigned*)l, 16, 0, 0); }
__device__ __forceinline__ bf16x8 frag256(const LAS unsigned char* tile, int row, int chunk) { return *(const LAS bf16x8*)(tile + row * 256 + ((chunk ^ (row & 15)) << 4)); }
__device__ __forceinline__ void phase3(const Ctx& F) {
    const bf16* KTr = (const bf16*)((const char*)F.H + DO_KTR); const bf16* KTrc = (const bf16*)((const char*)F.H + DO_KTRC);
    const bf16* VTr = (const bf16*)(F.ws + WS_VTR); const bf16* VTrc = (const bf16*)(F.ws + WS_VTRC);
    bf16* ST = (bf16*)((char*)F.H + DO_ST);
    const int lane = F.lane, r = lane & 31, hh = lane >> 5, dkt = F.wave & 3, dvs = F.wave >> 2, w = F.wave;
    for (int u0 = F.bid; u0 < 256; u0 += F.G) {
        const int unit = (F.G == 256) ? ((u0 & 7) * 32 + (u0 >> 3)) : u0;
        const int bh = unit >> 2, dvh = (unit >> 1) & 1, dir = unit & 1, h = bh & 3;
        const float lg2 = __log2f(1.0f - __expf(F.a->in[10][dir * 4 + h]));
        const float gstep = fexp2(dir == 0 ? -lg2 : lg2);
        const float cdec = fexp2(lg2 * 128.0f);
        f32x16 acc;
#pragma unroll
        for (int i = 0; i < 16; ++i) acc[i] = 0.f;
        __syncthreads();
#define P3_STAGE(s_) do { const int s__ = (s_); const bool cx = s__ < 2; const int ci = cx ? (dir == 0 ? s__ : 1 - s__) : (dir == 0 ? s__ - 2 : 17 - s__); \
            const bf16* kb = cx ? KTrc + (size_t)bh * 128 * CTXL + ci * 128 : KTr + (size_t)bh * 128 * TPITCH + ci * 128; \
            const bf16* vb = cx ? VTrc + ((size_t)bh * 128 + dvh * 64) * CTXL + ci * 128 : VTr + ((size_t)bh * 128 + dvh * 64) * TPITCH + ci * 128; \
            const size_t pitch = cx ? (size_t)CTXL : (size_t)TPITCH; \
            _Pragma("unroll") for (int i = 0; i < 6; ++i) { const int idx = (i < 4 ? i : i - 4) * 512 + w * 64 + lane, R = idx >> 4, cc = (idx & 15) ^ (R & 15); \
                dma16((i < 4 ? kb : vb) + (size_t)R * pitch + 8 * cc, F.lds + (s__ % 3) * 49152 + (i * 512 + w * 64) * 16); } } while (0)
        P3_STAGE(0); P3_STAGE(1);
#pragma unroll 1
        for (int s = 0; s < 18; ++s) {
            if (s >= 2) {
                const int c = dir == 0 ? s - 2 : 17 - s;
                bf16* sp = ST + ((((size_t)dir * 64 + bh) * 16 + c) * 128 + dvh * 64 + dvs * 32 + r) * 128 + dkt * 32 + 4 * hh;
#pragma unroll
                for (int g = 0; g < 4; ++g) *(u32x2*)(sp + 8 * g) = (u32x2){pk2(acc[4 * g], acc[4 * g + 1]), pk2(acc[4 * g + 2], acc[4 * g + 3])};
            }
            if (s < 2) asm volatile("s_waitcnt vmcnt(6)" ::: "memory"); else if (s < 17) asm volatile("s_waitcnt vmcnt(10)" ::: "memory"); else asm volatile("s_waitcnt vmcnt(0)" ::: "memory");
            __builtin_amdgcn_s_barrier(); asm volatile("" ::: "memory");
            if (s < 16) P3_STAGE(s + 2);
            if (s < 17) {
#pragma unroll
                for (int i = 0; i < 16; ++i) acc[i] *= cdec;
                const LAS unsigned char* kt = F.lds + (s % 3) * 49152; const LAS unsigned char* vt = kt + 32768;
#pragma unroll
                for (int ks = 0; ks < 8; ++ks) {
                    const bf16x8 af = frag256(kt, 32 * dkt + r, 2 * ks + hh); const bf16x8 vv = frag256(vt, 32 * dvs + r, 2 * ks + hh); bf16x8 bfr;
                    const int tk = 16 * ks + 8 * hh; float wgt = fexp2(lg2 * (float)(dir == 0 ? (127 - tk) : tk));
                    float wv8[8];
#pragma unroll
                    for (int j = 0; j < 8; ++j) { wv8[j] = bf2f((unsigned short)vv[j]) * wgt; wgt *= gstep; }
                    bfr = pack8((f32x4){wv8[0], wv8[1], wv8[2], wv8[3]}, (f32x4){wv8[4], wv8[5], wv8[6], wv8[7]});
                    acc = __builtin_amdgcn_mfma_f32_32x32x16_bf16(af, bfr, acc, 0, 0, 0);
                }
            }
        }
        asm volatile("s_waitcnt vmcnt(0) lgkmcnt(0)" ::: "memory");
        __syncthreads();
#undef P3_STAGE
    }
}

__device__ __forceinline__ void ret_unit(const Ctx& F, int unit) {
    const bf16* P = (const bf16*)(F.ws + WS_P); const bf16* ST = (const bf16*)((const char*)F.H + DO_ST); const bf16* VTr = (const bf16*)(F.ws + WS_VTR); bf16* Y = (bf16*)(F.ws + WS_XA);
    int lane = F.lane; asm volatile("" : "+v"(lane));
    const int li = lane & 15, kq = lane >> 4, w = F.wave;
    const int b = unit >> 6, h = (unit >> 4) & 3, c = unit & 15, bh = b * 4 + h;
    const size_t tok0 = (size_t)b * SEQ + c * 128;
    const int i0 = 16 * w;
    const float lgf = __log2f(1.0f - __expf(F.a->in[10][h])), lgb = __log2f(1.0f - __expf(F.a->in[10][4 + h]));
    constexpr int T_ST0 = 0, T_K = 65536, T_V = 98304;
    __syncthreads();
#pragma unroll
    for (int i = 0; i < 16; ++i) { const int tile = i >> 2; const int idx = (i & 3) * 512 + w * 64 + lane, R = idx >> 4, cc = (idx & 15) ^ (R & 15);
        const bf16* src;
        if (tile < 2) src = ST + ((((size_t)tile * 64 + bh) * 16 + c) * 128 + R) * 128 + 8 * cc;
        else if (tile == 2) src = P + (tok0 + R) * PW + PO_RK + h * 128 + 8 * cc;
        else src = VTr + ((size_t)bh * 128 + R) * TPITCH + c * 128 + 8 * cc;
        dma16(src, F.lds + (i * 512 + w * 64) * 16); }
    bf16x8 qf[4];
    { const bf16* qp = P + (tok0 + i0 + li) * PW + PO_RQ + h * 128 + 8 * kq;
#pragma unroll
      for (int ks = 0; ks < 4; ++ks) qf[ks] = *(const bf16x8*)(qp + 32 * ks); }
    asm volatile("s_waitcnt vmcnt(0)" ::: "memory");
    __syncthreads();
    f32x4 O[8];
#pragma unroll
    for (int dirn = 0; dirn < 2; ++dirn) {
        const LAS unsigned char* tl = F.lds + T_ST0 + dirn * 32768;
        float rs[4];
#pragma unroll
        for (int jj = 0; jj < 4; ++jj) { const int i = i0 + 4 * kq + jj; rs[jj] = dirn == 0 ? fexp2(lgf * (float)(i + 1)) : fexp2(lgb * (float)(128 - i)); }
#pragma unroll
        for (int nt = 0; nt < 8; ++nt) { f32x4 a = (f32x4){0.f, 0.f, 0.f, 0.f};
#pragma unroll
            for (int ks = 0; ks < 4; ++ks) a = __builtin_amdgcn_mfma_f32_16x16x32_bf16(qf[ks], frag256(tl, 16 * nt + li, 4 * ks + kq), a, 0, 0, 0);
#pragma unroll
            for (int jj = 0; jj < 4; ++jj) { const float v = a[jj] * rs[jj]; if (dirn == 0) O[nt][jj] = v; else O[nt][jj] += v; } }
    }
    bf16x8 pf[4];
    const int krow = 8 * (li >> 2) + (li & 3);
#pragma unroll
    for (int u = 0; u < 4; ++u) {
        f32x4 s2[2];
#pragma unroll
        for (int hf = 0; hf < 2; ++hf) { f32x4 a = (f32x4){0.f, 0.f, 0.f, 0.f};
#pragma unroll
            for (int ks = 0; ks < 4; ++ks) a = __builtin_amdgcn_mfma_f32_16x16x32_bf16(frag256(F.lds + T_K, 32 * u + krow + 4 * hf, 4 * ks + kq), qf[ks], a, 0, 0, 0);
#pragma unroll
            for (int jj = 0; jj < 4; ++jj) { const int dlt = (i0 + li) - (32 * u + 8 * kq + 4 * hf + jj);
                const float ex = fexp2((dlt > 0 ? lgf : lgb) * fabsf((float)dlt));
                a[jj] *= (dlt == 0) ? 2.0f : ex; }
            s2[hf] = a; }
        pf[u] = pack8(s2[0], s2[1]);
    }
#pragma unroll
    for (int u = 0; u < 4; ++u)
#pragma unroll
        for (int nt = 0; nt < 8; ++nt) O[nt] = __builtin_amdgcn_mfma_f32_16x16x32_bf16(pf[u], frag256(F.lds + T_V, 16 * nt + li, 4 * u + kq), O[nt], 0, 0, 0);
    __syncthreads();
    LAS float* osc = (LAS float*)(F.lds + w * 8448);
#pragma unroll
    for (int jj = 0; jj < 4; ++jj) {
        float sm = 0.f;
#pragma unroll
        for (int nt = 0; nt < 8; ++nt) sm += O[nt][jj];
        sm += __shfl_xor(sm, 1); sm += __shfl_xor(sm, 2); sm += __shfl_xor(sm, 4); sm += __shfl_xor(sm, 8);
        const float mean = sm * (1.0f / 128.0f); float q = 0.f;
#pragma unroll
        for (int nt = 0; nt < 8; ++nt) { const float d = O[nt][jj] - mean; q += d * d; }
        q += __shfl_xor(q, 1); q += __shfl_xor(q, 2); q += __shfl_xor(q, 4); q += __shfl_xor(q, 8);
        const float rstd = __builtin_amdgcn_rsqf(q * (1.0f / 128.0f) + LN_EPS);
#pragma unroll
        for (int nt = 0; nt < 8; ++nt) osc[(4 * kq + jj) * 132 + 16 * nt + li] = (O[nt][jj] - mean) * rstd;
    }
    LDS_WAIT(); asm volatile("" ::: "memory");
#pragma unroll
    for (int i = 0; i < 4; ++i) { const int q = lane + 64 * i, row = q >> 4, ch = q & 15; const size_t tk = tok0 + i0 + row;
        const f32x4 a = *(const LAS f32x4*)(osc + row * 132 + 8 * ch), c2 = *(const LAS f32x4*)(osc + row * 132 + 8 * ch + 4);
        const u32x4 g = *(const u32x4*)(P + tk * PW + PO_RG + h * 128 + 8 * ch);
        u32x4 o;
        o.x = pk2(silu_f(bflo(g.x)) * a.x, silu_f(bfhi(g.x)) * a.y); o.y = pk2(silu_f(bflo(g.y)) * a.z, silu_f(bfhi(g.y)) * a.w);
        o.z = pk2(silu_f(bflo(g.z)) * c2.x, silu_f(bfhi(g.z)) * c2.y); o.w = pk2(silu_f(bflo(g.w)) * c2.z, silu_f(bfhi(g.w)) * c2.w);
        if (ABL & 32) o = (u32x4){0u, 0u, 0u, 0u};
        *(u32x4*)(Y + tk * D + h * 128 + 8 * ch) = o; }
    LDS_WAIT(); asm volatile("" ::: "memory");
}
__device__ __forceinline__ void na_unit(const Ctx& F, int unit, bool load_ctx) {
    const bf16* P = (const bf16*)(F.ws + WS_P); const bf16* Pc = (const bf16*)(F.ws + WS_PC); bf16* Y = (bf16*)(F.ws + WS_XA);
    const bf16* VTn = (const bf16*)(F.ws + WS_VTN); const bf16* VTnc = (const bf16*)(F.ws + WS_VTNC);
    int lane = F.lane; asm volatile("" : "+v"(lane));
    const int li = lane & 15, kq = lane >> 4, w = F.wave;
    const int b = unit >> 7, nh = (unit >> 4) & 7, rp = unit & 15;
    const int r = 2 * rp + (w >> 2), cb = w & 3;
    const int rmin = min(max(2 * rp - 4, 0), GROWS - 8);
    const int r0 = min(max(r - 4, 0), GROWS - 8), kstart = min(max(16 * cb - 8, 0), GRIDW - 32);
    const int qc = 16 * cb + li; const int wstart = min(max(qc - 8, 0), GRIDW - 16);
    const size_t tokb = (size_t)b * SEQ;
    const int krow = 8 * (li >> 2) + (li & 3);
    constexpr int L_CTX = 73728, L_TBL = 106496, L_CTXV = 108544;
    __syncthreads();
#pragma unroll
    for (int i = 0; i < 13; ++i) { const int idx = i * 512 + w * 64 + lane; const bf16* src;
        if (i < 9) { const int R = idx >> 3, cc = (idx & 7) ^ (R & 7); const int kr = min(rmin + (R >> 6), GROWS - 1);
            src = P + (tokb + kr * 64 + (R & 63)) * PW + PO_NK + nh * 64 + 8 * cc; }
        else { if (!load_ctx) continue; const int id2 = idx - 4608, R = id2 >> 3, cc = (id2 & 7) ^ (R & 7); src = Pc + ((size_t)b * CTXL + R) * PCW + nh * 64 + 8 * cc; }
        dma16(src, F.lds + (i * 512 + w * 64) * 16); }
    if (load_ctx) {
#pragma unroll
        for (int i = 0; i < 4; ++i) { const int id2 = i * 512 + w * 64 + lane, Rd = id2 >> 5, cc = (id2 & 31) ^ (Rd & 7);
            dma16(VTnc + ((size_t)(b * 8 + nh) * 64 + Rd) * CTXL + 8 * cc, F.lds + L_CTXV + (i * 512 + w * 64) * 16); } }
    LAS float* tbl = (LAS float*)(F.lds + L_TBL);
    for (int q = F.tid; q < 15 * 32; q += 512) { const int rr = q >> 5, cc = q & 31; tbl[q] = cc < 31 ? F.a->in[11][(size_t)(nh * 15 + rr) * 31 + cc] * 1.4426950408889634f : -3.0e38f; }
    bf16x8 qf[2];
    { const bf16* qp = P + (tokb + r * 64 + qc) * PW + PO_NQ + nh * 64 + 8 * kq; qf[0] = *(const bf16x8*)qp; qf[1] = *(const bf16x8*)(qp + 32); }
    asm volatile("s_waitcnt vmcnt(0)" ::: "memory");
    __syncthreads();
    int cidx[8];
#pragma unroll
    for (int o = 0; o < 8; ++o) { const int kc = kstart + 8 * kq + o; const bool ok = (kc >= wstart) && (kc < wstart + 16); cidx[o] = ok ? (kc - qc + 15) : 31; }
    f32x4 sw[16], sc[16];
    float mx = -3.0e38f;
#pragma unroll
    for (int wt = 0; wt < 16; ++wt) {
        const int kr = r0 + (wt >> 1);
        f32x4 a;
#pragma unroll
        for (int jj = 0; jj < 4; ++jj) a[jj] = tbl[(kr - r + 7) * 32 + cidx[4 * (wt & 1) + jj]];
        const int R = (kr - rmin) * 64 + kstart + krow + 4 * (wt & 1);
        const LAS unsigned char* rowp = F.lds + R * 128;
        a = __builtin_amdgcn_mfma_f32_16x16x32_bf16(*(const LAS bf16x8*)(rowp + ((kq ^ (R & 7)) << 4)), qf[0], a, 0, 0, 0);
        a = __builtin_amdgcn_mfma_f32_16x16x32_bf16(*(const LAS bf16x8*)(rowp + (((4 + kq) ^ (R & 7)) << 4)), qf[1], a, 0, 0, 0);
#pragma unroll
        for (int jj = 0; jj < 4; ++jj) mx = fmaxf(mx, a[jj]);
        sw[wt] = a;
    }
#pragma unroll
    for (int ct = 0; ct < 16; ++ct) {
        const int R = 32 * (ct >> 1) + krow + 4 * (ct & 1);
        const LAS unsigned char* rowp = F.lds + L_CTX + R * 128;
        f32x4 a = (f32x4){0.f, 0.f, 0.f, 0.f};
        a = __builtin_amdgcn_mfma_f32_16x16x32_bf16(*(const LAS bf16x8*)(rowp + ((kq ^ (R & 7)) << 4)), qf[0], a, 0, 0, 0);
        a = __builtin_amdgcn_mfma_f32_16x16x32_bf16(*(const LAS bf16x8*)(rowp + (((4 + kq) ^ (R & 7)) << 4)), qf[1], a, 0, 0, 0);
#pragma unroll
        for (int jj = 0; jj < 4; ++jj) mx = fmaxf(mx, a[jj]);
        sc[ct] = a;
    }
    __syncthreads();
#pragma unroll
    for (int i = 0; i < 13; ++i) { const int idx = i * 512 + w * 64 + lane; const bf16* src;
        if (i < 9) { const int Rd = idx / 72, q = idx - Rd * 72, cc = q ^ (Rd & 7); const int kr = min(rmin + (cc >> 3), GROWS - 1);
            src = VTn + ((size_t)(b * 8 + nh) * 64 + Rd) * TPITCH + kr * 64 + (cc & 7) * 8; }
        else continue;
        dma16(src, F.lds + (i * 512 + w * 64) * 16); }
    mx = fmaxf(mx, __shfl_xor(mx, 16)); mx = fmaxf(mx, __shfl_xor(mx, 32));
    float sum = 0.f;
#pragma unroll
    for (int wt = 0; wt < 16; ++wt)
#pragma unroll
        for (int jj = 0; jj < 4; ++jj) { const float e = fexp2(sw[wt][jj] - mx); sw[wt][jj] = e; sum += e; }
#pragma unroll
    for (int ct = 0; ct < 16; ++ct)
#pragma unroll
        for (int jj = 0; jj < 4; ++jj) { const float e = fexp2(sc[ct][jj] - mx); sc[ct][jj] = e; sum += e; }
    sum += __shfl_xor(sum, 16); sum += __shfl_xor(sum, 32);
    asm volatile("s_waitcnt vmcnt(0)" ::: "memory");
    __syncthreads();
    f32x4 O[4];
#pragma unroll
    for (int nt = 0; nt < 4; ++nt) O[nt] = (f32x4){0.f, 0.f, 0.f, 0.f};
#pragma unroll
    for (int u = 0; u < 8; ++u) { bf16x8 pf;
        pf = pack8(sw[2 * u], sw[2 * u + 1]);
        const int cch = (r0 + u - rmin) * 8 + (kstart >> 3) + kq;
#pragma unroll
        for (int nt = 0; nt < 4; ++nt) { const int Rd = 16 * nt + li;
            O[nt] = __builtin_amdgcn_mfma_f32_16x16x32_bf16(pf, *(const LAS bf16x8*)(F.lds + Rd * 1152 + ((cch ^ (Rd & 7)) << 4)), O[nt], 0, 0, 0); } }
#pragma unroll
    for (int u = 0; u < 8; ++u) { bf16x8 pf;
        pf = pack8(sc[2 * u], sc[2 * u + 1]);
#pragma unroll
        for (int nt = 0; nt < 4; ++nt) { const int Rd = 16 * nt + li;
            O[nt] = __builtin_amdgcn_mfma_f32_16x16x32_bf16(pf, *(const LAS bf16x8*)(F.lds + L_CTXV + Rd * 512 + (((4 * u + kq) ^ (Rd & 7)) << 4)), O[nt], 0, 0, 0); } }
    __syncthreads();
    LAS float* osc = (LAS float*)(F.lds + w * 4352);
#pragma unroll
    for (int jj = 0; jj < 4; ++jj) {
        const float sq = __shfl(sum, 4 * kq + jj); const float inv = frcp(sq);
#pragma unroll
        for (int nt = 0; nt < 4; ++nt) osc[(4 * kq + jj) * 68 + 16 * nt + li] = O[nt][jj] * inv;
    }
    LDS_WAIT(); asm volatile("" ::: "memory");
#pragma unroll
    for (int i = 0; i < 2; ++i) { const int q = lane + 64 * i, row = q >> 3, ch = q & 7;
        const f32x4 a = *(const LAS f32x4*)(osc + row * 68 + 8 * ch), c2 = *(const LAS f32x4*)(osc + row * 68 + 8 * ch + 4);
        u32x4 o = (u32x4){pk2(a.x, a.y), pk2(a.z, a.w), pk2(c2.x, c2.y), pk2(c2.z, c2.w)};
        if (ABL & 16) o = (u32x4){0u, 0u, 0u, 0u};
        *(u32x4*)(Y + (tokb + r * 64 + 16 * cb + row) * D + 512 + nh * 64 + 8 * ch) = o; }
    LDS_WAIT(); asm volatile("" ::: "memory");
}
__device__ __forceinline__ void phase4(const Ctx& F) {
#ifndef P4MASK
#define P4MASK 3
#endif
    if (P4MASK & 1) for (int u = F.bid; u < 1024; u += F.G) ret_unit(F, u);
    if (P4MASK & 2) {
        if (F.G == 256) { const int vb = (F.bid & 7) * 32 + (F.bid >> 3);
            for (int k = 0; k < 8; ++k) na_unit(F, vb * 8 + k, k == 0); }
        else for (int u = F.bid; u < 2048; u += F.G) na_unit(F, u, true);
    }
}

struct SchedOut {
    int G, c; const char* Wt;
    __device__ __forceinline__ bool next(int i, g8::Unit& u) const {
        const int L = i * G + c; if (L >= 512) return false;
        int pm, pn; g8::tile_of(L, 128, 4, pm, pn); u.pm = pm; u.pn = pn; u.e = 0; u.aux = 0; u.B = Wt + (size_t)pn * 256 * 1024 * 2; return true; }
    __device__ __forceinline__ unsigned rowoff(const g8::Unit& u, int r) const { return (unsigned)(u.pm * 256 + r) * 2048u; }
};
struct EpiY {
    static constexpr bool IDEMP = true;
    bf16* Yg; const float* gate0; const float* cs; float abl;
    __device__ __forceinline__ void operator()(const f32x4 (&acc)[2][2][4][2], const g8::Unit& u, int wr, int wc, int fr, int fq) const {
        const int row0 = u.pm * 256 + wr * 64 + fr, col0 = u.pn * 256 + wc * 32 + 8 * fq;
        const float* gp = gate0 + (size_t)(row0 >> 11) * 6144 + col0;
        f32x4 gv[2][2];
#pragma unroll
        for (int bj = 0; bj < 2; ++bj)
#pragma unroll
            for (int n = 0; n < 2; ++n) { gv[bj][n] = *(const f32x4*)(gp + bj * 128 + n * 4) * abl; if (cs) gv[bj][n] *= *(const f32x4*)(cs + col0 + bj * 128 + n * 4); }
#pragma unroll
        for (int ai = 0; ai < 2; ++ai)
#pragma unroll
            for (int m = 0; m < 4; ++m) { bf16* rp = Yg + (size_t)(row0 + ai * 128 + m * 16) * D + col0;
#pragma unroll
                for (int bj = 0; bj < 2; ++bj) { const f32x4 v0 = acc[ai][bj][m][0] * gv[bj][0], v1 = acc[ai][bj][m][1] * gv[bj][1];
                    *(u32x4*)(rp + bj * 128) = (u32x4){pk2(v0.x, v0.y), pk2(v0.z, v0.w), pk2(v1.x, v1.y), pk2(v1.z, v1.w)}; } }
    }
};

struct LnVecs { f32x4 lg[4], lb[4], sh[4], sc1[4]; f32x4 br1; };
__device__ __forceinline__ void ln_load(const float* R32, const bf16* R16, const bf16* Yg, int t, int lane, f32x4 (&nr)[4], u32x2 (&ny)[4]) {
    const u32x2* yr = (const u32x2*)(Yg + (size_t)t * D) + lane;
    if (R32) { const float* rr = R32 + (size_t)t * D;
#pragma unroll
        for (int j = 0; j < 4; ++j) nr[j] = *(const f32x4*)(rr + 4 * lane + 256 * j); }
    else { const u32x2* rr = (const u32x2*)(R16 + (size_t)t * D) + lane;
#pragma unroll
        for (int j = 0; j < 4; ++j) { const u32x2 h = rr[64 * j]; nr[j] = (f32x4){bflo(h.x), bfhi(h.x), bflo(h.y), bfhi(h.y)}; } }
#pragma unroll
    for (int j = 0; j < 4; ++j) ny[j] = yr[64 * j];
}
__device__ __forceinline__ void ln_row(const Ctx& F, int l, int t, const f32x4 (&nr)[4], const u32x2 (&ny)[4], const LnVecs& V, LAS f32x4* wl, LAS u32x4* rec_slot) {
    const int lane = F.lane; const LAS float* br2l = (const LAS float*)(F.lds + 149760);
    bf16* hm = (bf16*)(F.ws + WS_XA);
    unsigned long long* hr8 = (unsigned long long*)((bf16*)(F.ws + WS_H16) + (size_t)t * D) + lane;
    f32x4 v[4]; float s = 0.f;
#pragma unroll
    for (int j = 0; j < 4; ++j) { const u32x2 y = ny[j]; v[j] = nr[j] * ALPHA + (f32x4){bflo(y.x), bfhi(y.x), bflo(y.y), bfhi(y.y)}; s += (v[j].x + v[j].y) + (v[j].z + v[j].w); }
    const float mean = wave_sum(s) * (1.0f / D); float s2 = 0.f;
#pragma unroll
    for (int j = 0; j < 4; ++j) { v[j] = v[j] - mean; s2 += (v[j].x * v[j].x + v[j].y * v[j].y) + (v[j].z * v[j].z + v[j].w * v[j].w); }
    const float rstd = __builtin_amdgcn_rsqf(wave_sum(s2) * (1.0f / D) + LN_EPS);
    unsigned long long* o8 = (unsigned long long*)(hm + (size_t)t * D) + lane;
    float pg[4] = {0.f, 0.f, 0.f, 0.f};
#pragma unroll
    for (int j = 0; j < 4; ++j) { const int ci = 4 * lane + 256 * j;
        const f32x4 h1 = v[j] * rstd * V.lg[j] + V.lb[j];
        hr8[64 * j] = (unsigned long long)pk2(h1.x, h1.y) | ((unsigned long long)pk2(h1.z, h1.w) << 32);
        const f32x4 m = h1 * V.sc1[j] + V.sh[j];
        v[j] = m;
        o8[64 * j] = (unsigned long long)pk2(m.x, m.y) | ((unsigned long long)pk2(m.z, m.w) << 32);
#pragma unroll
        for (int e = 0; e < 4; ++e) { const f32x4 w = wl[(4 * j + e) * 64 + lane];
#pragma unroll
            for (int g = 0; g < 4; ++g) pg[g] += m[e] * w[g]; } }
    float lgt[4];
#pragma unroll
    for (int g = 0; g < 4; ++g) lgt[g] = wave_sum(pg[g]) + V.br1[g];
    int grp = 0; float gm = lgt[0];
#pragma unroll
    for (int g = 1; g < 4; ++g) if (lgt[g] > gm) { gm = lgt[g]; grp = g; }
    float gs = 0.f;
#pragma unroll
    for (int g = 0; g < 4; ++g) gs += __expf(lgt[g] - gm);
    const float gate_g = 1.0f / gs;
    float pe[8] = {0.f, 0.f, 0.f, 0.f, 0.f, 0.f, 0.f, 0.f};
#pragma unroll
    for (int j = 0; j < 4; ++j) {
#pragma unroll
        for (int e = 0; e < 4; ++e) { const f32x4 wa = wl[1024 + 2048 * grp + ((4 * j + e) * 2) * 64 + lane], wb = wl[1024 + 2048 * grp + ((4 * j + e) * 2 + 1) * 64 + lane];
#pragma unroll
            for (int q = 0; q < 4; ++q) { pe[q] += v[j][e] * wa[q]; pe[4 + q] += v[j][e] * wb[q]; } } }
    float le[8];
    {
        float a4[4], a2[2], a1;
#pragma unroll
        for (int q = 0; q < 4; ++q) { const float mine = (lane & 1) ? pe[q + 4] : pe[q], send = (lane & 1) ? pe[q] : pe[q + 4]; a4[q] = mine + __shfl_xor(send, 1); }
#pragma unroll
        for (int q = 0; q < 2; ++q) { const float mine = (lane & 2) ? a4[q + 2] : a4[q], send = (lane & 2) ? a4[q] : a4[q + 2]; a2[q] = mine + __shfl_xor(send, 2); }
        { const float mine = (lane & 4) ? a2[1] : a2[0], send = (lane & 4) ? a2[0] : a2[1]; a1 = mine + __shfl_xor(send, 4); }
        a1 += __shfl_xor(a1, 8); a1 += __shfl_xor(a1, 16); a1 += __shfl_xor(a1, 32);
#pragma unroll
        for (int q = 0; q < 8; ++q) { const int src = ((q >> 2) & 1) | (((q >> 1) & 1) << 1) | ((q & 1) << 2); le[q] = __shfl(a1, src) + br2l[grp * 8 + q]; }

    }
    int i0 = 0; float v0 = le[0];
#pragma unroll
    for (int q = 1; q < 8; ++q) if (le[q] > v0) { v0 = le[q]; i0 = q; }
    int i1 = -1; float v1 = -3.0e38f;
#pragma unroll
    for (int q = 0; q < 8; ++q) if (q != i0 && le[q] > v1) { v1 = le[q]; i1 = q; }
    const float e1 = __expf(v1 - v0); const float w0 = (ABL & 128) ? 0.f : gate_g / (1.0f + e1), w1 = (ABL & 1024) ? 1.0f : ((ABL & 64) ? 0.f : gate_g * e1 / (1.0f + e1));
    if (lane == 0) *rec_slot = (u32x4){(unsigned)(grp * 8 + i0), (unsigned)(grp * 8 + i1), __builtin_bit_cast(unsigned, w0), __builtin_bit_cast(unsigned, w1)};
}
__device__ __forceinline__ void phase_ln_router(const Ctx& F, int l, const float* R32, const bf16* Yg) {
    const bf16* R16 = (const bf16*)(F.ws + WS_H16);
    const int gw = F.bid * 8 + F.wave, lane = F.lane;
    int* tokinfo = (int*)(F.ws + WS_TOKINFO); int* list = (int*)(F.ws + WS_LIST);
    unsigned* cnt = (unsigned*)(F.ws + WS_CTL) + CW_CNT + 64 * (l * 32);
    LAS f32x4* wl = (LAS f32x4*)F.lds;
    __syncthreads();
    for (int k = F.tid; k < 1024; k += 512) { const int ln = (k & 255) >> 2, e = k & 3, j = k >> 8;
        wl[(4 * j + e) * 64 + ln] = *(const f32x4*)(F.a->in[14] + ((size_t)l * D + k) * 4);
#pragma unroll
        for (int g = 0; g < 4; ++g)
#pragma unroll
            for (int q = 0; q < 2; ++q) wl[1024 + 2048 * g + ((4 * j + e) * 2 + q) * 64 + ln] = *(const f32x4*)(F.a->in[16] + (((size_t)l * 4 + g) * D + k) * 8 + 4 * q); }
    if (F.tid < 32) ((LAS float*)(F.lds + 149760))[F.tid] = F.a->in[17][l * 32 + F.tid];
    __syncthreads();
    LAS u32x4* recs = (LAS u32x4*)(F.lds + 147456);
    const int t_lo = gw * 16;
    for (int tb = t_lo; tb < T; tb += F.G * 8 * 16) {
        const int b = tb >> 11;
        LnVecs V;
#pragma unroll
        for (int j = 0; j < 4; ++j) { const int ci = 4 * lane + 256 * j;
            V.lg[j] = *(const f32x4*)(F.a->in[6] + (l * 2 + 0) * D + ci); V.lb[j] = *(const f32x4*)(F.a->in[7] + (l * 2 + 0) * D + ci);
            V.sh[j] = *(const f32x4*)(modp(F, l, b, 3) + ci); V.sc1[j] = *(const f32x4*)(modp(F, l, b, 4) + ci) + 1.0f; }
        V.br1 = *(const f32x4*)(F.a->in[15] + l * 4);
        f32x4 rA[4], rB[4]; u32x2 yA[4], yB[4];
        ln_load(R32, R16, Yg, tb, lane, rA, yA);
#pragma unroll 1
        for (int k = 0; k < 16; k += 2) {
            ln_load(R32, R16, Yg, tb + k + 1, lane, rB, yB);
            asm volatile("" ::: "memory");
            ln_row(F, l, tb + k, rA, yA, V, wl, recs + F.wave * 16 + k);
            if (k + 2 < 16) ln_load(R32, R16, Yg, tb + k + 2, lane, rA, yA);
            asm volatile("" ::: "memory");
            ln_row(F, l, tb + k + 1, rB, yB, V, wl, recs + F.wave * 16 + k + 1);
        }
        LAS int* lcnt = (LAS int*)(F.lds + 149504);
        __syncthreads();
        if (F.tid < 64) lcnt[F.tid] = 0;
        __syncthreads();
        int e = 0, lp = 0; unsigned wa = 0u, wb = 0u; const int which = F.tid & 1;
        const int r = F.tid >> 1; const int t = (tb - F.wave * 16) + r;
        if (F.tid < 256) { const u32x4 rec = recs[r]; e = which ? (int)rec.y : (int)rec.x; wa = rec.z; wb = rec.w;
            lp = __hip_atomic_fetch_add(&lcnt[e], 1, __ATOMIC_RELAXED, __HIP_MEMORY_SCOPE_WORKGROUP); }
        __syncthreads();
        if (F.tid < 32) lcnt[32 + F.tid] = (int)atomicAdd(cnt + 64 * F.tid, (unsigned)lcnt[F.tid]);
        __syncthreads();
        if (F.tid < 256) { const int pos = lcnt[32 + e] + lp;
            list[(size_t)e * LISTCAP + pos] = t;
            int* ti = tokinfo + (size_t)t * 8;
            *(u32x2*)(ti + 2 * which) = (u32x2){(unsigned)e, (unsigned)pos};
            if (which == 0) *(u32x2*)(ti + 4) = (u32x2){wa, wb}; }
    }
}

__device__ __forceinline__ void moe_table(const Ctx& F, int l) {
    LAS int* tab = (LAS int*)(F.lds + LDS_TAB_OFF);
    __syncthreads();
    if (F.tid < 32) tab[40 + F.tid] = (int)__hip_atomic_load((unsigned*)(F.ws + WS_CTL) + CW_CNT + 64 * (l * 32 + F.tid), __ATOMIC_RELAXED, __HIP_MEMORY_SCOPE_AGENT);
    __syncthreads();
    if (F.tid == 0) { int s = 0; for (int e = 0; e < 32; ++e) { tab[e] = s; s += (tab[40 + e] + 255) >> 8; } tab[32] = s; }
    __syncthreads();
}
__device__ __forceinline__ int moe_vc(int c, int G) { return (G == 256) ? (((c & 7) * 8 + (c >> 5)) * 4 + ((c >> 3) & 3)) : c; }
struct SchedMoe {
    int G, c; const char* Wt; size_t wstride; size_t pnstride; const LAS int* tab; const LAS int* tokl; int gather; unsigned lda2;
    __device__ __forceinline__ bool next(int i, g8::Unit& u) const {
        const int L = i * G + moe_vc(c, G); const int nrt = __builtin_amdgcn_readfirstlane(tab[32]); if (L >= 4 * nrt) return false;
        const int rt = L >> 2, pn = L & 3; int e = 0;
        for (int q = 1; q < 32; ++q) e = (tab[q] <= rt) ? q : e;
        e = __builtin_amdgcn_readfirstlane(e);
        u.pm = rt; u.pn = pn; u.e = e; u.aux = i; u.B = Wt + (size_t)e * wstride + (size_t)pn * pnstride; return true; }
    __device__ __forceinline__ unsigned rowoff(const g8::Unit& u, int r) const {
        if (gather) return (unsigned)tokl[u.aux * 256 + r] * lda2;
        return (unsigned)(u.pm * 256 + r) * lda2; }
};
constexpr int MOE_MAXU = 8, LDS_TOKL_OFF = LDSCTL_OFF + 1024;
static_assert(LDS_TOKL_OFF + MOE_MAXU * 256 * 4 <= LDS_BYTES && LDS_SCR_OFF + 8 * 2304 <= LDSCTL_OFF, "LDS map");
__device__ __forceinline__ void moe_tokl(const Ctx& F) {
    const LAS int* tab = (const LAS int*)(F.lds + LDS_TAB_OFF); LAS int* tokl = (LAS int*)(F.lds + LDS_TOKL_OFF);
    const int* list = (const int*)(F.ws + WS_LIST);
    for (int q = F.tid; q < MOE_MAXU * 256; q += 512) { const int i = q >> 8, r = q & 255; const int L = i * F.G + moe_vc(F.bid, F.G); int tk = 0;
        if (L < 4 * tab[32]) { const int rt = L >> 2; int e = 0; for (int k = 1; k < 32; ++k) e = (tab[k] <= rt) ? k : e;
            const int idx = (rt - tab[e]) * 256 + r; tk = list[(size_t)e * LISTCAP + (idx < tab[40 + e] ? idx : 0)]; }
        tokl[q] = tk; }
    __syncthreads();
}
struct EpiAct {
    bf16* act;
    __device__ __forceinline__ void operator()(const f32x4 (&acc)[2][2][4][2], const g8::Unit& u, int wr, int wc, int fr, int fq) const {
        const int row0 = u.pm * 256 + wr * 64 + fr, col0 = u.pn * 128 + wc * 32 + 8 * fq;
#pragma unroll
        for (int ai = 0; ai < 2; ++ai)
#pragma unroll
            for (int m = 0; m < 4; ++m) { bf16* rp = act + (size_t)(row0 + ai * 128 + m * 16) * HID + col0;
                const f32x4 g0 = acc[ai][0][m][0], u0 = acc[ai][0][m][1], g1 = acc[ai][1][m][0], u1 = acc[ai][1][m][1];
                *(u32x4*)rp = (u32x4){pk2(silu_f(g0.x) * u0.x, silu_f(g0.y) * u0.y), pk2(silu_f(g0.z) * u0.z, silu_f(g0.w) * u0.w),
                                      pk2(silu_f(g1.x) * u1.x, silu_f(g1.y) * u1.y), pk2(silu_f(g1.z) * u1.z, silu_f(g1.w) * u1.w)}; }
    }
};
struct EpiEo {
    bf16* eo;
    __device__ __forceinline__ void operator()(const f32x4 (&acc)[2][2][4][2], const g8::Unit& u, int wr, int wc, int fr, int fq) const {
        const int row0 = u.pm * 256 + wr * 64 + fr, col0 = u.pn * 256 + wc * 32 + 8 * fq;
#pragma unroll
        for (int ai = 0; ai < 2; ++ai)
#pragma unroll
            for (int m = 0; m < 4; ++m) { bf16* rp = eo + (size_t)(row0 + ai * 128 + m * 16) * D + col0;
#pragma unroll
                for (int bj = 0; bj < 2; ++bj) { const f32x4 v0 = acc[ai][bj][m][0], v1 = acc[ai][bj][m][1];
                    *(u32x4*)(rp + bj * 128) = (u32x4){pk2(v0.x, v0.y), pk2(v0.z, v0.w), pk2(v1.x, v1.y), pk2(v1.z, v1.w)}; } }
    }
};

struct CmbRow { u32x2 h[4]; u32x2 ea[4], eb[4]; };
__device__ __forceinline__ void cmb_load(const Ctx& F, const LAS int* tab, int t, const u32x4& ti, CmbRow& r) {
    const unsigned e0i = ti.x, p0i = ti.y, e1i = ti.z, p1i = ti.w;
    const size_t s0 = (size_t)tab[e0i] * 256 + p0i, s1 = (size_t)tab[e1i] * 256 + p1i;
    const bf16* eo = (const bf16*)(F.ws + WS_EO);
    const u32x2* e0 = (const u32x2*)(eo + s0 * D) + F.lane; const u32x2* e1 = (const u32x2*)(eo + s1 * D) + F.lane; const u32x2* hp = (const u32x2*)((const bf16*)(F.ws + WS_H16) + (size_t)t * D) + F.lane;
#pragma unroll
    for (int j = 0; j < 4; ++j) { r.ea[j] = e0[64 * j]; r.eb[j] = e1[64 * j]; r.h[j] = hp[64 * j]; }
}
__device__ __forceinline__ void cmb_row(const Ctx& F, int l, int t, const CmbRow& r, const u32x2& tw, const f32x4 (&gt)[4], const f32x4 (&lg)[4], const f32x4 (&lb)[4]) {
    const float ab = ((ABL >> (1 + 2 * l)) & 1) ? 0.f : 1.f;
    const unsigned twx = tw.x, twy = tw.y;
    const float w0 = ab * __uint_as_float(twx), w1 = ab * __uint_as_float(twy);
    f32x4 v[4]; float s = 0.f;
#pragma unroll
    for (int j = 0; j < 4; ++j) { const u32x2 a = r.ea[j], c2 = r.eb[j];
        f32x4 y; y.x = w0 * bflo(a.x) + w1 * bflo(c2.x); y.y = w0 * bfhi(a.x) + w1 * bfhi(c2.x); y.z = w0 * bflo(a.y) + w1 * bflo(c2.y); y.w = w0 * bfhi(a.y) + w1 * bfhi(c2.y);
        const u32x2 hh = r.h[j]; v[j] = (f32x4){bflo(hh.x), bfhi(hh.x), bflo(hh.y), bfhi(hh.y)} * ALPHA + gt[j] * y; s += (v[j].x + v[j].y) + (v[j].z + v[j].w); }
    const float mean = wave_sum(s) * (1.0f / D); float s2 = 0.f;
#pragma unroll
    for (int j = 0; j < 4; ++j) { v[j] = v[j] - mean; s2 += (v[j].x * v[j].x + v[j].y * v[j].y) + (v[j].z * v[j].z + v[j].w * v[j].w); }
    const float rstd = __builtin_amdgcn_rsqf(wave_sum(s2) * (1.0f / D) + LN_EPS);
    if (l == 1) { float* hr = F.H + (size_t)t * D;
#pragma unroll
        for (int j = 0; j < 4; ++j) *(f32x4*)(hr + 4 * F.lane + 256 * j) = v[j] * rstd * lg[j] + lb[j]; }
    else { unsigned long long* hr8 = (unsigned long long*)((bf16*)(F.ws + WS_H16) + (size_t)t * D) + F.lane;
#pragma unroll
        for (int j = 0; j < 4; ++j) { const f32x4 o = v[j] * rstd * lg[j] + lb[j]; hr8[64 * j] = (unsigned long long)pk2(o.x, o.y) | ((unsigned long long)pk2(o.z, o.w) << 32); } }
}
__device__ __forceinline__ void phase_combine(const Ctx& F, int l) {
    moe_table(F, l);
    const LAS int* tab = (const LAS int*)(F.lds + LDS_TAB_OFF);
    const int gw = F.bid * 8 + F.wave, lane = F.lane;
    const int* tokinfo = (const int*)(F.ws + WS_TOKINFO);
    for (int tb = gw * 16; tb < T; tb += F.G * 8 * 16) {
        const int b = tb >> 11;
        f32x4 gt[4], lg[4], lb[4];
#pragma unroll
        for (int j = 0; j < 4; ++j) { const int ci = 4 * lane + 256 * j; gt[j] = *(const f32x4*)(modp(F, l, b, 5) + ci);
            lg[j] = *(const f32x4*)(F.a->in[6] + (l * 2 + 1) * D + ci); lb[j] = *(const f32x4*)(F.a->in[7] + (l * 2 + 1) * D + ci); }
        u32x4 tiv = (u32x4){0u, 0u, 0u, 0u}; u32x2 twv = (u32x2){0u, 0u};
        if (lane < 16) { tiv = *(const u32x4*)(tokinfo + (size_t)(tb + lane) * 8); twv = *(const u32x2*)(tokinfo + (size_t)(tb + lane) * 8 + 4); }
#define CMB_TI(k_) ((u32x4){(unsigned)__shfl((int)tiv.x, (k_)), (unsigned)__shfl((int)tiv.y, (k_)), (unsigned)__shfl((int)tiv.z, (k_)), (unsigned)__shfl((int)tiv.w, (k_))})
#define CMB_TW(k_) ((u32x2){(unsigned)__shfl((int)twv.x, (k_)), (unsigned)__shfl((int)twv.y, (k_))})
        CmbRow A, B;
        cmb_load(F, tab, tb, CMB_TI(0), A);
#pragma unroll 1
        for (int k = 0; k < 16; k += 2) {
            cmb_load(F, tab, tb + k + 1, CMB_TI(k + 1), B);
            asm volatile("" ::: "memory");
            cmb_row(F, l, tb + k, A, CMB_TW(k), gt, lg, lb);
            if (k + 2 < 16) cmb_load(F, tab, tb + k + 2, CMB_TI(k + 2), A);
            asm volatile("" ::: "memory");
            cmb_row(F, l, tb + k + 1, B, CMB_TW(k + 1), gt, lg, lb);
        }
#undef CMB_TI
#undef CMB_TW
    }
}

template <int WH> __device__ __forceinline__ void pool_item(const Ctx& F, bf16* zp, int b, int p0, int ch) {
    const bf16* hb = (const bf16*)(F.ws + WS_H16) + (size_t)b * SEQ * D + ch;
    const f32x4 sc1 = *(const f32x4*)(modp(F, 1, b, 1) + ch) + 1.0f;
    u32x2 rw[8 + 2 * WH];
#pragma unroll
    for (int i = 0; i < 8 + 2 * WH; ++i) { const int p = p0 - WH + i; const bool ok = (p >= 0) && (p < SEQ); const u32x2 v = *(const u32x2*)(hb + (size_t)(ok ? p : p0) * D); rw[i] = ok ? v : (u32x2){0u, 0u}; }
#define PZ_ROW(i_) ((f32x4){bflo(rw[i_].x), bfhi(rw[i_].x), bflo(rw[i_].y), bfhi(rw[i_].y)})
    f32x4 sum = (f32x4){0.f, 0.f, 0.f, 0.f};
#pragma unroll
    for (int i = 0; i < 2 * WH; ++i) sum += PZ_ROW(i);
#pragma unroll
    for (int j = 0; j < 8; ++j) { const int p = p0 + j; const int cnt = min(p + WH, SEQ) - max(p - WH, 0);
        const f32x4 z = (sum * frcp((float)cnt) - PZ_ROW(j + WH)) * sc1;
        *(u32x2*)(zp + ((size_t)b * SEQ + p) * D + ch) = (u32x2){pk2(z.x, z.y), pk2(z.z, z.w)};
        sum += PZ_ROW(j + 2 * WH) - PZ_ROW(j); }
#undef PZ_ROW
}
__device__ __forceinline__ void phase_pool(const Ctx& F) {
    bf16* zp = (bf16*)(F.ws + WS_XA);
    for (int item = F.bid * 512 + F.tid; item < 4096 * 256; item += F.G * 512) {
        const int strip = item >> 8, ct = item & 255, b = strip >> 8, p0 = (strip & 255) * 8, ch = 4 * ct;
        const int g = __builtin_amdgcn_readfirstlane(ct >> 6);
        if (g == 0) pool_item<1>(F, zp, b, p0, ch); else if (g == 1) pool_item<2>(F, zp, b, p0, ch); else if (g == 2) pool_item<4>(F, zp, b, p0, ch); else pool_item<8>(F, zp, b, p0, ch);
    }
}
struct SchedPool {
    int G, c; const char* Wt;
    __device__ __forceinline__ bool next(int i, g8::Unit& u) const {
        const int L = i * G + c; if (L >= 512) return false;
        int pm, pn; g8::tile_of(L, 128, 4, pm, pn); u.pm = pm; u.pn = pn; u.e = 0; u.aux = 0; u.B = Wt + (size_t)pn * 256 * 256 * 2; return true; }
    __device__ __forceinline__ unsigned rowoff(const g8::Unit& u, int r) const { return (unsigned)(u.pm * 256 + r) * 2048u + (unsigned)u.pn * 512u; }
};

__global__ void __launch_bounds__(512, 2) mk_fwd(Args args) {
    extern __shared__ __attribute__((aligned(16))) unsigned char lds_raw[];
    Ctx F;
    F.lds = (LAS unsigned char*)lds_raw;
    F.tid = threadIdx.x; F.lane = F.tid & 63; F.wave = __builtin_amdgcn_readfirstlane(F.tid >> 6); F.G = gridDim.x; F.bid = blockIdx.x;
    F.a = (KArgs)__builtin_amdgcn_kernarg_segment_ptr();
    F.H = args.out; F.ws = args.ws;
    for (int u = F.tid; u < (LDS_BYTES - LDSCTL_OFF) / 4; u += 512) ((LAS unsigned*)(F.lds + LDSCTL_OFF))[u] = 0u;
    __syncthreads();
    XcdBarrier bar; bar.bar = (unsigned*)(F.ws + WS_CTL) + CW_BAR; bar.x = 0; bar.st = nullptr;
    if (MK_N_LAUNCHES == 1) bar = xcd_barrier_post((unsigned*)(F.ws + WS_CTL) + CW_BAR, (volatile LAS unsigned*)(F.lds + LDSCTL_OFF));
    const int lo = args.ph_lo, hi = args.ph_hi;
#ifndef PHMASK
#define PHMASK 0xFFFF
#endif
#define IN(k) (((PHMASK >> (k)) & 1) && lo <= (k) && (k) < hi)
#define FRESH() do { asm volatile("" : "+s"(F.a)); } while (0)
#define SEAM(k) do { if (IN(k) && IN((k) + 1)) xcd_barrier(bar); } while (0)

    if (IN(0)) { FRESH(); phase0(F); if (RPT & 1) { __syncthreads(); phase0(F); } } SEAM(0);
    if (IN(1)) { FRESH(); phase1(F); if (RPT & 2) { __syncthreads(); phase1(F); } } SEAM(1);
    if (IN(2)) { FRESH();
        SchedIn S{F.G, F.bid, (const char*)(F.ws + WS_WIN)};
        EpiIn E{F.ws, (unsigned char*)F.H, F.lds};
        g8::gemm_phase(F.lds, (const char*)(F.ws + WS_XA), 1024, S, E);
        convert_tail(F, F.bid, (1792 + 128) % 256, 0, 10240);
    } SEAM(2);
    if (IN(3)) { FRESH(); phase3(F); if (RPT & 8) { __syncthreads(); phase3(F); } } SEAM(3);
    if (IN(4)) { FRESH(); phase4(F); if (RPT & 16) { __syncthreads(); phase4(F); } } SEAM(4);
    if (IN(5)) { FRESH();
        SchedOut S{F.G, F.bid, (const char*)(F.ws + WS_WOUT)};
        EpiY E{(bf16*)(F.ws + WS_P), modp(F, 0, 0, 2), nullptr, (ABL & 1) ? 0.f : 1.f};
        g8::gemm_phase(F.lds, (const char*)(F.ws + WS_XA), 1024, S, E); if ((RPT >> 5) & 1) { __syncthreads(); g8::gemm_phase(F.lds, (const char*)(F.ws + WS_XA), 1024, S, E); }
    } SEAM(5);
    if (IN(6)) { FRESH(); phase_ln_router(F, 0, F.a->in[0], (const bf16*)(F.ws + WS_P)); } SEAM(6);
    if (IN(7)) { FRESH();
        moe_table(F, 0); moe_tokl(F);
        SchedMoe S{F.G, F.bid, (const char*)(F.ws + WS_WGU), (size_t)1024 * 1024 * 2, (size_t)256 * 1024 * 2, (const LAS int*)(F.lds + LDS_TAB_OFF), (const LAS int*)(F.lds + LDS_TOKL_OFF), 1, 2048u};
        EpiAct E{(bf16*)(F.ws + WS_ACT)};
        g8::gemm_phase(F.lds, (const char*)(F.ws + WS_XA), 1024, S, E);
        convert_tail(F, moe_vc(F.bid, F.G), (4 * ((const LAS int*)(F.lds + LDS_TAB_OFF))[32]) % 256, 10240, 20480); if ((RPT >> 7) & 1) { __syncthreads(); g8::gemm_phase(F.lds, (const char*)(F.ws + WS_XA), 1024, S, E); }
    } SEAM(7);
    if (IN(8)) { FRESH();
        moe_table(F, 0);
        SchedMoe S{F.G, F.bid, (const char*)(F.ws + WS_WDN), (size_t)1024 * 512 * 2, (size_t)256 * 512 * 2, (const LAS int*)(F.lds + LDS_TAB_OFF), (const LAS int*)(F.lds + LDS_TOKL_OFF), 0, 1024u};
        EpiEo E{(bf16*)(F.ws + WS_EO)};
        g8::gemm_phase(F.lds, (const char*)(F.ws + WS_ACT), 512, S, E);
        convert_tail(F, moe_vc(F.bid, F.G), (4 * ((const LAS int*)(F.lds + LDS_TAB_OFF))[32]) % 256, 20480, I_E1); if ((RPT >> 8) & 1) { __syncthreads(); g8::gemm_phase(F.lds, (const char*)(F.ws + WS_ACT), 512, S, E); }
    } SEAM(8);
    if (IN(9)) { FRESH(); phase_combine(F, 0); } SEAM(9);
    if (IN(10)) { FRESH(); phase_pool(F); if (RPT & 1024) { __syncthreads(); phase_pool(F); } } SEAM(10);
    if (IN(11)) { FRESH();
        SchedPool S{F.G, F.bid, (const char*)(F.ws + WS_WPOOL)};
        EpiY E{(bf16*)(F.ws + WS_ACT), modp(F, 1, 0, 2), F.a->in[13], (ABL & 4) ? 0.f : 1.f};
        g8::gemm_phase(F.lds, (const char*)(F.ws + WS_XA), 256, S, E);
    } SEAM(11);
    if (IN(12)) { FRESH(); phase_ln_router(F, 1, nullptr, (const bf16*)(F.ws + WS_ACT)); } SEAM(12);
    if (IN(13)) { FRESH();
        moe_table(F, 1); moe_tokl(F);
        SchedMoe S{F.G, F.bid, (const char*)(F.ws + WS_WGU) + (size_t)32 * 1024 * 1024 * 2, (size_t)1024 * 1024 * 2, (size_t)256 * 1024 * 2, (const LAS int*)(F.lds + LDS_TAB_OFF), (const LAS int*)(F.lds + LDS_TOKL_OFF), 1, 2048u};
        EpiAct E{(bf16*)(F.ws + WS_ACT)};
        g8::gemm_phase(F.lds, (const char*)(F.ws + WS_XA), 1024, S, E);
    } SEAM(13);
    if (IN(14)) { FRESH();
        moe_table(F, 1);
        SchedMoe S{F.G, F.bid, (const char*)(F.ws + WS_WDN) + (size_t)32 * 1024 * 512 * 2, (size_t)1024 * 512 * 2, (size_t)256 * 512 * 2, (const LAS int*)(F.lds + LDS_TAB_OFF), (const LAS int*)(F.lds + LDS_TOKL_OFF), 0, 1024u};
        EpiEo E{(bf16*)(F.ws + WS_EO)};
        g8::gemm_phase(F.lds, (const char*)(F.ws + WS_ACT), 512, S, E);
    } SEAM(14);
    if (IN(15)) { FRESH(); phase_combine(F, 1); }
#undef IN
#undef SEAM
}

extern "C" void kernel_launch(void* const* d_in, const int* in_sizes, int n_in, void* d_out, int out_size, void* d_ws, size_t ws_size, hipStream_t stream) {
    static int grid = 0;
    if (grid == 0) {
        if (n_in != 21 || in_sizes[0] != T * D || out_size != T * D || ws_size < WS_END) { fprintf(stderr, "kernel_launch: unexpected shapes (n_in %d, ws %zu); nothing launched\n", n_in, ws_size); grid = -1; return; }
        int dev = 0, cus = 0, per_cu = 0;
        if (hipGetDevice(&dev) != hipSuccess || hipDeviceGetAttribute(&cus, hipDeviceAttributeMultiprocessorCount, dev) != hipSuccess) { grid = -1; return; }
        if (hipFuncSetAttribute((const void*)mk_fwd, hipFuncAttributeMaxDynamicSharedMemorySize, LDS_BYTES) != hipSuccess) { fprintf(stderr, "kernel_launch: hipFuncSetAttribute failed\n"); grid = -1; return; }
        if (hipOccupancyMaxActiveBlocksPerMultiprocessor(&per_cu, (const void*)mk_fwd, 512, LDS_BYTES) != hipSuccess || per_cu < 1) { fprintf(stderr, "kernel_launch: occupancy query reports %d\n", per_cu); }
        (void)hipGetLastError();
        grid = cus;
    }
    if (grid < 0) return;
    if (hipMemsetAsync((char*)d_ws + WS_CTL, 0, CTL_ZERO_BYTES, stream) != hipSuccess) return;
    Args a{};
    for (int i = 0; i < 21; ++i) a.in[i] = (const float*)d_in[i];
    a.out = (float*)d_out; a.ws = (unsigned char*)d_ws;
    if (MK_N_LAUNCHES == 1) { a.ph_lo = 0; a.ph_hi = NPHASE; hipLaunchKernelGGL(mk_fwd, dim3(grid), dim3(512), LDS_BYTES, stream, a); }
    else for (int p = 0; p < NPHASE; ++p) { a.ph_lo = p; a.ph_hi = p + 1; hipLaunchKernelGGL(mk_fwd, dim3(grid), dim3(512), LDS_BYTES, stream, a); }
}
```

```cpp
#include <hip/hip_runtime.h>
#include <cstdio>
#include <cstdint>

#ifndef ABL
#define ABL 0
#endif
#ifndef RPT
#define RPT 0
#endif
#ifndef MK_N_LAUNCHES
#define MK_N_LAUNCHES 1
#endif

#define GAS __attribute__((address_space(1)))
#define LAS __attribute__((address_space(3)))
typedef unsigned short bf16;
typedef short bf16x8 __attribute__((ext_vector_type(8)));
typedef float f32x4 __attribute__((ext_vector_type(4)));
typedef float f32x16 __attribute__((ext_vector_type(16)));
typedef unsigned u32x4 __attribute__((ext_vector_type(4)));
typedef unsigned u32x2 __attribute__((ext_vector_type(2)));

constexpr int D = 1024, NB = 16, SEQ = 2048, T = NB * SEQ, CTXL = 256, TC = NB * CTXL;
constexpr int GRIDW = 64, GROWS = SEQ / GRIDW;
constexpr int OFF_RK = 0, OFF_RV = 512, OFF_NK = 1024, OFF_NV = 1536, KV_COLS = 2048, OFF_RQ = 2048, OFF_RG = 2560, OFF_NQ = 3072, IN_COLS = 3584;
constexpr int NEXP = 32, HID = 512, LISTCAP = T;
constexpr int MAXSLOT = 73728;
constexpr float LN_EPS = 1e-5f;
constexpr float ALPHA = 1.41421356237309515f;
constexpr int NPHASE = 16;

constexpr size_t MiB = 1u << 20;
constexpr size_t WS_CTL = 0, CTL_ZERO_BYTES = 128 * 1024;
constexpr size_t WS_MOD = 1 * MiB;
constexpr size_t WS_TOKINFO = 2 * MiB;
constexpr size_t WS_LIST = 3 * MiB;
constexpr size_t WS_WIN = 8 * MiB, WS_WOUT = 15 * MiB, WS_WPOOL = 17 * MiB, WS_WGU = 18 * MiB, WS_WDN = 146 * MiB;
constexpr size_t WS_XA = 210 * MiB;
constexpr size_t WS_P = 282 * MiB;
constexpr size_t WS_ACT = 282 * MiB, WS_EO = 354 * MiB;
constexpr int TPITCH = SEQ + 64;
constexpr size_t WS_VTR = 446 * MiB, WS_VTRC = 480 * MiB;
constexpr size_t WS_VTN = 484 * MiB, WS_VTNC = 518 * MiB;
constexpr size_t WS_PC = 522 * MiB;
constexpr size_t WS_H16 = 526 * MiB;
constexpr size_t WS_END = 590 * MiB;
constexpr size_t DO_ST = 0;
constexpr size_t DO_KTR = 64 * MiB, DO_KTRC = 98 * MiB;
constexpr int PW = 2624, PO_RK = 0, PO_NK = 512, PO_RQ = 1024, PO_RG = 1536, PO_NQ = 2048, PCW = 512;
static_assert(WS_EO + (size_t)MAXSLOT * 1024 * 2 <= 498 * MiB && WS_ACT + (size_t)MAXSLOT * 512 * 2 <= WS_EO, "ws map");
static_assert(WS_P + (size_t)T * PW * 2 <= WS_VTR && WS_VTR + (size_t)64 * 128 * TPITCH * 2 <= WS_VTRC && WS_VTN + (size_t)128 * 64 * TPITCH * 2 <= WS_VTNC && DO_KTR + (size_t)64 * 128 * TPITCH * 2 <= DO_KTRC && WS_XA + (size_t)(T + TC) * D * 2 <= WS_P, "ws map");
constexpr int CW_BAR = 4096, XCD_BAR_WORDS_C = 3456;
constexpr int CW_CNT = 16384;
static_assert((CW_CNT + 64 * 64) * 4 <= (int)CTL_ZERO_BYTES && (CW_BAR + XCD_BAR_WORDS_C) * 4 <= (int)CTL_ZERO_BYTES, "ctl words inside the memset");

constexpr int RING_BYTES = 131072, LDS_SCR_OFF = RING_BYTES, LDSCTL_OFF = 154112, LDS_TAB_OFF = LDSCTL_OFF + 256, LDS_BYTES = 163840;

__device__ __forceinline__ unsigned f2bf(float f) { unsigned u = __builtin_bit_cast(unsigned, f); return (u + 0x7fffu + ((u >> 16) & 1u)) >> 16; }
__device__ __forceinline__ unsigned pk2(float lo, float hi) { unsigned r; asm("v_cvt_pk_bf16_f32 %0, %1, %2" : "=v"(r) : "v"(lo), "v"(hi)); return r; }
__device__ __forceinline__ bf16x8 pack8(const f32x4& a, const f32x4& b) { const u32x4 w = (u32x4){pk2(a.x, a.y), pk2(a.z, a.w), pk2(b.x, b.y), pk2(b.z, b.w)}; return __builtin_bit_cast(bf16x8, w); }
__device__ __forceinline__ float bf2f(unsigned h) { return __builtin_bit_cast(float, h << 16); }
__device__ __forceinline__ float bflo(unsigned w) { return __builtin_bit_cast(float, w << 16); }
__device__ __forceinline__ float bfhi(unsigned w) { return __builtin_bit_cast(float, w & 0xffff0000u); }
__device__ __forceinline__ float wave_sum(float v) {
    int x = __builtin_bit_cast(int, v);
#define WS_STEP(ctrl, rmask) do { const int t_ = __builtin_amdgcn_update_dpp(0, x, (ctrl), (rmask), 0xF, false); x = __builtin_bit_cast(int, __builtin_bit_cast(float, x) + __builtin_bit_cast(float, t_)); } while (0)
    WS_STEP(0xB1, 0xF);
    WS_STEP(0x4E, 0xF);
    WS_STEP(0x141, 0xF);
    WS_STEP(0x140, 0xF);
    WS_STEP(0x142, 0xA);
    WS_STEP(0x143, 0xC);
#undef WS_STEP
    return __builtin_bit_cast(float, __builtin_amdgcn_readlane(x, 63));
}
__device__ __forceinline__ float frcp(float x) { return __builtin_amdgcn_rcpf(x); }
__device__ __forceinline__ float silu_f(float v) { return v * frcp(1.0f + __expf(-v)); }
__device__ __forceinline__ float fexp2(float x) { return __builtin_amdgcn_exp2f(x); }
#define LDS_WAIT() asm volatile("s_waitcnt lgkmcnt(0)" ::: "memory")

#define XB_TMO      128
#define XB_XCNT(j)  (256  + 64 * (j))
#define XB_XSUB(j)  (1280 + 64 * (j))
#define XB_XGEN(j)  (2304 + 64 * (j))
#define XB_TOP      3328
#define XB_TOPGEN   3392
#define XCD_BAR_WORDS 3456
#define XB_SPIN_CAP (1u << 18)
__device__ __forceinline__ unsigned xb_ld(unsigned* p)              { return __hip_atomic_load(p, __ATOMIC_RELAXED, __HIP_MEMORY_SCOPE_AGENT); }
__device__ __forceinline__ unsigned xb_add(unsigned* p, unsigned v) { return __hip_atomic_fetch_add(p, v, __ATOMIC_RELAXED, __HIP_MEMORY_SCOPE_AGENT); }
__device__ __forceinline__ unsigned xb_xcc_id() { return (unsigned)__builtin_amdgcn_s_getreg((3 << 11) | 20) & 0xFu; }
#define XB_SPIN(cond, bar) do { unsigned _sp = 0; while (cond) { __builtin_amdgcn_s_sleep(1); \
    if ((++_sp & 255u) == 0u) { if (xb_ld(&(bar)[XB_TMO])) break; if (_sp > XB_SPIN_CAP) { atomicAdd(&(bar)[XB_TMO], 1u); break; } } } } while (0)
struct XcdBarrier { unsigned* bar; unsigned x; volatile LAS unsigned* st; };
__device__ __forceinline__ XcdBarrier xcd_barrier_post(unsigned* bar, volatile LAS unsigned* st) {
    XcdBarrier b; b.bar = bar; b.x = xb_xcc_id(); b.st = st;
    if (threadIdx.x == 0) (void)xb_add(&bar[XB_XCNT(b.x)], 1u);
    return b;
}
__device__ __forceinline__ void xcd_barrier_complete(unsigned* bar, unsigned x, unsigned& nloc, unsigned& nx) {
    const unsigned G = gridDim.x * gridDim.y * gridDim.z;
    unsigned sum, cnt, mine, sp = 0u;
    for (;;) {
        sum = 0u; cnt = 0u; mine = 0u;
#pragma unroll
        for (unsigned j = 0; j < 16; ++j) { const unsigned c = xb_ld(&bar[XB_XCNT(j)]); sum += c; cnt += (c > 0u) ? 1u : 0u; mine = (j == x) ? c : mine; }
        if (sum == G) break;
        __builtin_amdgcn_s_sleep(1);
        if ((++sp & 255u) == 0u) { if (xb_ld(&bar[XB_TMO])) break; if (sp > XB_SPIN_CAP) { atomicAdd(&bar[XB_TMO], 1u); break; } }
    }
    nloc = mine > 0u ? mine : 1u; nx = cnt > 0u ? cnt : 1u;
}
__device__ __forceinline__ void xcd_barrier(const XcdBarrier& b) {
    asm volatile("s_waitcnt vmcnt(0)" ::: "memory");
    __syncthreads();
    if (threadIdx.x == 0) {
        unsigned* bar = b.bar;
        __builtin_amdgcn_s_waitcnt(0);
        unsigned nloc = b.st[0], nx = b.st[1];
        if (nloc == 0u) { xcd_barrier_complete(bar, b.x, nloc, nx); b.st[0] = nloc; b.st[1] = nx; }
        const unsigned old = xb_add(&bar[XB_XSUB(b.x)], 1u);
        const unsigned gen = old / nloc;
        if (old + 1u == (gen + 1u) * nloc) {
            __builtin_amdgcn_fence(__ATOMIC_RELEASE, "agent");
            asm volatile("s_waitcnt vmcnt(0)" ::: "memory");
            const unsigned og = xb_add(&bar[XB_TOP], 1u);
            const unsigned tg = og / nx;
            if (og + 1u == (tg + 1u) * nx) xb_add(&bar[XB_TOPGEN], 1u);
            else XB_SPIN(xb_ld(&bar[XB_TOPGEN]) == tg, bar);
            __builtin_amdgcn_fence(__ATOMIC_ACQUIRE, "agent");
            xb_add(&bar[XB_XGEN(b.x)], 1u);
            asm volatile("s_waitcnt vmcnt(0)" ::: "memory");
        } else {
            XB_SPIN(xb_ld(&bar[XB_XGEN(b.x)]) == gen, bar);
            __builtin_amdgcn_fence(__ATOMIC_ACQUIRE, "agent");
            asm volatile("s_waitcnt vmcnt(0)" ::: "memory");
        }
    }
    __syncthreads();
}

struct Args { const float* in[21]; float* out; unsigned char* ws; int ph_lo, ph_hi; };
typedef const __attribute__((address_space(4))) Args* KArgs;
struct Ctx {
    LAS unsigned char* lds;
    int tid, lane, wave, G, bid;
    KArgs a;
    float* H;
    unsigned char* ws;
};
__device__ __forceinline__ const float* modp(const Ctx& F, int l, int row, int part) { return (const float*)(F.ws + WS_MOD) + (size_t)(l * 17 + row) * 6144 + part * 1024; }

namespace g8 {
constexpr int BM = 256, BK = 64, HALF = 128, HTB = HALF * BK * 2, STAGE_BYTES = 8 * HTB;
__device__ __forceinline__ int lds_byte(int r, int c) { const int st = (r >> 4) * 2 + (c >> 5), rr = r & 15, cc = c & 31, ob = rr * 64 + cc * 2; return st * 1024 + (ob ^ (((ob >> 9) & 1) << 5)); }
__device__ __forceinline__ void stage_rc(int b, int& R, int& C) { const int st = b / 1024, sb = b % 1024, swz = sb ^ (((sb >> 9) & 1) << 5); R = (st >> 1) * 16 + swz / 64; C = (st & 1) * 32 + (swz % 64) / 2; }
struct Unit { const char* B; int pm, pn, e, aux; };
__device__ __forceinline__ void tile_of(int L, int nM, int nN, int& pm, int& pn) {
    const int nwg = nM * nN; int wgid = L; { const int q = nwg / 8, r = nwg % 8, xcd = wgid % 8, off = wgid / 8; wgid = (xcd < r ? xcd * (q + 1) : r * (q + 1) + (xcd - r) * q) + off; }
    const int nig = 8 * nN, gid = wgid / nig, fm = gid * 8, gsz = (nM - fm) < 8 ? (nM - fm) : 8;
    pm = fm + ((wgid % nig) % gsz); pn = (wgid % nig) / gsz;
}
template <class Epi, class Sched>
__device__ __forceinline__ void gemm_phase(LAS unsigned char* lds, const char* Abase, const int K, const Sched& S, const Epi& E) {
    const int tid = threadIdx.x, wid = __builtin_amdgcn_readfirstlane(tid >> 6), lane = tid & 63, wr = wid >> 2, wc = wid & 3, fr = lane & 15, fq = lane >> 4;
    const int nt = K / BK;
    int R0, C0, R1, C1; stage_rc(tid * 16, R0, C0); stage_rc(tid * 16 + 8192, R1, C1);
    unsigned voffB[2]; voffB[0] = (unsigned)(R0 * K + C0) * 2u; voffB[1] = (unsigned)(R1 * K + C1) * 2u;
    const unsigned kstep = (unsigned)(BK * 2);
    const size_t hstepB = (size_t)HALF * K * 2;
    const unsigned ldsw = (unsigned)wid * 1024u;
    const int aoff = lds_byte(wr * 64 + fr, fq * 8), boff = lds_byte(wc * 32 + fr, fq * 8);
#define G8_SA(b, h) (((b) * 2 + (h)) * HTB)
#define G8_SB(b, h) ((4 + (b) * 2 + (h)) * HTB)
#define G8_STAGEB(bufoff, gbase) do { _Pragma("unroll") for (int _i = 0; _i < 2; ++_i) \
        __builtin_amdgcn_global_load_lds((const unsigned*)((const char*)(gbase) + voffB[_i]), (LAS unsigned*)(lds + (bufoff) + ldsw + _i * 8192), 16, 0, 0); } while (0)
#define G8_STAGEA(bufoff, offs, h, koff) do { _Pragma("unroll") for (int _i = 0; _i < 2; ++_i) \
        __builtin_amdgcn_global_load_lds((const unsigned*)((Abase + (koff)) + (offs)[h][_i]), (LAS unsigned*)(lds + (bufoff) + ldsw + _i * 8192), 16, 0, 0); } while (0)
#define G8_LDA(dst, b, h) do { _Pragma("unroll") for (int m = 0; m < 4; ++m) _Pragma("unroll") for (int k = 0; k < 2; ++k) dst[m][k] = *(const LAS bf16x8*)(lds + G8_SA(b, h) + aoff + m * 2048 + k * 1024); } while (0)
#define G8_LDB(dst, b, h) do { _Pragma("unroll") for (int n = 0; n < 2; ++n) _Pragma("unroll") for (int k = 0; k < 2; ++k) dst[n][k] = *(const LAS bf16x8*)(lds + G8_SB(b, h) + boff + n * 2048 + k * 1024); } while (0)
#define G8_MMA(ai, bj, At, Bt) do { __builtin_amdgcn_s_setprio(1); _Pragma("unroll") for (int m = 0; m < 4; ++m) _Pragma("unroll") for (int n = 0; n < 2; ++n) _Pragma("unroll") for (int k = 0; k < 2; ++k) \
        acc[ai][bj][m][n] = __builtin_amdgcn_mfma_f32_16x16x32_bf16(Bt[n][k], At[m][k], acc[ai][bj][m][n], 0, 0, 0); __builtin_amdgcn_s_setprio(0); } while (0)
#define G8_WAIT_V(n) asm volatile("s_waitcnt vmcnt(" #n ")" ::: "memory")
#define G8_WAIT_L(n) asm volatile("s_waitcnt lgkmcnt(" #n ")" ::: "memory")
#define G8_BAR __builtin_amdgcn_s_barrier()
#define G8_SCHED __builtin_amdgcn_sched_barrier(0)
    Unit cur, nxt; int ui = 0;
    if (!S.next(0, cur)) return;
    f32x4 acc[2][2][4][2];
#pragma unroll
    for (int a = 0; a < 2; ++a)
#pragma unroll
        for (int b = 0; b < 2; ++b)
#pragma unroll
            for (int m = 0; m < 4; ++m)
#pragma unroll
                for (int n = 0; n < 2; ++n) acc[a][b][m][n] = (f32x4){0.f, 0.f, 0.f, 0.f};
    bf16x8 At[4][2], B0[2][2], B1[2][2];
    unsigned ac[2][2];
    ac[0][0] = S.rowoff(cur, R0) + (unsigned)C0 * 2u; ac[0][1] = S.rowoff(cur, R1) + (unsigned)C1 * 2u;
    ac[1][0] = S.rowoff(cur, HALF + R0) + (unsigned)C0 * 2u; ac[1][1] = S.rowoff(cur, HALF + R1) + (unsigned)C1 * 2u;
    const char* cB = cur.B;
    G8_STAGEB(G8_SB(0, 0), cB); G8_STAGEB(G8_SB(0, 1), cB + hstepB); G8_STAGEA(G8_SA(0, 0), ac, 0, 0); G8_STAGEA(G8_SA(0, 1), ac, 1, 0);
    if (wr == 1) G8_BAR;
    G8_WAIT_V(2); G8_BAR;
    G8_STAGEB(G8_SB(1, 0), cB + kstep); G8_STAGEA(G8_SA(1, 0), ac, 0, kstep); G8_STAGEB(G8_SB(1, 1), cB + hstepB + kstep);
    G8_WAIT_V(6); G8_BAR;
    for (;;) {
        const bool has_next = S.next(ui + 1, nxt);
        const char* nB = has_next ? nxt.B : cB;
#pragma unroll 1
        for (int t = 0; t < nt; t += 2) {
            const bool last = (t == nt - 2);
            const unsigned k1 = (unsigned)(t + 1) * kstep;
            const unsigned k2 = last ? 0u : (unsigned)(t + 2) * kstep;
            const unsigned k3 = k2 + kstep;
            const char* b2 = last ? nB : cB + k2; const char* b3 = b2 + kstep;
            G8_LDB(B0, 0, 0); G8_LDB(B1, 0, 1); G8_SCHED; G8_LDA(At, 0, 0); G8_STAGEA(G8_SA(1, 1), ac, 1, k1);
            if (last && has_next) {
                ac[0][0] = S.rowoff(nxt, R0) + (unsigned)C0 * 2u; ac[0][1] = S.rowoff(nxt, R1) + (unsigned)C1 * 2u;
                ac[1][0] = S.rowoff(nxt, HALF + R0) + (unsigned)C0 * 2u; ac[1][1] = S.rowoff(nxt, HALF + R1) + (unsigned)C1 * 2u;
            }
            G8_WAIT_V(8); G8_WAIT_L(0); G8_BAR; G8_MMA(0, 0, At, B0); G8_MMA(0, 1, At, B1); G8_BAR; G8_SCHED;
            G8_LDA(At, 0, 1); G8_STAGEB(G8_SB(0, 0), b2); G8_STAGEB(G8_SB(0, 1), b2 + hstepB); G8_STAGEA(G8_SA(0, 0), ac, 0, k2);
            G8_WAIT_V(8); G8_WAIT_L(0); G8_BAR; G8_MMA(1, 0, At, B0); G8_MMA(1, 1, At, B1); G8_BAR; G8_SCHED;
            G8_LDB(B0, 1, 0); G8_LDB(B1, 1, 1); G8_SCHED; G8_LDA(At, 1, 0); G8_STAGEA(G8_SA(0, 1), ac, 1, k2);
            G8_WAIT_V(8); G8_WAIT_L(0); G8_BAR; G8_MMA(0, 0, At, B0); G8_MMA(0, 1, At, B1); G8_BAR; G8_SCHED;
            G8_LDA(At, 1, 1); G8_STAGEB(G8_SB(1, 0), b3); G8_STAGEB(G8_SB(1, 1), b3 + hstepB); G8_STAGEA(G8_SA(1, 0), ac, 0, k3);
            G8_WAIT_V(8); G8_WAIT_L(0); G8_BAR; G8_MMA(1, 0, At, B0); G8_MMA(1, 1, At, B1); G8_BAR; G8_SCHED;
        }
        if (wr == 0) G8_BAR;
        E(acc, cur, wr, wc, fr, fq);
        if (!has_next) break;
#pragma unroll
        for (int a = 0; a < 2; ++a)
#pragma unroll
            for (int b = 0; b < 2; ++b)
#pragma unroll
                for (int m = 0; m < 4; ++m)
#pragma unroll
                    for (int n = 0; n < 2; ++n) acc[a][b][m][n] = (f32x4){0.f, 0.f, 0.f, 0.f};
        cur = nxt; cB = nB; ++ui;
        if (wr == 1) G8_BAR;
    }
    G8_WAIT_V(0);
    G8_BAR;
#undef G8_SA
#undef G8_SB
#undef G8_STAGEA
#undef G8_STAGEB
#undef G8_LDA
#undef G8_LDB
#undef G8_MMA
#undef G8_WAIT_V
#undef G8_WAIT_L
#undef G8_BAR
#undef G8_SCHED
}
}

struct CvDesc { const float* W; bf16* WT; int ldw, ldo, k0, n0, kind, aux; };
struct RmId   { __device__ __forceinline__ int operator()(int n) const { return n; } };
struct RmGate { int up; __device__ __forceinline__ int operator()(int h) const { return 256 * (h >> 7) + 128 * ((h >> 2) & 1) + 32 * ((h >> 5) & 3) + 16 * up + 4 * ((h >> 3) & 3) + (h & 3); } };
struct RmPerm { __device__ __forceinline__ int operator()(int c) const { const int q = c & 31; return (c & ~31) + 16 * ((q >> 2) & 1) + 4 * (q >> 3) + (q & 3); } };
struct RmIn   { __device__ __forceinline__ int operator()(int n) const {
    const bool rope = (n < 512) || (n >= OFF_RQ && n < OFF_RQ + 512);
    const bool tokmaj = (n >= OFF_NK && n < OFF_NV) || (n >= OFF_RG);
    const int d = n & 127; return rope ? ((n & ~127) + 32 * ((d >> 4) & 3) + 16 * (d >> 6) + (d & 15)) : (tokmaj ? RmPerm{}(n) : n); } };

__device__ __forceinline__ int cv_rowmap(const CvDesc& d, int n) { return d.kind == 1 ? RmGate{d.aux}(n) : (d.kind == 2 ? RmPerm{}(n) : (d.kind == 3 ? RmIn{}(n) : n)); }
__device__ __forceinline__ void cv_load(const CvDesc& d, int lane, float (&buf)[32]) {
    const float* p = d.W + (size_t)(d.k0 + (lane >> 5)) * d.ldw + d.n0 + (lane & 31);
#pragma unroll
    for (int i = 0; i < 32; ++i) buf[i] = __builtin_nontemporal_load(p + (size_t)(2 * i) * d.ldw);
}
__device__ __forceinline__ void cv_store(const CvDesc& d, int lane, const float (&buf)[32], LAS float* scr) {
#pragma unroll
    for (int i = 0; i < 32; ++i) scr[(2 * i + (lane >> 5)) * 33 + (lane & 31)] = buf[i];
    LDS_WAIT(); asm volatile("" ::: "memory");
    const int c = lane & 7;
#pragma unroll
    for (int j = 0; j < 4; ++j) { const int n = (lane >> 3) + 8 * j; const LAS float* sp = scr + (8 * c) * 33 + n;
        u32x4 o; o.x = pk2(sp[0 * 33], sp[1 * 33]); o.y = pk2(sp[2 * 33], sp[3 * 33]); o.z = pk2(sp[4 * 33], sp[5 * 33]); o.w = pk2(sp[6 * 33], sp[7 * 33]);
        *(u32x4*)(d.WT + (size_t)cv_rowmap(d, d.n0 + n) * d.ldo + d.k0 + 8 * c) = o; }
    LDS_WAIT(); asm volatile("" ::: "memory");
}
constexpr int I_E1 = 3 * 32 * 256;
__device__ __forceinline__ CvDesc cv_expert(const Ctx& F, int l, int q) {
    const int mat = q >> 13, r = q & 8191, le = l * 32 + (r >> 8), w = r & 255; CvDesc d;
    if (mat < 2) { d.W = (mat ? F.a->in[19] : F.a->in[18]) + (size_t)le * 1024 * 512; d.ldw = 512; d.WT = (bf16*)(F.ws + WS_WGU) + (size_t)le * 1024 * 1024; d.ldo = 1024; d.kind = 1; d.aux = mat; d.k0 = 64 * (w >> 4); d.n0 = 32 * (w & 15); }
    else { d.W = F.a->in[20] + (size_t)le * 512 * 1024; d.ldw = 1024; d.WT = (bf16*)(F.ws + WS_WDN) + (size_t)le * 1024 * 512; d.ldo = 512; d.kind = 2; d.aux = 0; d.k0 = 64 * (w >> 5); d.n0 = 32 * (w & 31); }
    return d;
}
constexpr int I_IN = 16 * 112, I_OUT = 16 * 32, I_POOL = 4 * 32;
__device__ __forceinline__ CvDesc cv_phase0(const Ctx& F, int r, int nexp) {
    if (r < nexp) return cv_expert(F, r < I_E1 ? 0 : 1, r < I_E1 ? r : r - I_E1);
    r -= nexp; CvDesc d; d.aux = 0;
    if (r < I_IN) { d.W = F.a->in[8]; d.ldw = IN_COLS; d.WT = (bf16*)(F.ws + WS_WIN); d.ldo = 1024; d.kind = 3; d.k0 = 64 * (r / 112); d.n0 = 32 * (r % 112); return d; }
    r -= I_IN;
    if (r < I_OUT) { d.W = F.a->in[9]; d.ldw = 1024; d.WT = (bf16*)(F.ws + WS_WOUT); d.ldo = 1024; d.kind = 2; d.k0 = 64 * (r >> 5); d.n0 = 32 * (r & 31); return d; }
    r -= I_OUT;
    { const int g = r >> 5, q = r & 31; d.W = F.a->in[12] + (size_t)g * 65536; d.ldw = 256; d.WT = (bf16*)(F.ws + WS_WPOOL) + (size_t)g * 65536; d.ldo = 256; d.kind = 2; d.k0 = 64 * (q >> 3); d.n0 = 32 * (q & 7); return d; }
}
#define CV_RUN(first, end, stride, GEN) do { float bA_[32], bB_[32]; const int end_ = (end), st_ = (stride); \
    for (int it_ = (first); it_ < end_; it_ += 2 * st_) { const bool h1_ = it_ + st_ < end_; \
        const CvDesc dA_ = GEN(it_); const CvDesc dB_ = GEN(h1_ ? it_ + st_ : it_); \
        cv_load(dA_, F.lane, bA_); cv_load(dB_, F.lane, bB_);     \
        cv_store(dA_, F.lane, bA_, scr); if (h1_) cv_store(dB_, F.lane, bB_, scr); } } while (0)
__device__ __forceinline__ void phase0(const Ctx& F) {
    LAS float* sil = (LAS float*)F.lds;
    LAS float* red = (LAS float*)(F.lds + 17 * 1024 * 4);
    float* mod = (float*)(F.ws + WS_MOD);
    for (int it = F.bid; it < 192; it += F.G) {
        const int l = it / 96, col0 = (it % 96) * 64;
        for (int idx = F.tid; idx < 17 * 1024; idx += 512) { const int r = idx >> 10, k = idx & 1023; const float v = r < 16 ? F.a->in[1][r * 1024 + k] : F.a->in[3][k]; sil[idx] = silu_f(v); }
        __syncthreads();
        float a[17];
#pragma unroll
        for (int r = 0; r < 17; ++r) a[r] = 0.f;
        const int k0 = F.wave * 128;
        const float* wp = F.a->in[4] + ((size_t)l * 1024 + k0) * 6144 + col0 + F.lane;
#pragma unroll 4
        for (int kk = 0; kk < 128; ++kk) { const float w = wp[(size_t)kk * 6144];
#pragma unroll
            for (int r = 0; r < 17; ++r) a[r] += sil[r * 1024 + k0 + kk] * w; }
#pragma unroll
        for (int r = 0; r < 17; ++r) red[(F.wave * 17 + r) * 64 + F.lane] = a[r];
        __syncthreads();
        for (int idx = F.tid; idx < 17 * 64; idx += 512) { const int r = idx >> 6, cc = idx & 63; float s = F.a->in[5][l * 6144 + col0 + cc];
#pragma unroll
            for (int w8 = 0; w8 < 8; ++w8) s += red[(w8 * 17 + r) * 64 + cc];
            mod[(size_t)(l * 17 + r) * 6144 + col0 + cc] = s; }
        __syncthreads();
    }
    __syncthreads();
    LAS float* scr = (LAS float*)(F.lds + F.wave * 16384);
    const int gw = F.bid * 8 + F.wave, NGW = F.G * 8;
    const int nexp_items = (F.G == 256) ? I_E1 : 2 * I_E1;
    const int NITEMS = nexp_items + I_IN + I_OUT + I_POOL;
#define CV_GEN0(i_) cv_phase0(F, (i_), nexp_items)
    CV_RUN(gw, NITEMS, NGW, CV_GEN0);
#undef CV_GEN0
}
__device__ __forceinline__ void convert_tail(const Ctx& F, int vc, int first, int lo, int hi) {
    if (F.G != 256) return;
    if (first >= F.G) first = 0;
    if (vc < first) return;
    LAS float* scr = (LAS float*)(F.lds + F.wave * 16384);
    const int nw = (F.G - first) * 8;
#define CV_GEN1(i_) cv_expert(F, 1, (i_))
    CV_RUN(lo + (vc - first) * 8 + F.wave, hi, nw, CV_GEN1);
#undef CV_GEN1
}

__device__ __forceinline__ void p1_load(const Ctx& F, int row, f32x4 (&b)[4]) {
    const float* src = row < T ? F.a->in[0] + (size_t)row * D : F.a->in[2] + (size_t)(row - T) * D;
#pragma unroll
    for (int j = 0; j < 4; ++j) b[j] = *(const f32x4*)(src + 4 * F.lane + 256 * j);
}
__device__ __forceinline__ void p1_row(const Ctx& F, int row, const f32x4 (&v)[4], const f32x4 (&sh)[4], const f32x4 (&sc)[4]) {
    unsigned long long* o8 = (unsigned long long*)((bf16*)(F.ws + WS_XA) + (size_t)row * D) + F.lane;
#pragma unroll
    for (int j = 0; j < 4; ++j) { const f32x4 y = v[j] * sc[j] + sh[j];
        o8[64 * j] = (unsigned long long)pk2(y.x, y.y) | ((unsigned long long)pk2(y.z, y.w) << 32); }
}
__device__ __forceinline__ void phase1(const Ctx& F) {
    const int gw = F.bid * 8 + F.wave, NGW = F.G * 8;
    for (int run = gw; run < T / 16; run += NGW) {
        const int tb = run * 16, cb0 = T + run * 2, b = tb >> 11;
        f32x4 A[4], B[4], C[4], E[4], sh[4], sc[4], sh2[4], sc2[4];
#pragma unroll
        for (int j = 0; j < 4; ++j) { sh[j] = *(const f32x4*)(modp(F, 0, b, 0) + 4 * F.lane + 256 * j); sc[j] = *(const f32x4*)(modp(F, 0, b, 1) + 4 * F.lane + 256 * j) + 1.0f;
            sh2[j] = *(const f32x4*)(modp(F, 0, 16, 0) + 4 * F.lane + 256 * j); sc2[j] = *(const f32x4*)(modp(F, 0, 16, 1) + 4 * F.lane + 256 * j) + 1.0f; }
#define P1_ROWOF(i_) ((i_) < 16 ? tb + (i_) : cb0 + min((i_) - 16, 1))
        p1_load(F, tb, A); p1_load(F, tb + 1, B); p1_load(F, tb + 2, C);
#pragma unroll
        for (int k = 0; k < 16; k += 4) {
            p1_load(F, tb + k + 3, E);
            asm volatile("" ::: "memory"); __builtin_amdgcn_sched_barrier(0);
            p1_row(F, tb + k, A, sh, sc);
            p1_load(F, P1_ROWOF(k + 4), A);
            asm volatile("" ::: "memory"); __builtin_amdgcn_sched_barrier(0);
            p1_row(F, tb + k + 1, B, sh, sc);
            p1_load(F, P1_ROWOF(k + 5), B);
            asm volatile("" ::: "memory"); __builtin_amdgcn_sched_barrier(0);
            p1_row(F, tb + k + 2, C, sh, sc);
            p1_load(F, P1_ROWOF(k + 6), C);
            asm volatile("" ::: "memory"); __builtin_amdgcn_sched_barrier(0);
            p1_row(F, tb + k + 3, E, sh, sc);
        }
#undef P1_ROWOF
        p1_row(F, cb0, A, sh2, sc2);
        p1_row(F, cb0 + 1, B, sh2, sc2);
    }
}

struct SchedIn {
    int G, c; const char* Wt;
    __device__ __forceinline__ bool next(int i, g8::Unit& u) const {
        const int L = i * G + c; if (L >= 1792 + 128) return false;
        int pm, pn; if (L < 1792) g8::tile_of(L, 128, 14, pm, pn); else { g8::tile_of(L - 1792, 16, 8, pm, pn); pm += 128; }
        u.pm = pm; u.pn = pn; u.e = 0; u.aux = 0; u.B = Wt + (size_t)pn * 256 * 1024 * 2; return true; }
    __device__ __forceinline__ unsigned rowoff(const g8::Unit& u, int r) const { return (unsigned)(u.pm * 256 + r) * 2048u; }
};
struct EpiIn {
    unsigned char* ws; unsigned char* dout; LAS unsigned char* lds;
    __device__ __forceinline__ void tstore(const f32x4 (&v)[4], LAS bf16* scr, bf16* dst0, size_t colpitch, int lane, int fr, int fq) const {
#pragma unroll
        for (int m = 0; m < 4; ++m)
#pragma unroll
            for (int j = 0; j < 4; j += 2) { const unsigned w = pk2(v[m][j], v[m][j + 1]); scr[(4 * fq + j) * 72 + 16 * m + fr] = (bf16)(w & 0xffffu); scr[(4 * fq + j + 1) * 72 + 16 * m + fr] = (bf16)(w >> 16); }
        LDS_WAIT(); asm volatile("" ::: "memory");
#pragma unroll
        for (int i = 0; i < 2; ++i) { const int q = lane + 64 * i, cc = q >> 3, ch = q & 7;
            const u32x4 w = *(const LAS u32x4*)(scr + cc * 72 + ch * 8);
            *(u32x4*)(dst0 + (size_t)cc * colpitch + ch * 8) = w; }
        LDS_WAIT(); asm volatile("" ::: "memory");
    }
    __device__ __forceinline__ void operator()(const f32x4 (&acc)[2][2][4][2], const g8::Unit& u, int wr, int wc, int fr, int fq) const {
        const bool isctx = u.pm >= 128;
        const int lane = fr + 16 * fq, wid = wr * 4 + wc;
        LAS bf16* scr = (LAS bf16*)(lds + LDS_SCR_OFF + wid * 2304);
        const int row0 = u.pm * 256 + wr * 64 + fr;
        const int bb = isctx ? (u.pm - 128) : (u.pm >> 3);
        const int tt0 = isctx ? 0 : ((u.pm & 7) * 256);
        const size_t tp = isctx ? CTXL : TPITCH;
        const int pn = u.pn;
        if (pn < 2 || pn == 8 || pn == 9) {
            const float scale = (pn >= 8) ? 0.08838834764831845f : 1.0f;
            const int dd = 16 * wc + 4 * fq;
            f32x4 invf;
#pragma unroll
            for (int j = 0; j < 4; ++j) invf[j] = fexp2(-(float)((dd & 31) + j) * (13.287712379549449f / 32.0f));
#pragma unroll
            for (int ai = 0; ai < 2; ++ai)
#pragma unroll
                for (int bj = 0; bj < 2; ++bj) {
                    f32x4 o1[4], o2[4];
#pragma unroll
                    for (int m = 0; m < 4; ++m) { const int row = row0 + ai * 128 + m * 16;
                        f32x4 cs = (f32x4){1.f, 1.f, 1.f, 1.f}, sn = (f32x4){0.f, 0.f, 0.f, 0.f};
                        if (!isctx) { const float pos = (float)((wc < 2) ? (4 * (u.pm & 7) + wr + 2 * ai) : (fr + 16 * m));
#pragma unroll
                            for (int j = 0; j < 4; ++j) { const float ang = pos * invf[j]; cs[j] = __cosf(ang); sn[j] = __sinf(ang); } }
                        const f32x4 x1 = acc[ai][bj][m][0], x2 = acc[ai][bj][m][1];
                        o1[m] = (x1 * cs - x2 * sn) * scale; o2[m] = (x1 * sn + x2 * cs) * scale;
                        if (!isctx) { bf16* rp = (bf16*)(ws + WS_P) + (size_t)row * PW + (pn < 2 ? PO_RK + pn * 256 : PO_RQ + (pn - 8) * 256) + bj * 128 + dd;
                            *(u32x2*)(rp) = (u32x2){pk2(o1[m].x, o1[m].y), pk2(o1[m].z, o1[m].w)};
                            *(u32x2*)(rp + 64) = (u32x2){pk2(o2[m].x, o2[m].y), pk2(o2[m].z, o2[m].w)}; } }
                    if (pn < 2) {
                        const int head = pn * 2 + bj;
                        bf16* d0 = (bf16*)(dout + (isctx ? DO_KTRC : DO_KTR)) + ((size_t)(bb * 4 + head) * 128 + 16 * wc) * tp + tt0 + ai * 128 + wr * 64;
                        tstore(o1, scr, d0, tp, lane, fr, fq);
                        tstore(o2, scr, d0 + (size_t)64 * tp, tp, lane, fr, fq);
                    }
                }
        } else if (pn == 2 || pn == 3 || pn == 6 || pn == 7) {
#pragma unroll
            for (int ai = 0; ai < 2; ++ai)
#pragma unroll
                for (int bj = 0; bj < 2; ++bj)
#pragma unroll
                    for (int n = 0; n < 2; ++n) {
                        const int col = (pn & 1) * 256 + bj * 128 + wc * 32 + n * 16;
                        const size_t boff = (pn < 4) ? (isctx ? WS_VTRC : WS_VTR) : (isctx ? WS_VTNC : WS_VTN);
                        const size_t roff = (pn < 4) ? ((size_t)(bb * 4 + (col >> 7)) * 128 + (col & 127)) : ((size_t)(bb * 8 + (col >> 6)) * 64 + (col & 63));
                        bf16* d0 = (bf16*)(ws + boff) + roff * tp;
                        f32x4 v[4];
#pragma unroll
                        for (int m = 0; m < 4; ++m) v[m] = acc[ai][bj][m][n];
                        tstore(v, scr, d0 + tt0 + ai * 128 + wr * 64, tp, lane, fr, fq);
                    }
        } else {
            const float scale = (pn >= 12) ? 0.125f * 1.4426950408889634f : 1.0f;
            int ld = PW, c0; size_t boff = WS_P;
            if (pn < 6) { if (isctx) { boff = WS_PC; ld = PCW; } c0 = (isctx ? 0 : PO_NK) + (pn - 4) * 256; }
            else if (pn < 12) { c0 = PO_RG + (pn - 10) * 256; }
            else { c0 = PO_NQ + (pn - 12) * 256; }
            bf16* base = (bf16*)(ws + boff);
            const int rsub = isctx ? T : 0;
            const int col0 = c0 + wc * 32 + 8 * fq;
#pragma unroll
            for (int ai = 0; ai < 2; ++ai)
#pragma unroll
                for (int m = 0; m < 4; ++m) { bf16* rp = base + (size_t)(row0 + ai * 128 + m * 16 - rsub) * ld + col0;
#pragma unroll
                    for (int bj = 0; bj < 2; ++bj) { const f32x4 v0 = acc[ai][bj][m][0] * scale, v1 = acc[ai][bj][m][1] * scale;
                        *(u32x4*)(rp + bj * 128) = (u32x4){pk2(v0.x, v0.y), pk2(v0.z, v0.w), pk2(v1.x, v1.y), pk2(v1.z, v1.w)}; } }
        }
    }
};

__device__ __forceinline__ void dma16(const void* g, LAS unsigned char* l) { __builtin_amdgcn_global_load_lds((const unsigned*)g, (LAS unsigned*)l, 16, 0, 0); }
__device__ __forceinline__ bf16x8 frag256(const LAS unsigned char* tile, int row, int chunk) { return *(const LAS bf16x8*)(tile + row * 256 + ((chunk ^ (row & 15)) << 4)); }
__device__ __forceinline__ void phase3(const Ctx& F) {
    const bf16* KTr = (const bf16*)((const char*)F.H + DO_KTR); const bf16* KTrc = (const bf16*)((const char*)F.H + DO_KTRC);
    const bf16* VTr = (const bf16*)(F.ws + WS_VTR); const bf16* VTrc = (const bf16*)(F.ws + WS_VTRC);
    bf16* ST = (bf16*)((char*)F.H + DO_ST);
    const int lane = F.lane, r = lane & 31, hh = lane >> 5, dkt = F.wave & 3, dvs = F.wave >> 2, w = F.wave;
    for (int u0 = F.bid; u0 < 256; u0 += F.G) {
        const int unit = (F.G == 256) ? ((u0 & 7) * 32 + (u0 >> 3)) : u0;
        const int bh = unit >> 2, dvh = (unit >> 1) & 1, dir = unit & 1, h = bh & 3;
        const float lg2 = __log2f(1.0f - __expf(F.a->in[10][dir * 4 + h]));
        const float gstep = fexp2(dir == 0 ? -lg2 : lg2);
        const float cdec = fexp2(lg2 * 128.0f);
        f32x16 acc;
#pragma unroll
        for (int i = 0; i < 16; ++i) acc[i] = 0.f;
        __syncthreads();
#define P3_STAGE(s_) do { const int s__ = (s_); const bool cx = s__ < 2; const int ci = cx ? (dir == 0 ? s__ : 1 - s__) : (dir == 0 ? s__ - 2 : 17 - s__); \
            const bf16* kb = cx ? KTrc + (size_t)bh * 128 * CTXL + ci * 128 : KTr + (size_t)bh * 128 * TPITCH + ci * 128; \
            const bf16* vb = cx ? VTrc + ((size_t)bh * 128 + dvh * 64) * CTXL + ci * 128 : VTr + ((size_t)bh * 128 + dvh * 64) * TPITCH + ci * 128; \
            const size_t pitch = cx ? (size_t)CTXL : (size_t)TPITCH; \
            _Pragma("unroll") for (int i = 0; i < 6; ++i) { const int idx = (i < 4 ? i : i - 4) * 512 + w * 64 + lane, R = idx >> 4, cc = (idx & 15) ^ (R & 15); \
                dma16((i < 4 ? kb : vb) + (size_t)R * pitch + 8 * cc, F.lds + (s__ % 3) * 49152 + (i * 512 + w * 64) * 16); } } while (0)
        P3_STAGE(0); P3_STAGE(1);
#pragma unroll 1
        for (int s = 0; s < 18; ++s) {
            if (s >= 2) {
                const int c = dir == 0 ? s - 2 : 17 - s;
                bf16* sp = ST + ((((size_t)dir * 64 + bh) * 16 + c) * 128 + dvh * 64 + dvs * 32 + r) * 128 + dkt * 32 + 4 * hh;
#pragma unroll
                for (int g = 0; g < 4; ++g) *(u32x2*)(sp + 8 * g) = (u32x2){pk2(acc[4 * g], acc[4 * g + 1]), pk2(acc[4 * g + 2], acc[4 * g + 3])};
            }
            if (s < 2) asm volatile("s_waitcnt vmcnt(6)" ::: "memory"); else if (s < 17) asm volatile("s_waitcnt vmcnt(10)" ::: "memory"); else asm volatile("s_waitcnt vmcnt(0)" ::: "memory");
            __builtin_amdgcn_s_barrier(); asm volatile("" ::: "memory");
            if (s < 16) P3_STAGE(s + 2);
            if (s < 17) {
#pragma unroll
                for (int i = 0; i < 16; ++i) acc[i] *= cdec;
                const LAS unsigned char* kt = F.lds + (s % 3) * 49152; const LAS unsigned char* vt = kt + 32768;
#pragma unroll
                for (int ks = 0; ks < 8; ++ks) {
                    const bf16x8 af = frag256(kt, 32 * dkt + r, 2 * ks + hh); const bf16x8 vv = frag256(vt, 32 * dvs + r, 2 * ks + hh); bf16x8 bfr;
                    const int tk = 16 * ks + 8 * hh; float wgt = fexp2(lg2 * (float)(dir == 0 ? (127 - tk) : tk));
                    float wv8[8];
#pragma unroll
                    for (int j = 0; j < 8; ++j) { wv8[j] = bf2f((unsigned short)vv[j]) * wgt; wgt *= gstep; }
                    bfr = pack8((f32x4){wv8[0], wv8[1], wv8[2], wv8[3]}, (f32x4){wv8[4], wv8[5], wv8[6], wv8[7]});
                    acc = __builtin_amdgcn_mfma_f32_32x32x16_bf16(af, bfr, acc, 0, 0, 0);
                }
            }
        }
        asm volatile("s_waitcnt vmcnt(0) lgkmcnt(0)" ::: "memory");
        __syncthreads();
#undef P3_STAGE
    }
}

__device__ __forceinline__ void ret_unit(const Ctx& F, int unit) {
    const bf16* P = (const bf16*)(F.ws + WS_P); const bf16* ST = (const bf16*)((const char*)F.H + DO_ST); const bf16* VTr = (const bf16*)(F.ws + WS_VTR); bf16* Y = (bf16*)(F.ws + WS_XA);
    int lane = F.lane; asm volatile("" : "+v"(lane));
    const int li = lane & 15, kq = lane >> 4, w = F.wave;
    const int b = unit >> 6, h = (unit >> 4) & 3, c = unit & 15, bh = b * 4 + h;
    const size_t tok0 = (size_t)b * SEQ + c * 128;
    const int i0 = 16 * w;
    const float lgf = __log2f(1.0f - __expf(F.a->in[10][h])), lgb = __log2f(1.0f - __expf(F.a->in[10][4 + h]));
    constexpr int T_ST0 = 0, T_K = 65536, T_V = 98304;
    __syncthreads();
#pragma unroll
    for (int i = 0; i < 16; ++i) { const int tile = i >> 2; const int idx = (i & 3) * 512 + w * 64 + lane, R = idx >> 4, cc = (idx & 15) ^ (R & 15);
        const bf16* src;
        if (tile < 2) src = ST + ((((size_t)tile * 64 + bh) * 16 + c) * 128 + R) * 128 + 8 * cc;
        else if (tile == 2) src = P + (tok0 + R) * PW + PO_RK + h * 128 + 8 * cc;
        else src = VTr + ((size_t)bh * 128 + R) * TPITCH + c * 128 + 8 * cc;
        dma16(src, F.lds + (i * 512 + w * 64) * 16); }
    bf16x8 qf[4];
    { const bf16* qp = P + (tok0 + i0 + li) * PW + PO_RQ + h * 128 + 8 * kq;
#pragma unroll
      for (int ks = 0; ks < 4; ++ks) qf[ks] = *(const bf16x8*)(qp + 32 * ks); }
    asm volatile("s_waitcnt vmcnt(0)" ::: "memory");
    __syncthreads();
    f32x4 O[8];
#pragma unroll
    for (int dirn = 0; dirn < 2; ++dirn) {
        const LAS unsigned char* tl = F.lds + T_ST0 + dirn * 32768;
        float rs[4];
#pragma unroll
        for (int jj = 0; jj < 4; ++jj) { const int i = i0 + 4 * kq + jj; rs[jj] = dirn == 0 ? fexp2(lgf * (float)(i + 1)) : fexp2(lgb * (float)(128 - i)); }
#pragma unroll
        for (int nt = 0; nt < 8; ++nt) { f32x4 a = (f32x4){0.f, 0.f, 0.f, 0.f};
#pragma unroll
            for (int ks = 0; ks < 4; ++ks) a = __builtin_amdgcn_mfma_f32_16x16x32_bf16(qf[ks], frag256(tl, 16 * nt + li, 4 * ks + kq), a, 0, 0, 0);
#pragma unroll
            for (int jj = 0; jj < 4; ++jj) { const float v = a[jj] * rs[jj]; if (dirn == 0) O[nt][jj] = v; else O[nt][jj] += v; } }
    }
    bf16x8 pf[4];
    const int krow = 8 * (li >> 2) + (li & 3);
#pragma unroll
    for (int u = 0; u < 4; ++u) {
        f32x4 s2[2];
#pragma unroll
        for (int hf = 0; hf < 2; ++hf) { f32x4 a = (f32x4){0.f, 0.f, 0.f, 0.f};
#pragma unroll
            for (int ks = 0; ks < 4; ++ks) a = __builtin_amdgcn_mfma_f32_16x16x32_bf16(frag256(F.lds + T_K, 32 * u + krow + 4 * hf, 4 * ks + kq), qf[ks], a, 0, 0, 0);
#pragma unroll
            for (int jj = 0; jj < 4; ++jj) { const int dlt = (i0 + li) - (32 * u + 8 * kq + 4 * hf + jj);
                const float ex = fexp2((dlt > 0 ? lgf : lgb) * fabsf((float)dlt));
                a[jj] *= (dlt == 0) ? 2.0f : ex; }
            s2[hf] = a; }
        pf[u] = pack8(s2[0], s2[1]);
    }
#pragma unroll
    for (int u = 0; u < 4; ++u)
#pragma unroll
        for (int nt = 0; nt < 8; ++nt) O[nt] = __builtin_amdgcn_mfma_f32_16x16x32_bf16(pf[u], frag256(F.lds + T_V, 16 * nt + li, 4 * u + kq), O[nt], 0, 0, 0);
    __syncthreads();
    LAS float* osc = (LAS float*)(F.lds + w * 8448);
#pragma unroll
    for (int jj = 0; jj < 4; ++jj) {
        float sm = 0.f;
#pragma unroll
        for (int nt = 0; nt < 8; ++nt) sm += O[nt][jj];
        sm += __shfl_xor(sm, 1); sm += __shfl_xor(sm, 2); sm += __shfl_xor(sm, 4); sm += __shfl_xor(sm, 8);
        const float mean = sm * (1.0f / 128.0f); float q = 0.f;
#pragma unroll
        for (int nt = 0; nt < 8; ++nt) { const float d = O[nt][jj] - mean; q += d * d; }
        q += __shfl_xor(q, 1); q += __shfl_xor(q, 2); q += __shfl_xor(q, 4); q += __shfl_xor(q, 8);
        const float rstd = __builtin_amdgcn_rsqf(q * (1.0f / 128.0f) + LN_EPS);
#pragma unroll
        for (int nt = 0; nt < 8; ++nt) osc[(4 * kq + jj) * 132 + 16 * nt + li] = (O[nt][jj] - mean) * rstd;
    }
    LDS_WAIT(); asm volatile("" ::: "memory");
#pragma unroll
    for (int i = 0; i < 4; ++i) { const int q = lane + 64 * i, row = q >> 4, ch = q & 15; const size_t tk = tok0 + i0 + row;
        const f32x4 a = *(const LAS f32x4*)(osc + row * 132 + 8 * ch), c2 = *(const LAS f32x4*)(osc + row * 132 + 8 * ch + 4);
        const u32x4 g = *(const u32x4*)(P + tk * PW + PO_RG + h * 128 + 8 * ch);
        u32x4 o;
        o.x = pk2(silu_f(bflo(g.x)) * a.x, silu_f(bfhi(g.x)) * a.y); o.y = pk2(silu_f(bflo(g.y)) * a.z, silu_f(bfhi(g.y)) * a.w);
        o.z = pk2(silu_f(bflo(g.z)) * c2.x, silu_f(bfhi(g.z)) * c2.y); o.w = pk2(silu_f(bflo(g.w)) * c2.z, silu_f(bfhi(g.w)) * c2.w);
        if (ABL & 32) o = (u32x4){0u, 0u, 0u, 0u};
        *(u32x4*)(Y + tk * D + h * 128 + 8 * ch) = o; }
    LDS_WAIT(); asm volatile("" ::: "memory");
}
__device__ __forceinline__ void na_unit(const Ctx& F, int unit, bool load_ctx) {
    const bf16* P = (const bf16*)(F.ws + WS_P); const bf16* Pc = (const bf16*)(F.ws + WS_PC); bf16* Y = (bf16*)(F.ws + WS_XA);
    const bf16* VTn = (const bf16*)(F.ws + WS_VTN); const bf16* VTnc = (const bf16*)(F.ws + WS_VTNC);
    int lane = F.lane; asm volatile("" : "+v"(lane));
    const int li = lane & 15, kq = lane >> 4, w = F.wave;
    const int b = unit >> 7, nh = (unit >> 4) & 7, rp = unit & 15;
    const int r = 2 * rp + (w >> 2), cb = w & 3;
    const int rmin = min(max(2 * rp - 4, 0), GROWS - 8);
    const int r0 = min(max(r - 4, 0), GROWS - 8), kstart = min(max(16 * cb - 8, 0), GRIDW - 32);
    const int qc = 16 * cb + li; const int wstart = min(max(qc - 8, 0), GRIDW - 16);
    const size_t tokb = (size_t)b * SEQ;
    const int krow = 8 * (li >> 2) + (li & 3);
    constexpr int L_CTX = 73728, L_TBL = 106496, L_CTXV = 108544;
    __syncthreads();
#pragma unroll
    for (int i = 0; i < 13; ++i) { const int idx = i * 512 + w * 64 + lane; const bf16* src;
        if (i < 9) { const int R = idx >> 3, cc = (idx & 7) ^ (R & 7); const int kr = min(rmin + (R >> 6), GROWS - 1);
            src = P + (tokb + kr * 64 + (R & 63)) * PW + PO_NK + nh * 64 + 8 * cc; }
        else { if (!load_ctx) continue; const int id2 = idx - 4608, R = id2 >> 3, cc = (id2 & 7) ^ (R & 7); src = Pc + ((size_t)b * CTXL + R) * PCW + nh * 64 + 8 * cc; }
        dma16(src, F.lds + (i * 512 + w * 64) * 16); }
    if (load_ctx) {
#pragma unroll
        for (int i = 0; i < 4; ++i) { const int id2 = i * 512 + w * 64 + lane, Rd = id2 >> 5, cc = (id2 & 31) ^ (Rd & 7);
            dma16(VTnc + ((size_t)(b * 8 + nh) * 64 + Rd) * CTXL + 8 * cc, F.lds + L_CTXV + (i * 512 + w * 64) * 16); } }
    LAS float* tbl = (LAS float*)(F.lds + L_TBL);
    for (int q = F.tid; q < 15 * 32; q += 512) { const int rr = q >> 5, cc = q & 31; tbl[q] = cc < 31 ? F.a->in[11][(size_t)(nh * 15 + rr) * 31 + cc] * 1.4426950408889634f : -3.0e38f; }
    bf16x8 qf[2];
    { const bf16* qp = P + (tokb + r * 64 + qc) * PW + PO_NQ + nh * 64 + 8 * kq; qf[0] = *(const bf16x8*)qp; qf[1] = *(const bf16x8*)(qp + 32); }
    asm volatile("s_waitcnt vmcnt(0)" ::: "memory");
    __syncthreads();
    int cidx[8];
#pragma unroll
    for (int o = 0; o < 8; ++o) { const int kc = kstart + 8 * kq + o; const bool ok = (kc >= wstart) && (kc < wstart + 16); cidx[o] = ok ? (kc - qc + 15) : 31; }
    f32x4 sw[16], sc[16];
    float mx = -3.0e38f;
#pragma unroll
    for (int wt = 0; wt < 16; ++wt) {
        const int kr = r0 + (wt >> 1);
        f32x4 a;
#pragma unroll
        for (int jj = 0; jj < 4; ++jj) a[jj] = tbl[(kr - r + 7) * 32 + cidx[4 * (wt & 1) + jj]];
        const int R = (kr - rmin) * 64 + kstart + krow + 4 * (wt & 1);
        const LAS unsigned char* rowp = F.lds + R * 128;
        a = __builtin_amdgcn_mfma_f32_16x16x32_bf16(*(const LAS bf16x8*)(rowp + ((kq ^ (R & 7)) << 4)), qf[0], a, 0, 0, 0);
        a = __builtin_amdgcn_mfma_f32_16x16x32_bf16(*(const LAS bf16x8*)(rowp + (((4 + kq) ^ (R & 7)) << 4)), qf[1], a, 0, 0, 0);
#pragma unroll
        for (int jj = 0; jj < 4; ++jj) mx = fmaxf(mx, a[jj]);
        sw[wt] = a;
    }
#pragma unroll
    for (int ct = 0; ct < 16; ++ct) {
        const int R = 32 * (ct >> 1) + krow + 4 * (ct & 1);
        const LAS unsigned char* rowp = F.lds + L_CTX + R * 128;
        f32x4 a = (f32x4){0.f, 0.f, 0.f, 0.f};
        a = __builtin_amdgcn_mfma_f32_16x16x32_bf16(*(const LAS bf16x8*)(rowp + ((kq ^ (R & 7)) << 4)), qf[0], a, 0, 0, 0);
        a = __builtin_amdgcn_mfma_f32_16x16x32_bf16(*(const LAS bf16x8*)(rowp + (((4 + kq) ^ (R & 7)) << 4)), qf[1], a, 0, 0, 0);
#pragma unroll
        for (int jj = 0; jj < 4; ++jj) mx = fmaxf(mx, a[jj]);
        sc[ct] = a;
    }
    __syncthreads();
#pragma unroll
    for (int i = 0; i < 13; ++i) { const int idx = i * 512 + w * 64 + lane; const bf16* src;
        if (i < 9) { const int Rd = idx / 72, q = idx - Rd * 72, cc = q ^ (Rd & 7); const int kr = min(rmin + (cc >> 3), GROWS - 1);
            src = VTn + ((size_t)(b * 8 + nh) * 64 + Rd) * TPITCH + kr * 64 + (cc & 7) * 8; }
        else continue;
        dma16(src, F.lds + (i * 512 + w * 64) * 16); }
    mx = fmaxf(mx, __shfl_xor(mx, 16)); mx = fmaxf(mx, __shfl_xor(mx, 32));
    float sum = 0.f;
#pragma unroll
    for (int wt = 0; wt < 16; ++wt)
#pragma unroll
        for (int jj = 0; jj < 4; ++jj) { const float e = fexp2(sw[wt][jj] - mx); sw[wt][jj] = e; sum += e; }
#pragma unroll
    for (int ct = 0; ct < 16; ++ct)
#pragma unroll
        for (int jj = 0; jj < 4; ++jj) { const float e = fexp2(sc[ct][jj] - mx); sc[ct][jj] = e; sum += e; }
    sum += __shfl_xor(sum, 16); sum += __shfl_xor(sum, 32);
    asm volatile("s_waitcnt vmcnt(0)" ::: "memory");
    __syncthreads();
    f32x4 O[4];
#pragma unroll
    for (int nt = 0; nt < 4; ++nt) O[nt] = (f32x4){0.f, 0.f, 0.f, 0.f};
#pragma unroll
    for (int u = 0; u < 8; ++u) { bf16x8 pf;
        pf = pack8(sw[2 * u], sw[2 * u + 1]);
        const int cch = (r0 + u - rmin) * 8 + (kstart >> 3) + kq;
#pragma unroll
        for (int nt = 0; nt < 4; ++nt) { const int Rd = 16 * nt + li;
            O[nt] = __builtin_amdgcn_mfma_f32_16x16x32_bf16(pf, *(const LAS bf16x8*)(F.lds + Rd * 1152 + ((cch ^ (Rd & 7)) << 4)), O[nt], 0, 0, 0); } }
#pragma unroll
    for (int u = 0; u < 8; ++u) { bf16x8 pf;
        pf = pack8(sc[2 * u], sc[2 * u + 1]);
#pragma unroll
        for (int nt = 0; nt < 4; ++nt) { const int Rd = 16 * nt + li;
            O[nt] = __builtin_amdgcn_mfma_f32_16x16x32_bf16(pf, *(const LAS bf16x8*)(F.lds + L_CTXV + Rd * 512 + (((4 * u + kq) ^ (Rd & 7)) << 4)), O[nt], 0, 0, 0); } }
    __syncthreads();
    LAS float* osc = (LAS float*)(F.lds + w * 4352);
#pragma unroll
    for (int jj = 0; jj < 4; ++jj) {
        const float sq = __shfl(sum, 4 * kq + jj); const float inv = frcp(sq);
#pragma unroll
        for (int nt = 0; nt < 4; ++nt) osc[(4 * kq + jj) * 68 + 16 * nt + li] = O[nt][jj] * inv;
    }
    LDS_WAIT(); asm volatile("" ::: "memory");
#pragma unroll
    for (int i = 0; i < 2; ++i) { const int q = lane + 64 * i, row = q >> 3, ch = q & 7;
        const f32x4 a = *(const LAS f32x4*)(osc + row * 68 + 8 * ch), c2 = *(const LAS f32x4*)(osc + row * 68 + 8 * ch + 4);
        u32x4 o = (u32x4){pk2(a.x, a.y), pk2(a.z, a.w), pk2(c2.x, c2.y), pk2(c2.z, c2.w)};
        if (ABL & 16) o = (u32x4){0u, 0u, 0u, 0u};
        *(u32x4*)(Y + (tokb + r * 64 + 16 * cb + row) * D + 512 + nh * 64 + 8 * ch) = o; }
    LDS_WAIT(); asm volatile("" ::: "memory");
}
__device__ __forceinline__ void phase4(const Ctx& F) {
#ifndef P4MASK
#define P4MASK 3
#endif
    if (P4MASK & 1) for (int u = F.bid; u < 1024; u += F.G) ret_unit(F, u);
    if (P4MASK & 2) {
        if (F.G == 256) { const int vb = (F.bid & 7) * 32 + (F.bid >> 3);
            for (int k = 0; k < 8; ++k) na_unit(F, vb * 8 + k, k == 0); }
        else for (int u = F.bid; u < 2048; u += F.G) na_unit(F, u, true);
    }
}

struct SchedOut {
    int G, c; const char* Wt;
    __device__ __forceinline__ bool next(int i, g8::Unit& u) const {
        const int L = i * G + c; if (L >= 512) return false;
        int pm, pn; g8::tile_of(L, 128, 4, pm, pn); u.pm = pm; u.pn = pn; u.e = 0; u.aux = 0; u.B = Wt + (size_t)pn * 256 * 1024 * 2; return true; }
    __device__ __forceinline__ unsigned rowoff(const g8::Unit& u, int r) const { return (unsigned)(u.pm * 256 + r) * 2048u; }
};
struct EpiY {
    static constexpr bool IDEMP = true;
    bf16* Yg; const float* gate0; const float* cs; float abl;
    __device__ __forceinline__ void operator()(const f32x4 (&acc)[2][2][4][2], const g8::Unit& u, int wr, int wc, int fr, int fq) const {
        const int row0 = u.pm * 256 + wr * 64 + fr, col0 = u.pn * 256 + wc * 32 + 8 * fq;
        const float* gp = gate0 + (size_t)(row0 >> 11) * 6144 + col0;
        f32x4 gv[2][2];
#pragma unroll
        for (int bj = 0; bj < 2; ++bj)
#pragma unroll
            for (int n = 0; n < 2; ++n) { gv[bj][n] = *(const f32x4*)(gp + bj * 128 + n * 4) * abl; if (cs) gv[bj][n] *= *(const f32x4*)(cs + col0 + bj * 128 + n * 4); }
#pragma unroll
        for (int ai = 0; ai < 2; ++ai)
#pragma unroll
            for (int m = 0; m < 4; ++m) { bf16* rp = Yg + (size_t)(row0 + ai * 128 + m * 16) * D + col0;
#pragma unroll
                for (int bj = 0; bj < 2; ++bj) { const f32x4 v0 = acc[ai][bj][m][0] * gv[bj][0], v1 = acc[ai][bj][m][1] * gv[bj][1];
                    *(u32x4*)(rp + bj * 128) = (u32x4){pk2(v0.x, v0.y), pk2(v0.z, v0.w), pk2(v1.x, v1.y), pk2(v1.z, v1.w)}; } }
    }
};

struct LnVecs { f32x4 lg[4], lb[4], sh[4], sc1[4]; f32x4 br1; };
__device__ __forceinline__ void ln_load(const float* R32, const bf16* R16, const bf16* Yg, int t, int lane, f32x4 (&nr)[4], u32x2 (&ny)[4]) {
    const u32x2* yr = (const u32x2*)(Yg + (size_t)t * D) + lane;
    if (R32) { const float* rr = R32 + (size_t)t * D;
#pragma unroll
        for (int j = 0; j < 4; ++j) nr[j] = *(const f32x4*)(rr + 4 * lane + 256 * j); }
    else { const u32x2* rr = (const u32x2*)(R16 + (size_t)t * D) + lane;
#pragma unroll
        for (int j = 0; j < 4; ++j) { const u32x2 h = rr[64 * j]; nr[j] = (f32x4){bflo(h.x), bfhi(h.x), bflo(h.y), bfhi(h.y)}; } }
#pragma unroll
    for (int j = 0; j < 4; ++j) ny[j] = yr[64 * j];
}
__device__ __forceinline__ void ln_row(const Ctx& F, int l, int t, const f32x4 (&nr)[4], const u32x2 (&ny)[4], const LnVecs& V, LAS f32x4* wl, LAS u32x4* rec_slot) {
    const int lane = F.lane; const LAS float* br2l = (const LAS float*)(F.lds + 149760);
    bf16* hm = (bf16*)(F.ws + WS_XA);
    unsigned long long* hr8 = (unsigned long long*)((bf16*)(F.ws + WS_H16) + (size_t)t * D) + lane;
    f32x4 v[4]; float s = 0.f;
#pragma unroll
    for (int j = 0; j < 4; ++j) { const u32x2 y = ny[j]; v[j] = nr[j] * ALPHA + (f32x4){bflo(y.x), bfhi(y.x), bflo(y.y), bfhi(y.y)}; s += (v[j].x + v[j].y) + (v[j].z + v[j].w); }
    const float mean = wave_sum(s) * (1.0f / D); float s2 = 0.f;
#pragma unroll
    for (int j = 0; j < 4; ++j) { v[j] = v[j] - mean; s2 += (v[j].x * v[j].x + v[j].y * v[j].y) + (v[j].z * v[j].z + v[j].w * v[j].w); }
    const float rstd = __builtin_amdgcn_rsqf(wave_sum(s2) * (1.0f / D) + LN_EPS);
    unsigned long long* o8 = (unsigned long long*)(hm + (size_t)t * D) + lane;
    float pg[4] = {0.f, 0.f, 0.f, 0.f};
#pragma unroll
    for (int j = 0; j < 4; ++j) { const int ci = 4 * lane + 256 * j;
        const f32x4 h1 = v[j] * rstd * V.lg[j] + V.lb[j];
        hr8[64 * j] = (unsigned long long)pk2(h1.x, h1.y) | ((unsigned long long)pk2(h1.z, h1.w) << 32);
        const f32x4 m = h1 * V.sc1[j] + V.sh[j];
        v[j] = m;
        o8[64 * j] = (unsigned long long)pk2(m.x, m.y) | ((unsigned long long)pk2(m.z, m.w) << 32);
#pragma unroll
        for (int e = 0; e < 4; ++e) { const f32x4 w = wl[(4 * j + e) * 64 + lane];
#pragma unroll
            for (int g = 0; g < 4; ++g) pg[g] += m[e] * w[g]; } }
    float lgt[4];
#pragma unroll
    for (int g = 0; g < 4; ++g) lgt[g] = wave_sum(pg[g]) + V.br1[g];
    int grp = 0; float gm = lgt[0];
#pragma unroll
    for (int g = 1; g < 4; ++g) if (lgt[g] > gm) { gm = lgt[g]; grp = g; }
    float gs = 0.f;
#pragma unroll
    for (int g = 0; g < 4; ++g) gs += __expf(lgt[g] - gm);
    const float gate_g = 1.0f / gs;
    float pe[8] = {0.f, 0.f, 0.f, 0.f, 0.f, 0.f, 0.f, 0.f};
#pragma unroll
    for (int j = 0; j < 4; ++j) {
#pragma unroll
        for (int e = 0; e < 4; ++e) { const f32x4 wa = wl[1024 + 2048 * grp + ((4 * j + e) * 2) * 64 + lane], wb = wl[1024 + 2048 * grp + ((4 * j + e) * 2 + 1) * 64 + lane];
#pragma unroll
            for (int q = 0; q < 4; ++q) { pe[q] += v[j][e] * wa[q]; pe[4 + q] += v[j][e] * wb[q]; } } }
    float le[8];
    {
        float a4[4], a2[2], a1;
#pragma unroll
        for (int q = 0; q < 4; ++q) { const float mine = (lane & 1) ? pe[q + 4] : pe[q], send = (lane & 1) ? pe[q] : pe[q + 4]; a4[q] = mine + __shfl_xor(send, 1); }
#pragma unroll
        for (int q = 0; q < 2; ++q) { const float mine = (lane & 2) ? a4[q + 2] : a4[q], send = (lane & 2) ? a4[q] : a4[q + 2]; a2[q] = mine + __shfl_xor(send, 2); }
        { const float mine = (lane & 4) ? a2[1] : a2[0], send = (lane & 4) ? a2[0] : a2[1]; a1 = mine + __shfl_xor(send, 4); }
        a1 += __shfl_xor(a1, 8); a1 += __shfl_xor(a1, 16); a1 += __shfl_xor(a1, 32);
#pragma unroll
        for (int q = 0; q < 8; ++q) { const int src = ((q >> 2) & 1) | (((q >> 1) & 1) << 1) | ((q & 1) << 2); le[q] = __shfl(a1, src) + br2l[grp * 8 + q]; }

    }
    int i0 = 0; float v0 = le[0];
#pragma unroll
    for (int q = 1; q < 8; ++q) if (le[q] > v0) { v0 = le[q]; i0 = q; }
    int i1 = -1; float v1 = -3.0e38f;
#pragma unroll
    for (int q = 0; q < 8; ++q) if (q != i0 && le[q] > v1) { v1 = le[q]; i1 = q; }
    const float e1 = __expf(v1 - v0); const float w0 = (ABL & 128) ? 0.f : gate_g / (1.0f + e1), w1 = (ABL & 1024) ? 1.0f : ((ABL & 64) ? 0.f : gate_g * e1 / (1.0f + e1));
    if (lane == 0) *rec_slot = (u32x4){(unsigned)(grp * 8 + i0), (unsigned)(grp * 8 + i1), __builtin_bit_cast(unsigned, w0), __builtin_bit_cast(unsigned, w1)};
}
__device__ __forceinline__ void phase_ln_router(const Ctx& F, int l, const float* R32, const bf16* Yg) {
    const bf16* R16 = (const bf16*)(F.ws + WS_H16);
    const int gw = F.bid * 8 + F.wave, lane = F.lane;
    int* tokinfo = (int*)(F.ws + WS_TOKINFO); int* list = (int*)(F.ws + WS_LIST);
    unsigned* cnt = (unsigned*)(F.ws + WS_CTL) + CW_CNT + 64 * (l * 32);
    LAS f32x4* wl = (LAS f32x4*)F.lds;
    __syncthreads();
    for (int k = F.tid; k < 1024; k += 512) { const int ln = (k & 255) >> 2, e = k & 3, j = k >> 8;
        wl[(4 * j + e) * 64 + ln] = *(const f32x4*)(F.a->in[14] + ((size_t)l * D + k) * 4);
#pragma unroll
        for (int g = 0; g < 4; ++g)
#pragma unroll
            for (int q = 0; q < 2; ++q) wl[1024 + 2048 * g + ((4 * j + e) * 2 + q) * 64 + ln] = *(const f32x4*)(F.a->in[16] + (((size_t)l * 4 + g) * D + k) * 8 + 4 * q); }
    if (F.tid < 32) ((LAS float*)(F.lds + 149760))[F.tid] = F.a->in[17][l * 32 + F.tid];
    __syncthreads();
    LAS u32x4* recs = (LAS u32x4*)(F.lds + 147456);
    const int t_lo = gw * 16;
    for (int tb = t_lo; tb < T; tb += F.G * 8 * 16) {
        const int b = tb >> 11;
        LnVecs V;
#pragma unroll
        for (int j = 0; j < 4; ++j) { const int ci = 4 * lane + 256 * j;
            V.lg[j] = *(const f32x4*)(F.a->in[6] + (l * 2 + 0) * D + ci); V.lb[j] = *(const f32x4*)(F.a->in[7] + (l * 2 + 0) * D + ci);
            V.sh[j] = *(const f32x4*)(modp(F, l, b, 3) + ci); V.sc1[j] = *(const f32x4*)(modp(F, l, b, 4) + ci) + 1.0f; }
        V.br1 = *(const f32x4*)(F.a->in[15] + l * 4);
        f32x4 rA[4], rB[4]; u32x2 yA[4], yB[4];
        ln_load(R32, R16, Yg, tb, lane, rA, yA);
#pragma unroll 1
        for (int k = 0; k < 16; k += 2) {
            ln_load(R32, R16, Yg, tb + k + 1, lane, rB, yB);
            asm volatile("" ::: "memory");
            ln_row(F, l, tb + k, rA, yA, V, wl, recs + F.wave * 16 + k);
            if (k + 2 < 16) ln_load(R32, R16, Yg, tb + k + 2, lane, rA, yA);
            asm volatile("" ::: "memory");
            ln_row(F, l, tb + k + 1, rB, yB, V, wl, recs + F.wave * 16 + k + 1);
        }
        LAS int* lcnt = (LAS int*)(F.lds + 149504);
        __syncthreads();
        if (F.tid < 64) lcnt[F.tid] = 0;
        __syncthreads();
        int e = 0, lp = 0; unsigned wa = 0u, wb = 0u; const int which = F.tid & 1;
        const int r = F.tid >> 1; const int t = (tb - F.wave * 16) + r;
        if (F.tid < 256) { const u32x4 rec = recs[r]; e = which ? (int)rec.y : (int)rec.x; wa = rec.z; wb = rec.w;
            lp = __hip_atomic_fetch_add(&lcnt[e], 1, __ATOMIC_RELAXED, __HIP_MEMORY_SCOPE_WORKGROUP); }
        __syncthreads();
        if (F.tid < 32) lcnt[32 + F.tid] = (int)atomicAdd(cnt + 64 * F.tid, (unsigned)lcnt[F.tid]);
        __syncthreads();
        if (F.tid < 256) { const int pos = lcnt[32 + e] + lp;
            list[(size_t)e * LISTCAP + pos] = t;
            int* ti = tokinfo + (size_t)t * 8;
            *(u32x2*)(ti + 2 * which) = (u32x2){(unsigned)e, (unsigned)pos};
            if (which == 0) *(u32x2*)(ti + 4) = (u32x2){wa, wb}; }
    }
}

__device__ __forceinline__ void moe_table(const Ctx& F, int l) {
    LAS int* tab = (LAS int*)(F.lds + LDS_TAB_OFF);
    __syncthreads();
    if (F.tid < 32) tab[40 + F.tid] = (int)__hip_atomic_load((unsigned*)(F.ws + WS_CTL) + CW_CNT + 64 * (l * 32 + F.tid), __ATOMIC_RELAXED, __HIP_MEMORY_SCOPE_AGENT);
    __syncthreads();
    if (F.tid == 0) { int s = 0; for (int e = 0; e < 32; ++e) { tab[e] = s; s += (tab[40 + e] + 255) >> 8; } tab[32] = s; }
    __syncthreads();
}
__device__ __forceinline__ int moe_vc(int c, int G) { return (G == 256) ? (((c & 7) * 8 + (c >> 5)) * 4 + ((c >> 3) & 3)) : c; }
struct SchedMoe {
    int G, c; const char* Wt; size_t wstride; size_t pnstride; const LAS int* tab; const LAS int* tokl; int gather; unsigned lda2;
    __device__ __forceinline__ bool next(int i, g8::Unit& u) const {
        const int L = i * G + moe_vc(c, G); const int nrt = __builtin_amdgcn_readfirstlane(tab[32]); if (L >= 4 * nrt) return false;
        const int rt = L >> 2, pn = L & 3; int e = 0;
        for (int q = 1; q < 32; ++q) e = (tab[q] <= rt) ? q : e;
        e = __builtin_amdgcn_readfirstlane(e);
        u.pm = rt; u.pn = pn; u.e = e; u.aux = i; u.B = Wt + (size_t)e * wstride + (size_t)pn * pnstride; return true; }
    __device__ __forceinline__ unsigned rowoff(const g8::Unit& u, int r) const {
        if (gather) return (unsigned)tokl[u.aux * 256 + r] * lda2;
        return (unsigned)(u.pm * 256 + r) * lda2; }
};
constexpr int MOE_MAXU = 8, LDS_TOKL_OFF = LDSCTL_OFF + 1024;
static_assert(LDS_TOKL_OFF + MOE_MAXU * 256 * 4 <= LDS_BYTES && LDS_SCR_OFF + 8 * 2304 <= LDSCTL_OFF, "LDS map");
__device__ __forceinline__ void moe_tokl(const Ctx& F) {
    const LAS int* tab = (const LAS int*)(F.lds + LDS_TAB_OFF); LAS int* tokl = (LAS int*)(F.lds + LDS_TOKL_OFF);
    const int* list = (const int*)(F.ws + WS_LIST);
    for (int q = F.tid; q < MOE_MAXU * 256; q += 512) { const int i = q >> 8, r = q & 255; const int L = i * F.G + moe_vc(F.bid, F.G); int tk = 0;
        if (L < 4 * tab[32]) { const int rt = L >> 2; int e = 0; for (int k = 1; k < 32; ++k) e = (tab[k] <= rt) ? k : e;
            const int idx = (rt - tab[e]) * 256 + r; tk = list[(size_t)e * LISTCAP + (idx < tab[40 + e] ? idx : 0)]; }
        tokl[q] = tk; }
    __syncthreads();
}
struct EpiAct {
    bf16* act;
    __device__ __forceinline__ void operator()(const f32x4 (&acc)[2][2][4][2], const g8::Unit& u, int wr, int wc, int fr, int fq) const {
        const int row0 = u.pm * 256 + wr * 64 + fr, col0 = u.pn * 128 + wc * 32 + 8 * fq;
#pragma unroll
        for (int ai = 0; ai < 2; ++ai)
#pragma unroll
            for (int m = 0; m < 4; ++m) { bf16* rp = act + (size_t)(row0 + ai * 128 + m * 16) * HID + col0;
                const f32x4 g0 = acc[ai][0][m][0], u0 = acc[ai][0][m][1], g1 = acc[ai][1][m][0], u1 = acc[ai][1][m][1];
                *(u32x4*)rp = (u32x4){pk2(silu_f(g0.x) * u0.x, silu_f(g0.y) * u0.y), pk2(silu_f(g0.z) * u0.z, silu_f(g0.w) * u0.w),
                                      pk2(silu_f(g1.x) * u1.x, silu_f(g1.y) * u1.y), pk2(silu_f(g1.z) * u1.z, silu_f(g1.w) * u1.w)}; }
    }
};
struct EpiEo {
    bf16* eo;
    __device__ __forceinline__ void operator()(const f32x4 (&acc)[2][2][4][2], const g8::Unit& u, int wr, int wc, int fr, int fq) const {
        const int row0 = u.pm * 256 + wr * 64 + fr, col0 = u.pn * 256 + wc * 32 + 8 * fq;
#pragma unroll
        for (int ai = 0; ai < 2; ++ai)
#pragma unroll
            for (int m = 0; m < 4; ++m) { bf16* rp = eo + (size_t)(row0 + ai * 128 + m * 16) * D + col0;
#pragma unroll
                for (int bj = 0; bj < 2; ++bj) { const f32x4 v0 = acc[ai][bj][m][0], v1 = acc[ai][bj][m][1];
                    *(u32x4*)(rp + bj * 128) = (u32x4){pk2(v0.x, v0.y), pk2(v0.z, v0.w), pk2(v1.x, v1.y), pk2(v1.z, v1.w)}; } }
    }
};

struct CmbRow { u32x2 h[4]; u32x2 ea[4], eb[4]; };
__device__ __forceinline__ void cmb_load(const Ctx& F, const LAS int* tab, int t, const u32x4& ti, CmbRow& r) {
    const unsigned e0i = ti.x, p0i = ti.y, e1i = ti.z, p1i = ti.w;
    const size_t s0 = (size_t)tab[e0i] * 256 + p0i, s1 = (size_t)tab[e1i] * 256 + p1i;
    const bf16* eo = (const bf16*)(F.ws + WS_EO);
    const u32x2* e0 = (const u32x2*)(eo + s0 * D) + F.lane; const u32x2* e1 = (const u32x2*)(eo + s1 * D) + F.lane; const u32x2* hp = (const u32x2*)((const bf16*)(F.ws + WS_H16) + (size_t)t * D) + F.lane;
#pragma unroll
    for (int j = 0; j < 4; ++j) { r.ea[j] = e0[64 * j]; r.eb[j] = e1[64 * j]; r.h[j] = hp[64 * j]; }
}
__device__ __forceinline__ void cmb_row(const Ctx& F, int l, int t, const CmbRow& r, const u32x2& tw, const f32x4 (&gt)[4], const f32x4 (&lg)[4], const f32x4 (&lb)[4]) {
    const float ab = ((ABL >> (1 + 2 * l)) & 1) ? 0.f : 1.f;
    const unsigned twx = tw.x, twy = tw.y;
    const float w0 = ab * __uint_as_float(twx), w1 = ab * __uint_as_float(twy);
    f32x4 v[4]; float s = 0.f;
#pragma unroll
    for (int j = 0; j < 4; ++j) { const u32x2 a = r.ea[j], c2 = r.eb[j];
        f32x4 y; y.x = w0 * bflo(a.x) + w1 * bflo(c2.x); y.y = w0 * bfhi(a.x) + w1 * bfhi(c2.x); y.z = w0 * bflo(a.y) + w1 * bflo(c2.y); y.w = w0 * bfhi(a.y) + w1 * bfhi(c2.y);
        const u32x2 hh = r.h[j]; v[j] = (f32x4){bflo(hh.x), bfhi(hh.x), bflo(hh.y), bfhi(hh.y)} * ALPHA + gt[j] * y; s += (v[j].x + v[j].y) + (v[j].z + v[j].w); }
    const float mean = wave_sum(s) * (1.0f / D); float s2 = 0.f;
#pragma unroll
    for (int j = 0; j < 4; ++j) { v[j] = v[j] - mean; s2 += (v[j].x * v[j].x + v[j].y * v[j].y) + (v[j].z * v[j].z + v[j].w * v[j].w); }
    const float rstd = __builtin_amdgcn_rsqf(wave_sum(s2) * (1.0f / D) + LN_EPS);
    if (l == 1) { float* hr = F.H + (size_t)t * D;
#pragma unroll
        for (int j = 0; j < 4; ++j) *(f32x4*)(hr + 4 * F.lane + 256 * j) = v[j] * rstd * lg[j] + lb[j]; }
    else { unsigned long long* hr8 = (unsigned long long*)((bf16*)(F.ws + WS_H16) + (size_t)t * D) + F.lane;
#pragma unroll
        for (int j = 0; j < 4; ++j) { const f32x4 o = v[j] * rstd * lg[j] + lb[j]; hr8[64 * j] = (unsigned long long)pk2(o.x, o.y) | ((unsigned long long)pk2(o.z, o.w) << 32); } }
}
__device__ __forceinline__ void phase_combine(const Ctx& F, int l) {
    moe_table(F, l);
    const LAS int* tab = (const LAS int*)(F.lds + LDS_TAB_OFF);
    const int gw = F.bid * 8 + F.wave, lane = F.lane;
    const int* tokinfo = (const int*)(F.ws + WS_TOKINFO);
    for (int tb = gw * 16; tb < T; tb += F.G * 8 * 16) {
        const int b = tb >> 11;
        f32x4 gt[4], lg[4], lb[4];
#pragma unroll
        for (int j = 0; j < 4; ++j) { const int ci = 4 * lane + 256 * j; gt[j] = *(const f32x4*)(modp(F, l, b, 5) + ci);
            lg[j] = *(const f32x4*)(F.a->in[6] + (l * 2 + 1) * D + ci); lb[j] = *(const f32x4*)(F.a->in[7] + (l * 2 + 1) * D + ci); }
        u32x4 tiv = (u32x4){0u, 0u, 0u, 0u}; u32x2 twv = (u32x2){0u, 0u};
        if (lane < 16) { tiv = *(const u32x4*)(tokinfo + (size_t)(tb + lane) * 8); twv = *(const u32x2*)(tokinfo + (size_t)(tb + lane) * 8 + 4); }
#define CMB_TI(k_) ((u32x4){(unsigned)__shfl((int)tiv.x, (k_)), (unsigned)__shfl((int)tiv.y, (k_)), (unsigned)__shfl((int)tiv.z, (k_)), (unsigned)__shfl((int)tiv.w, (k_))})
#define CMB_TW(k_) ((u32x2){(unsigned)__shfl((int)twv.x, (k_)), (unsigned)__shfl((int)twv.y, (k_))})
        CmbRow A, B;
        cmb_load(F, tab, tb, CMB_TI(0), A);
#pragma unroll 1
        for (int k = 0; k < 16; k += 2) {
            cmb_load(F, tab, tb + k + 1, CMB_TI(k + 1), B);
            asm volatile("" ::: "memory");
            cmb_row(F, l, tb + k, A, CMB_TW(k), gt, lg, lb);
            if (k + 2 < 16) cmb_load(F, tab, tb + k + 2, CMB_TI(k + 2), A);
            asm volatile("" ::: "memory");
            cmb_row(F, l, tb + k + 1, B, CMB_TW(k + 1), gt, lg, lb);
        }
#undef CMB_TI
#undef CMB_TW
    }
}

template <int WH> __device__ __forceinline__ void pool_item(const Ctx& F, bf16* zp, int b, int p0, int ch) {
    const bf16* hb = (const bf16*)(F.ws + WS_H16) + (size_t)b * SEQ * D + ch;
    const f32x4 sc1 = *(const f32x4*)(modp(F, 1, b, 1) + ch) + 1.0f;
    u32x2 rw[8 + 2 * WH];
#pragma unroll
    for (int i = 0; i < 8 + 2 * WH; ++i) { const int p = p0 - WH + i; const bool ok = (p >= 0) && (p < SEQ); const u32x2 v = *(const u32x2*)(hb + (size_t)(ok ? p : p0) * D); rw[i] = ok ? v : (u32x2){0u, 0u}; }
#define PZ_ROW(i_) ((f32x4){bflo(rw[i_].x), bfhi(rw[i_].x), bflo(rw[i_].y), bfhi(rw[i_].y)})
    f32x4 sum = (f32x4){0.f, 0.f, 0.f, 0.f};
#pragma unroll
    for (int i = 0; i < 2 * WH; ++i) sum += PZ_ROW(i);
#pragma unroll
    for (int j = 0; j < 8; ++j) { const int p = p0 + j; const int cnt = min(p + WH, SEQ) - max(p - WH, 0);
        const f32x4 z = (sum * frcp((float)cnt) - PZ_ROW(j + WH)) * sc1;
        *(u32x2*)(zp + ((size_t)b * SEQ + p) * D + ch) = (u32x2){pk2(z.x, z.y), pk2(z.z, z.w)};
        sum += PZ_ROW(j + 2 * WH) - PZ_ROW(j); }
#undef PZ_ROW
}
__device__ __forceinline__ void phase_pool(const Ctx& F) {
    bf16* zp = (bf16*)(F.ws + WS_XA);
    for (int item = F.bid * 512 + F.tid; item < 4096 * 256; item += F.G * 512) {
        const int strip = item >> 8, ct = item & 255, b = strip >> 8, p0 = (strip & 255) * 8, ch = 4 * ct;
        const int g = __builtin_amdgcn_readfirstlane(ct >> 6);
        if (g == 0) pool_item<1>(F, zp, b, p0, ch); else if (g == 1) pool_item<2>(F, zp, b, p0, ch); else if (g == 2) pool_item<4>(F, zp, b, p0, ch); else pool_item<8>(F, zp, b, p0, ch);
    }
}
struct SchedPool {
    int G, c; const char* Wt;
    __device__ __forceinline__ bool next(int i, g8::Unit& u) const {
        const int L = i * G + c; if (L >= 512) return false;
        int pm, pn; g8::tile_of(L, 128, 4, pm, pn); u.pm = pm; u.pn = pn; u.e = 0; u.aux = 0; u.B = Wt + (size_t)pn * 256 * 256 * 2; return true; }
    __device__ __forceinline__ unsigned rowoff(const g8::Unit& u, int r) const { return (unsigned)(u.pm * 256 + r) * 2048u + (unsigned)u.pn * 512u; }
};

__global__ void __launch_bounds__(512, 2) mk_fwd(Args args) {
    extern __shared__ __attribute__((aligned(16))) unsigned char lds_raw[];
    Ctx F;
    F.lds = (LAS unsigned char*)lds_raw;
    F.tid = threadIdx.x; F.lane = F.tid & 63; F.wave = __builtin_amdgcn_readfirstlane(F.tid >> 6); F.G = gridDim.x; F.bid = blockIdx.x;
    F.a = (KArgs)__builtin_amdgcn_kernarg_segment_ptr();
    F.H = args.out; F.ws = args.ws;
    for (int u = F.tid; u < (LDS_BYTES - LDSCTL_OFF) / 4; u += 512) ((LAS unsigned*)(F.lds + LDSCTL_OFF))[u] = 0u;
    __syncthreads();
    XcdBarrier bar; bar.bar = (unsigned*)(F.ws + WS_CTL) + CW_BAR; bar.x = 0; bar.st = nullptr;
    if (MK_N_LAUNCHES == 1) bar = xcd_barrier_post((unsigned*)(F.ws + WS_CTL) + CW_BAR, (volatile LAS unsigned*)(F.lds + LDSCTL_OFF));
    const int lo = args.ph_lo, hi = args.ph_hi;
#ifndef PHMASK
#define PHMASK 0xFFFF
#endif
#define IN(k) (((PHMASK >> (k)) & 1) && lo <= (k) && (k) < hi)
#define FRESH() do { asm volatile("" : "+s"(F.a)); } while (0)
#define SEAM(k) do { if (IN(k) && IN((k) + 1)) xcd_barrier(bar); } while (0)

    if (IN(0)) { FRESH(); phase0(F); if (RPT & 1) { __syncthreads(); phase0(F); } } SEAM(0);
    if (IN(1)) { FRESH(); phase1(F); if (RPT & 2) { __syncthreads(); phase1(F); } } SEAM(1);
    if (IN(2)) { FRESH();
        SchedIn S{F.G, F.bid, (const char*)(F.ws + WS_WIN)};
        EpiIn E{F.ws, (unsigned char*)F.H, F.lds};
        g8::gemm_phase(F.lds, (const char*)(F.ws + WS_XA), 1024, S, E);
        convert_tail(F, F.bid, (1792 + 128) % 256, 0, 10240);
    } SEAM(2);
    if (IN(3)) { FRESH(); phase3(F); if (RPT & 8) { __syncthreads(); phase3(F); } } SEAM(3);
    if (IN(4)) { FRESH(); phase4(F); if (RPT & 16) { __syncthreads(); phase4(F); } } SEAM(4);
    if (IN(5)) { FRESH();
        SchedOut S{F.G, F.bid, (const char*)(F.ws + WS_WOUT)};
        EpiY E{(bf16*)(F.ws + WS_P), modp(F, 0, 0, 2), nullptr, (ABL & 1) ? 0.f : 1.f};
        g8::gemm_phase(F.lds, (const char*)(F.ws + WS_XA), 1024, S, E); if ((RPT >> 5) & 1) { __syncthreads(); g8::gemm_phase(F.lds, (const char*)(F.ws + WS_XA), 1024, S, E); }
    } SEAM(5);
    if (IN(6)) { FRESH(); phase_ln_router(F, 0, F.a->in[0], (const bf16*)(F.ws + WS_P)); } SEAM(6);
    if (IN(7)) { FRESH();
        moe_table(F, 0); moe_tokl(F);
        SchedMoe S{F.G, F.bid, (const char*)(F.ws + WS_WGU), (size_t)1024 * 1024 * 2, (size_t)256 * 1024 * 2, (const LAS int*)(F.lds + LDS_TAB_OFF), (const LAS int*)(F.lds + LDS_TOKL_OFF), 1, 2048u};
        EpiAct E{(bf16*)(F.ws + WS_ACT)};
        g8::gemm_phase(F.lds, (const char*)(F.ws + WS_XA), 1024, S, E);
        convert_tail(F, moe_vc(F.bid, F.G), (4 * ((const LAS int*)(F.lds + LDS_TAB_OFF))[32]) % 256, 10240, 20480); if ((RPT >> 7) & 1) { __syncthreads(); g8::gemm_phase(F.lds, (const char*)(F.ws + WS_XA), 1024, S, E); }
    } SEAM(7);
    if (IN(8)) { FRESH();
        moe_table(F, 0);
        SchedMoe S{F.G, F.bid, (const char*)(F.ws + WS_WDN), (size_t)1024 * 512 * 2, (size_t)256 * 512 * 2, (const LAS int*)(F.lds + LDS_TAB_OFF), (const LAS int*)(F.lds + LDS_TOKL_OFF), 0, 1024u};
        EpiEo E{(bf16*)(F.ws + WS_EO)};
        g8::gemm_phase(F.lds, (const char*)(F.ws + WS_ACT), 512, S, E);
        convert_tail(F, moe_vc(F.bid, F.G), (4 * ((const LAS int*)(F.lds + LDS_TAB_OFF))[32]) % 256, 20480, I_E1); if ((RPT >> 8) & 1) { __syncthreads(); g8::gemm_phase(F.lds, (const char*)(F.ws + WS_ACT), 512, S, E); }
    } SEAM(8);
    if (IN(9)) { FRESH(); phase_combine(F, 0); } SEAM(9);
    if (IN(10)) { FRESH(); phase_pool(F); if (RPT & 1024) { __syncthreads(); phase_pool(F); } } SEAM(10);
    if (IN(11)) { FRESH();
        SchedPool S{F.G, F.bid, (const char*)(F.ws + WS_WPOOL)};
        EpiY E{(bf16*)(F.ws + WS_ACT), modp(F, 1, 0, 2), F.a->in[13], (ABL & 4) ? 0.f : 1.f};
        g8::gemm_phase(F.lds, (const char*)(F.ws + WS_XA), 256, S, E);
    } SEAM(11);
    if (IN(12)) { FRESH(); phase_ln_router(F, 1, nullptr, (const bf16*)(F.ws + WS_ACT)); } SEAM(12);
    if (IN(13)) { FRESH();
        moe_table(F, 1); moe_tokl(F);
        SchedMoe S{F.G, F.bid, (const char*)(F.ws + WS_WGU) + (size_t)32 * 1024 * 1024 * 2, (size_t)1024 * 1024 * 2, (size_t)256 * 1024 * 2, (const LAS int*)(F.lds + LDS_TAB_OFF), (const LAS int*)(F.lds + LDS_TOKL_OFF), 1, 2048u};
        EpiAct E{(bf16*)(F.ws + WS_ACT)};
        g8::gemm_phase(F.lds, (const char*)(F.ws + WS_XA), 1024, S, E);
    } SEAM(13);
    if (IN(14)) { FRESH();
        moe_table(F, 1);
        SchedMoe S{F.G, F.bid, (const char*)(F.ws + WS_WDN) + (size_t)32 * 1024 * 512 * 2, (size_t)1024 * 512 * 2, (size_t)256 * 512 * 2, (const LAS int*)(F.lds + LDS_TAB_OFF), (const LAS int*)(F.lds + LDS_TOKL_OFF), 0, 1024u};
        EpiEo E{(bf16*)(F.ws + WS_EO)};
        g8::gemm_phase(F.lds, (const char*)(F.ws + WS_ACT), 512, S, E);
    } SEAM(14);
    if (IN(15)) { FRESH(); phase_combine(F, 1); }
#undef IN
#undef SEAM
}

extern "C" void kernel_launch(void* const* d_in, const int* in_sizes, int n_in, void* d_out, int out_size, void* d_ws, size_t ws_size, hipStream_t stream) {
    static int grid = 0;
    if (grid == 0) {
        if (n_in != 21 || in_sizes[0] != T * D || out_size != T * D || ws_size < WS_END) { fprintf(stderr, "kernel_launch: unexpected shapes (n_in %d, ws %zu); nothing launched\n", n_in, ws_size); grid = -1; return; }
        int dev = 0, cus = 0, per_cu = 0;
        if (hipGetDevice(&dev) != hipSuccess || hipDeviceGetAttribute(&cus, hipDeviceAttributeMultiprocessorCount, dev) != hipSuccess) { grid = -1; return; }
        if (hipFuncSetAttribute((const void*)mk_fwd, hipFuncAttributeMaxDynamicSharedMemorySize, LDS_BYTES) != hipSuccess) { fprintf(stderr, "kernel_launch: hipFuncSetAttribute failed\n"); grid = -1; return; }
        if (hipOccupancyMaxActiveBlocksPerMultiprocessor(&per_cu, (const void*)mk_fwd, 512, LDS_BYTES) != hipSuccess || per_cu < 1) { fprintf(stderr, "kernel_launch: occupancy query reports %d\n", per_cu); }
        (void)hipGetLastError();
        grid = cus;
    }
    if (grid < 0) return;
    if (hipMemsetAsync((char*)d_ws + WS_CTL, 0, CTL_ZERO_BYTES, stream) != hipSuccess) return;
    Args a{};
    for (int i = 0; i < 21; ++i) a.in[i] = (const float*)d_in[i];
    a.out = (float*)d_out; a.ws = (unsigned char*)d_ws;
    if (MK_N_LAUNCHES == 1) { a.ph_lo = 0; a.ph_hi = NPHASE; hipLaunchKernelGGL(mk_fwd, dim3(grid), dim3(512), LDS_BYTES, stream, a); }
    else for (int p = 0; p < NPHASE; ++p) { a.ph_lo = p; a.ph_hi = p + 1; hipLaunchKernelGGL(mk_fwd, dim3(grid), dim3(512), LDS_BYTES, stream, a); }
}
```

```cpp
#include <hip/hip_runtime.h>
#include <cstdio>
#include <cstdint>

#ifndef ABL
#define ABL 0
#endif
#ifndef RPT
#define RPT 0
#endif
#ifndef MK_N_LAUNCHES
#define MK_N_LAUNCHES 1
#endif

#define GAS __attribute__((address_space(1)))
#define LAS __attribute__((address_space(3)))
typedef unsigned short bf16;
typedef short bf16x8 __attribute__((ext_vector_type(8)));
typedef float f32x4 __attribute__((ext_vector_type(4)));
typedef float f32x16 __attribute__((ext_vector_type(16)));
typedef unsigned u32x4 __attribute__((ext_vector_type(4)));
typedef unsigned u32x2 __attribute__((ext_vector_type(2)));

constexpr int D = 1024, NB = 16, SEQ = 2048, T = NB * SEQ, CTXL = 256, TC = NB * CTXL;
constexpr int GRIDW = 64, GROWS = SEQ / GRIDW;
constexpr int OFF_RK = 0, OFF_RV = 512, OFF_NK = 1024, OFF_NV = 1536, KV_COLS = 2048, OFF_RQ = 2048, OFF_RG = 2560, OFF_NQ = 3072, IN_COLS = 3584;
constexpr int NEXP = 32, HID = 512, LISTCAP = T;
constexpr int MAXSLOT = 73728;
constexpr float LN_EPS = 1e-5f;
constexpr float ALPHA = 1.41421356237309515f;
constexpr int NPHASE = 16;

constexpr size_t MiB = 1u << 20;
constexpr size_t WS_CTL = 0, CTL_ZERO_BYTES = 128 * 1024;
constexpr size_t WS_MOD = 1 * MiB;
constexpr size_t WS_TOKINFO = 2 * MiB;
constexpr size_t WS_LIST = 3 * MiB;
constexpr size_t WS_WIN = 8 * MiB, WS_WOUT = 15 * MiB, WS_WPOOL = 17 * MiB, WS_WGU = 18 * MiB, WS_WDN = 146 * MiB;
constexpr size_t WS_XA = 210 * MiB;
constexpr size_t WS_P = 282 * MiB;
constexpr size_t WS_ACT = 282 * MiB, WS_EO = 354 * MiB;
constexpr int TPITCH = SEQ + 64;
constexpr size_t WS_VTR = 446 * MiB, WS_VTRC = 480 * MiB;
constexpr size_t WS_VTN = 484 * MiB, WS_VTNC = 518 * MiB;
constexpr size_t WS_PC = 522 * MiB;
constexpr size_t WS_H16 = 526 * MiB;
constexpr size_t WS_END = 590 * MiB;
constexpr size_t DO_ST = 0;
constexpr size_t DO_KTR = 64 * MiB, DO_KTRC = 98 * MiB;
constexpr int PW = 2624, PO_RK = 0, PO_NK = 512, PO_RQ = 1024, PO_RG = 1536, PO_NQ = 2048, PCW = 512;
static_assert(WS_EO + (size_t)MAXSLOT * 1024 * 2 <= 498 * MiB && WS_ACT + (size_t)MAXSLOT * 512 * 2 <= WS_EO, "ws map");
static_assert(WS_P + (size_t)T * PW * 2 <= WS_VTR && WS_VTR + (size_t)64 * 128 * TPITCH * 2 <= WS_VTRC && WS_VTN + (size_t)128 * 64 * TPITCH * 2 <= WS_VTNC && DO_KTR + (size_t)64 * 128 * TPITCH * 2 <= DO_KTRC && WS_XA + (size_t)(T + TC) * D * 2 <= WS_P, "ws map");
constexpr int CW_BAR = 4096, XCD_BAR_WORDS_C = 3456;
constexpr int CW_CNT = 16384;
static_assert((CW_CNT + 64 * 64) * 4 <= (int)CTL_ZERO_BYTES && (CW_BAR + XCD_BAR_WORDS_C) * 4 <= (int)CTL_ZERO_BYTES, "ctl words inside the memset");

constexpr int RING_BYTES = 131072, LDS_SCR_OFF = RING_BYTES, LDSCTL_OFF = 154112, LDS_TAB_OFF = LDSCTL_OFF + 256, LDS_BYTES = 163840;

__device__ __forceinline__ unsigned f2bf(float f) { unsigned u = __builtin_bit_cast(unsigned, f); return (u + 0x7fffu + ((u >> 16) & 1u)) >> 16; }
__device__ __forceinline__ unsigned pk2(float lo, float hi) { unsigned r; asm("v_cvt_pk_bf16_f32 %0, %1, %2" : "=v"(r) : "v"(lo), "v"(hi)); return r; }
__device__ __forceinline__ bf16x8 pack8(const f32x4& a, const f32x4& b) { const u32x4 w = (u32x4){pk2(a.x, a.y), pk2(a.z, a.w), pk2(b.x, b.y), pk2(b.z, b.w)}; return __builtin_bit_cast(bf16x8, w); }
__device__ __forceinline__ float bf2f(unsigned h) { return __builtin_bit_cast(float, h << 16); }
__device__ __forceinline__ float bflo(unsigned w) { return __builtin_bit_cast(float, w << 16); }
__device__ __forceinline__ float bfhi(unsigned w) { return __builtin_bit_cast(float, w & 0xffff0000u); }
__device__ __forceinline__ float wave_sum(float v) {
    int x = __builtin_bit_cast(int, v);
#define WS_STEP(ctrl, rmask) do { const int t_ = __builtin_amdgcn_update_dpp(0, x, (ctrl), (rmask), 0xF, false); x = __builtin_bit_cast(int, __builtin_bit_cast(float, x) + __builtin_bit_cast(float, t_)); } while (0)
    WS_STEP(0xB1, 0xF);
    WS_STEP(0x4E, 0xF);
    WS_STEP(0x141, 0xF);
    WS_STEP(0x140, 0xF);
    WS_STEP(0x142, 0xA);
    WS_STEP(0x143, 0xC);
#undef WS_STEP
    return __builtin_bit_cast(float, __builtin_amdgcn_readlane(x, 63));
}
__device__ __forceinline__ float frcp(float x) { return __builtin_amdgcn_rcpf(x); }
__device__ __forceinline__ float silu_f(float v) { return v * frcp(1.0f + __expf(-v)); }
__device__ __forceinline__ float fexp2(float x) { return __builtin_amdgcn_exp2f(x); }
#define LDS_WAIT() asm volatile("s_waitcnt lgkmcnt(0)" ::: "memory")

#define XB_TMO      128
#define XB_XCNT(j)  (256  + 64 * (j))
#define XB_XSUB(j)  (1280 + 64 * (j))
#define XB_XGEN(j)  (2304 + 64 * (j))
#define XB_TOP      3328
#define XB_TOPGEN   3392
#define XCD_BAR_WORDS 3456
#define XB_SPIN_CAP (1u << 18)
__device__ __forceinline__ unsigned xb_ld(unsigned* p)              { return __hip_atomic_load(p, __ATOMIC_RELAXED, __HIP_MEMORY_SCOPE_AGENT); }
__device__ __forceinline__ unsigned xb_add(unsigned* p, unsigned v) { return __hip_atomic_fetch_add(p, v, __ATOMIC_RELAXED, __HIP_MEMORY_SCOPE_AGENT); }
__device__ __forceinline__ unsigned xb_xcc_id() { return (unsigned)__builtin_amdgcn_s_getreg((3 << 11) | 20) & 0xFu; }
#define XB_SPIN(cond, bar) do { unsigned _sp = 0; while (cond) { __builtin_amdgcn_s_sleep(1); \
    if ((++_sp & 255u) == 0u) { if (xb_ld(&(bar)[XB_TMO])) break; if (_sp > XB_SPIN_CAP) { atomicAdd(&(bar)[XB_TMO], 1u); break; } } } } while (0)
struct XcdBarrier { unsigned* bar; unsigned x; volatile LAS unsigned* st; };
__device__ __forceinline__ XcdBarrier xcd_barrier_post(unsigned* bar, volatile LAS unsigned* st) {
    XcdBarrier b; b.bar = bar; b.x = xb_xcc_id(); b.st = st;
    if (threadIdx.x == 0) (void)xb_add(&bar[XB_XCNT(b.x)], 1u);
    return b;
}
__device__ __forceinline__ void xcd_barrier_complete(unsigned* bar, unsigned x, unsigned& nloc, unsigned& nx) {
    const unsigned G = gridDim.x * gridDim.y * gridDim.z;
    unsigned sum, cnt, mine, sp = 0u;
    for (;;) {
        sum = 0u; cnt = 0u; mine = 0u;
#pragma unroll
        for (unsigned j = 0; j < 16; ++j) { const unsigned c = xb_ld(&bar[XB_XCNT(j)]); sum += c; cnt += (c > 0u) ? 1u : 0u; mine = (j == x) ? c : mine; }
        if (sum == G) break;
        __builtin_amdgcn_s_sleep(1);
        if ((++sp & 255u) == 0u) { if (xb_ld(&bar[XB_TMO])) break; if (sp > XB_SPIN_CAP) { atomicAdd(&bar[XB_TMO], 1u); break; } }
    }
    nloc = mine > 0u ? mine : 1u; nx = cnt > 0u ? cnt : 1u;
}
__device__ __forceinline__ void xcd_barrier(const XcdBarrier& b) {
    asm volatile("s_waitcnt vmcnt(0)" ::: "memory");
    __syncthreads();
    if (threadIdx.x == 0) {
        unsigned* bar = b.bar;
        __builtin_amdgcn_s_waitcnt(0);
        unsigned nloc = b.st[0], nx = b.st[1];
        if (nloc == 0u) { xcd_barrier_complete(bar, b.x, nloc, nx); b.st[0] = nloc; b.st[1] = nx; }
        const unsigned old = xb_add(&bar[XB_XSUB(b.x)], 1u);
        const unsigned gen = old / nloc;
        if (old + 1u == (gen + 1u) * nloc) {
            __builtin_amdgcn_fence(__ATOMIC_RELEASE, "agent");
            asm volatile("s_waitcnt vmcnt(0)" ::: "memory");
            const unsigned og = xb_add(&bar[XB_TOP], 1u);
            const unsigned tg = og / nx;
            if (og + 1u == (tg + 1u) * nx) xb_add(&bar[XB_TOPGEN], 1u);
            else XB_SPIN(xb_ld(&bar[XB_TOPGEN]) == tg, bar);
            __builtin_amdgcn_fence(__ATOMIC_ACQUIRE, "agent");
            xb_add(&bar[XB_XGEN(b.x)], 1u);
            asm volatile("s_waitcnt vmcnt(0)" ::: "memory");
        } else {
            XB_SPIN(xb_ld(&bar[XB_XGEN(b.x)]) == gen, bar);
            __builtin_amdgcn_fence(__ATOMIC_ACQUIRE, "agent");
            asm volatile("s_waitcnt vmcnt(0)" ::: "memory");
        }
    }
    __syncthreads();
}

struct Args { const float* in[21]; float* out; unsigned char* ws; int ph_lo, ph_hi; };
typedef const __attribute__((address_space(4))) Args* KArgs;
struct Ctx {
    LAS unsigned char* lds;
    int tid, lane, wave, G, bid;
    KArgs a;
    float* H;
    unsigned char* ws;
};
__device__ __forceinline__ const float* modp(const Ctx& F, int l, int row, int part) { return (const float*)(F.ws + WS_MOD) + (size_t)(l * 17 + row) * 6144 + part * 1024; }

namespace g8 {
constexpr int BM = 256, BK = 64, HALF = 128, HTB = HALF * BK * 2, STAGE_BYTES = 8 * HTB;
__device__ __forceinline__ int lds_byte(int r, int c) { const int st = (r >> 4) * 2 + (c >> 5), rr = r & 15, cc = c & 31, ob = rr * 64 + cc * 2; return st * 1024 + (ob ^ (((ob >> 9) & 1) << 5)); }
__device__ __forceinline__ void stage_rc(int b, int& R, int& C) { const int st = b / 1024, sb = b % 1024, swz = sb ^ (((sb >> 9) & 1) << 5); R = (st >> 1) * 16 + swz / 64; C = (st & 1) * 32 + (swz % 64) / 2; }
struct Unit { const char* B; int pm, pn, e, aux; };
__device__ __forceinline__ void tile_of(int L, int nM, int nN, int& pm, int& pn) {
    const int nwg = nM * nN; int wgid = L; { const int q = nwg / 8, r = nwg % 8, xcd = wgid % 8, off = wgid / 8; wgid = (xcd < r ? xcd * (q + 1) : r * (q + 1) + (xcd - r) * q) + off; }
    const int nig = 8 * nN, gid = wgid / nig, fm = gid * 8, gsz = (nM - fm) < 8 ? (nM - fm) : 8;
    pm = fm + ((wgid % nig) % gsz); pn = (wgid % nig) / gsz;
}
template <class Epi, class Sched>
__device__ __forceinline__ void gemm_phase(LAS unsigned char* lds, const char* Abase, const int K, const Sched& S, const Epi& E) {
    const int tid = threadIdx.x, wid = __builtin_amdgcn_readfirstlane(tid >> 6), lane = tid & 63, wr = wid >> 2, wc = wid & 3, fr = lane & 15, fq = lane >> 4;
    const int nt = K / BK;
    int R0, C0, R1, C1; stage_rc(tid * 16, R0, C0); stage_rc(tid * 16 + 8192, R1, C1);
    unsigned voffB[2]; voffB[0] = (unsigned)(R0 * K + C0) * 2u; voffB[1] = (unsigned)(R1 * K + C1) * 2u;
    const unsigned kstep = (unsigned)(BK * 2);
    const size_t hstepB = (size_t)HALF * K * 2;
    const unsigned ldsw = (unsigned)wid * 1024u;
    const int aoff = lds_byte(wr * 64 + fr, fq * 8), boff = lds_byte(wc * 32 + fr, fq * 8);
#define G8_SA(b, h) (((b) * 2 + (h)) * HTB)
#define G8_SB(b, h) ((4 + (b) * 2 + (h)) * HTB)
#define G8_STAGEB(bufoff, gbase) do { _Pragma("unroll") for (int _i = 0; _i < 2; ++_i) \
        __builtin_amdgcn_global_load_lds((const unsigned*)((const char*)(gbase) + voffB[_i]), (LAS unsigned*)(lds + (bufoff) + ldsw + _i * 8192), 16, 0, 0); } while (0)
#define G8_STAGEA(bufoff, offs, h, koff) do { _Pragma("unroll") for (int _i = 0; _i < 2; ++_i) \
        __builtin_amdgcn_global_load_lds((const unsigned*)((Abase + (koff)) + (offs)[h][_i]), (LAS unsigned*)(lds + (bufoff) + ldsw + _i * 8192), 16, 0, 0); } while (0)
#define G8_LDA(dst, b, h) do { _Pragma("unroll") for (int m = 0; m < 4; ++m) _Pragma("unroll") for (int k = 0; k < 2; ++k) dst[m][k] = *(const LAS bf16x8*)(lds + G8_SA(b, h) + aoff + m * 2048 + k * 1024); } while (0)
#define G8_LDB(dst, b, h) do { _Pragma("unroll") for (int n = 0; n < 2; ++n) _Pragma("unroll") for (int k = 0; k < 2; ++k) dst[n][k] = *(const LAS bf16x8*)(lds + G8_SB(b, h) + boff + n * 2048 + k * 1024); } while (0)
#define G8_MMA(ai, bj, At, Bt) do { __builtin_amdgcn_s_setprio(1); _Pragma("unroll") for (int m = 0; m < 4; ++m) _Pragma("unroll") for (int n = 0; n < 2; ++n) _Pragma("unroll") for (int k = 0; k < 2; ++k) \
        acc[ai][bj][m][n] = __builtin_amdgcn_mfma_f32_16x16x32_bf16(Bt[n][k], At[m][k], acc[ai][bj][m][n], 0, 0, 0); __builtin_amdgcn_s_setprio(0); } while (0)
#define G8_WAIT_V(n) asm volatile("s_waitcnt vmcnt(" #n ")" ::: "memory")
#define G8_WAIT_L(n) asm volatile("s_waitcnt lgkmcnt(" #n ")" ::: "memory")
#define G8_BAR __builtin_amdgcn_s_barrier()
#define G8_SCHED __builtin_amdgcn_sched_barrier(0)
    Unit cur, nxt; int ui = 0;
    if (!S.next(0, cur)) return;
    f32x4 acc[2][2][4][2];
#pragma unroll
    for (int a = 0; a < 2; ++a)
#pragma unroll
        for (int b = 0; b < 2; ++b)
#pragma unroll
            for (int m = 0; m < 4; ++m)
#pragma unroll
                for (int n = 0; n < 2; ++n) acc[a][b][m][n] = (f32x4){0.f, 0.f, 0.f, 0.f};
    bf16x8 At[4][2], B0[2][2], B1[2][2];
    unsigned ac[2][2];
    ac[0][0] = S.rowoff(cur, R0) + (unsigned)C0 * 2u; ac[0][1] = S.rowoff(cur, R1) + (unsigned)C1 * 2u;
    ac[1][0] = S.rowoff(cur, HALF + R0) + (unsigned)C0 * 2u; ac[1][1] = S.rowoff(cur, HALF + R1) + (unsigned)C1 * 2u;
    const char* cB = cur.B;
    G8_STAGEB(G8_SB(0, 0), cB); G8_STAGEB(G8_SB(0, 1), cB + hstepB); G8_STAGEA(G8_SA(0, 0), ac, 0, 0); G8_STAGEA(G8_SA(0, 1), ac, 1, 0);
    if (wr == 1) G8_BAR;
    G8_WAIT_V(2); G8_BAR;
    G8_STAGEB(G8_SB(1, 0), cB + kstep); G8_STAGEA(G8_SA(1, 0), ac, 0, kstep); G8_STAGEB(G8_SB(1, 1), cB + hstepB + kstep);
    G8_WAIT_V(6); G8_BAR;
    for (;;) {
        const bool has_next = S.next(ui + 1, nxt);
        const char* nB = has_next ? nxt.B : cB;
#pragma unroll 1
        for (int t = 0; t < nt; t += 2) {
            const bool last = (t == nt - 2);
            const unsigned k1 = (unsigned)(t + 1) * kstep;
            const unsigned k2 = last ? 0u : (unsigned)(t + 2) * kstep;
            const unsigned k3 = k2 + kstep;
            const char* b2 = last ? nB : cB + k2; const char* b3 = b2 + kstep;
            G8_LDB(B0, 0, 0); G8_LDB(B1, 0, 1); G8_SCHED; G8_LDA(At, 0, 0); G8_STAGEA(G8_SA(1, 1), ac, 1, k1);
            if (last && has_next) {
                ac[0][0] = S.rowoff(nxt, R0) + (unsigned)C0 * 2u; ac[0][1] = S.rowoff(nxt, R1) + (unsigned)C1 * 2u;
                ac[1][0] = S.rowoff(nxt, HALF + R0) + (unsigned)C0 * 2u; ac[1][1] = S.rowoff(nxt, HALF + R1) + (unsigned)C1 * 2u;
            }
            G8_WAIT_V(8); G8_WAIT_L(0); G8_BAR; G8_MMA(0, 0, At, B0); G8_MMA(0, 1, At, B1); G8_BAR; G8_SCHED;
            G8_LDA(At, 0, 1); G8_STAGEB(G8_SB(0, 0), b2); G8_STAGEB(G8_SB(0, 1), b2 + hstepB); G8_STAGEA(G8_SA(0, 0), ac, 0, k2);
            G8_WAIT_V(8); G8_WAIT_L(0); G8_BAR; G8_MMA(1, 0, At, B0); G8_MMA(1, 1, At, B1); G8_BAR; G8_SCHED;
            G8_LDB(B0, 1, 0); G8_LDB(B1, 1, 1); G8_SCHED; G8_LDA(At, 1, 0); G8_STAGEA(G8_SA(0, 1), ac, 1, k2);
            G8_WAIT_V(8); G8_WAIT_L(0); G8_BAR; G8_MMA(0, 0, At, B0); G8_MMA(0, 1, At, B1); G8_BAR; G8_SCHED;
            G8_LDA(At, 1, 1); G8_STAGEB(G8_SB(1, 0), b3); G8_STAGEB(G8_SB(1, 1), b3 + hstepB); G8_STAGEA(G8_SA(1, 0), ac, 0, k3);
            G8_WAIT_V(8); G8_WAIT_L(0); G8_BAR; G8_MMA(1, 0, At, B0); G8_MMA(1, 1, At, B1); G8_BAR; G8_SCHED;
        }
        if (wr == 0) G8_BAR;
        E(acc, cur, wr, wc, fr, fq);
        if (!has_next) break;
#pragma unroll
        for (int a = 0; a < 2; ++a)
#pragma unroll
            for (int b = 0; b < 2; ++b)
#pragma unroll
                for (int m = 0; m < 4; ++m)
#pragma unroll
                    for (int n = 0; n < 2; ++n) acc[a][b][m][n] = (f32x4){0.f, 0.f, 0.f, 0.f};
        cur = nxt; cB = nB; ++ui;
        if (wr == 1) G8_BAR;
    }
    G8_WAIT_V(0);
    G8_BAR;
#undef G8_SA
#undef G8_SB
#undef G8_STAGEA
#undef G8_STAGEB
#undef G8_LDA
#undef G8_LDB
#undef G8_MMA
#undef G8_WAIT_V
#undef G8_WAIT_L
#undef G8_BAR
#undef G8_SCHED
}
}

struct CvDesc { const float* W; bf16* WT; int ldw, ldo, k0, n0, kind, aux; };
struct RmId   { __device__ __forceinline__ int operator()(int n) const { return n; } };
struct RmGate { int up; __device__ __forceinline__ int operator()(int h) const { return 256 * (h >> 7) + 128 * ((h >> 2) & 1) + 32 * ((h >> 5) & 3) + 16 * up + 4 * ((h >> 3) & 3) + (h & 3); } };
struct RmPerm { __device__ __forceinline__ int operator()(int c) const { const int q = c & 31; return (c & ~31) + 16 * ((q >> 2) & 1) + 4 * (q >> 3) + (q & 3); } };
struct RmIn   { __device__ __forceinline__ int operator()(int n) const {
    const bool rope = (n < 512) || (n >= OFF_RQ && n < OFF_RQ + 512);
    const bool tokmaj = (n >= OFF_NK && n < OFF_NV) || (n >= OFF_RG);
    const int d = n & 127; return rope ? ((n & ~127) + 32 * ((d >> 4) & 3) + 16 * (d >> 6) + (d & 15)) : (tokmaj ? RmPerm{}(n) : n); } };

__device__ __forceinline__ int cv_rowmap(const CvDesc& d, int n) { return d.kind == 1 ? RmGate{d.aux}(n) : (d.kind == 2 ? RmPerm{}(n) : (d.kind == 3 ? RmIn{}(n) : n)); }
__device__ __forceinline__ void cv_load(const CvDesc& d, int lane, float (&buf)[32]) {
    const float* p = d.W + (size_t)(d.k0 + (lane >> 5)) * d.ldw + d.n0 + (lane & 31);
#pragma unroll
    for (int i = 0; i < 32; ++i) buf[i] = __builtin_nontemporal_load(p + (size_t)(2 * i) * d.ldw);
}
__device__ __forceinline__ void cv_store(const CvDesc& d, int lane, const float (&buf)[32], LAS float* scr) {
#pragma unroll
    for (int i = 0; i < 32; ++i) scr[(2 * i + (lane >> 5)) * 33 + (lane & 31)] = buf[i];
    LDS_WAIT(); asm volatile("" ::: "memory");
    const int c = lane & 7;
#pragma unroll
    for (int j = 0; j < 4; ++j) { const int n = (lane >> 3) + 8 * j; const LAS float* sp = scr + (8 * c) * 33 + n;
        u32x4 o; o.x = pk2(sp[0 * 33], sp[1 * 33]); o.y = pk2(sp[2 * 33], sp[3 * 33]); o.z = pk2(sp[4 * 33], sp[5 * 33]); o.w = pk2(sp[6 * 33], sp[7 * 33]);
        *(u32x4*)(d.WT + (size_t)cv_rowmap(d, d.n0 + n) * d.ldo + d.k0 + 8 * c) = o; }
    LDS_WAIT(); asm volatile("" ::: "memory");
}
constexpr int I_E1 = 3 * 32 * 256;
__device__ __forceinline__ CvDesc cv_expert(const Ctx& F, int l, int q) {
    const int mat = q >> 13, r = q & 8191, le = l * 32 + (r >> 8), w = r & 255; CvDesc d;
    if (mat < 2) { d.W = (mat ? F.a->in[19] : F.a->in[18]) + (size_t)le * 1024 * 512; d.ldw = 512; d.WT = (bf16*)(F.ws + WS_WGU) + (size_t)le * 1024 * 1024; d.ldo = 1024; d.kind = 1; d.aux = mat; d.k0 = 64 * (w >> 4); d.n0 = 32 * (w & 15); }
    else { d.W = F.a->in[20] + (size_t)le * 512 * 1024; d.ldw = 1024; d.WT = (bf16*)(F.ws + WS_WDN) + (size_t)le * 1024 * 512; d.ldo = 512; d.kind = 2; d.aux = 0; d.k0 = 64 * (w >> 5); d.n0 = 32 * (w & 31); }
    return d;
}
constexpr int I_IN = 16 * 112, I_OUT = 16 * 32, I_POOL = 4 * 32;
__device__ __forceinline__ CvDesc cv_phase0(const Ctx& F, int r, int nexp) {
    if (r < nexp) return cv_expert(F, r < I_E1 ? 0 : 1, r < I_E1 ? r : r - I_E1);
    r -= nexp; CvDesc d; d.aux = 0;
    if (r < I_IN) { d.W = F.a->in[8]; d.ldw = IN_COLS; d.WT = (bf16*)(F.ws + WS_WIN); d.ldo = 1024; d.kind = 3; d.k0 = 64 * (r / 112); d.n0 = 32 * (r % 112); return d; }
    r -= I_IN;
    if (r < I_OUT) { d.W = F.a->in[9]; d.ldw = 1024; d.WT = (bf16*)(F.ws + WS_WOUT); d.ldo = 1024; d.kind = 2; d.k0 = 64 * (r >> 5); d.n0 = 32 * (r & 31); return d; }
    r -= I_OUT;
    { const int g = r >> 5, q = r & 31; d.W = F.a->in[12] + (size_t)g * 65536; d.ldw = 256; d.WT = (bf16*)(F.ws + WS_WPOOL) + (size_t)g * 65536; d.ldo = 256; d.kind = 2; d.k0 = 64 * (q >> 3); d.n0 = 32 * (q & 7); return d; }
}
#define CV_RUN(first, end, stride, GEN) do { float bA_[32], bB_[32]; const int end_ = (end), st_ = (stride); \
    for (int it_ = (first); it_ < end_; it_ += 2 * st_) { const bool h1_ = it_ + st_ < end_; \
        const CvDesc dA_ = GEN(it_); const CvDesc dB_ = GEN(h1_ ? it_ + st_ : it_); \
        cv_load(dA_, F.lane, bA_); cv_load(dB_, F.lane, bB_);     \
        cv_store(dA_, F.lane, bA_, scr); if (h1_) cv_store(dB_, F.lane, bB_, scr); } } while (0)
__device__ __forceinline__ void phase0(const Ctx& F) {
    LAS float* sil = (LAS float*)F.lds;
    LAS float* red = (LAS float*)(F.lds + 17 * 1024 * 4);
    float* mod = (float*)(F.ws + WS_MOD);
    for (int it = F.bid; it < 192; it += F.G) {
        const int l = it / 96, col0 = (it % 96) * 64;
        for (int idx = F.tid; idx < 17 * 1024; idx += 512) { const int r = idx >> 10, k = idx & 1023; const float v = r < 16 ? F.a->in[1][r * 1024 + k] : F.a->in[3][k]; sil[idx] = silu_f(v); }
        __syncthreads();
        float a[17];
#pragma unroll
        for (int r = 0; r < 17; ++r) a[r] = 0.f;
        const int k0 = F.wave * 128;
        const float* wp = F.a->in[4] + ((size_t)l * 1024 + k0) * 6144 + col0 + F.lane;
#pragma unroll 4
        for (int kk = 0; kk < 128; ++kk) { const float w = wp[(size_t)kk * 6144];
#pragma unroll
            for (int r = 0; r < 17; ++r) a[r] += sil[r * 1024 + k0 + kk] * w; }
#pragma unroll
        for (int r = 0; r < 17; ++r) red[(F.wave * 17 + r) * 64 + F.lane] = a[r];
        __syncthreads();
        for (int idx = F.tid; idx < 17 * 64; idx += 512) { const int r = idx >> 6, cc = idx & 63; float s = F.a->in[5][l * 6144 + col0 + cc];
#pragma unroll
            for (int w8 = 0; w8 < 8; ++w8) s += red[(w8 * 17 + r) * 64 + cc];
            mod[(size_t)(l * 17 + r) * 6144 + col0 + cc] = s; }
        __syncthreads();
    }
    __syncthreads();
    LAS float* scr = (LAS float*)(F.lds + F.wave * 16384);
    const int gw = F.bid * 8 + F.wave, NGW = F.G * 8;
    const int nexp_items = (F.G == 256) ? I_E1 : 2 * I_E1;
    const int NITEMS = nexp_items + I_IN + I_OUT + I_POOL;
#define CV_GEN0(i_) cv_phase0(F, (i_), nexp_items)
    CV_RUN(gw, NITEMS, NGW, CV_GEN0);
#undef CV_GEN0
}
__device__ __forceinline__ void convert_tail(const Ctx& F, int vc, int first, int lo, int hi) {
    if (F.G != 256) return;
    if (first >= F.G) first = 0;
    if (vc < first) return;
    LAS float* scr = (LAS float*)(F.lds + F.wave * 16384);
    const int nw = (F.G - first) * 8;
#define CV_GEN1(i_) cv_expert(F, 1, (i_))
    CV_RUN(lo + (vc - first) * 8 + F.wave, hi, nw, CV_GEN1);
#undef CV_GEN1
}

__device__ __forceinline__ void p1_load(const Ctx& F, int row, f32x4 (&b)[4]) {
    const float* src = row < T ? F.a->in[0] + (size_t)row * D : F.a->in[2] + (size_t)(row - T) * D;
#pragma unroll
    for (int j = 0; j < 4; ++j) b[j] = *(const f32x4*)(src + 4 * F.lane + 256 * j);
}
__device__ __forceinline__ void p1_row(const Ctx& F, int row, const f32x4 (&v)[4], const f32x4 (&sh)[4], const f32x4 (&sc)[4]) {
    unsigned long long* o8 = (unsigned long long*)((bf16*)(F.ws + WS_XA) + (size_t)row * D) + F.lane;
#pragma unroll
    for (int j = 0; j < 4; ++j) { const f32x4 y = v[j] * sc[j] + sh[j];
        o8[64 * j] = (unsigned long long)pk2(y.x, y.y) | ((unsigned long long)pk2(y.z, y.w) << 32); }
}
__device__ __forceinline__ void phase1(const Ctx& F) {
    const int gw = F.bid * 8 + F.wave, NGW = F.G * 8;
    for (int run = gw; run < T / 16; run += NGW) {
        const int tb = run * 16, cb0 = T + run * 2, b = tb >> 11;
        f32x4 A[4], B[4], C[4], E[4], sh[4], sc[4], sh2[4], sc2[4];
#pragma unroll
        for (int j = 0; j < 4; ++j) { sh[j] = *(const f32x4*)(modp(F, 0, b, 0) + 4 * F.lane + 256 * j); sc[j] = *(const f32x4*)(modp(F, 0, b, 1) + 4 * F.lane + 256 * j) + 1.0f;
            sh2[j] = *(const f32x4*)(modp(F, 0, 16, 0) + 4 * F.lane + 256 * j); sc2[j] = *(const f32x4*)(modp(F, 0, 16, 1) + 4 * F.lane + 256 * j) + 1.0f; }
#define P1_ROWOF(i_) ((i_) < 16 ? tb + (i_) : cb0 + min((i_) - 16, 1))
        p1_load(F, tb, A); p1_load(F, tb + 1, B); p1_load(F, tb + 2, C);
#pragma unroll
        for (int k = 0; k < 16; k += 4) {
            p1_load(F, tb + k + 3, E);
            asm volatile("" ::: "memory"); __builtin_amdgcn_sched_barrier(0);
            p1_row(F, tb + k, A, sh, sc);
            p1_load(F, P1_ROWOF(k + 4), A);
            asm volatile("" ::: "memory"); __builtin_amdgcn_sched_barrier(0);
            p1_row(F, tb + k + 1, B, sh, sc);
            p1_load(F, P1_ROWOF(k + 5), B);
            asm volatile("" ::: "memory"); __builtin_amdgcn_sched_barrier(0);
            p1_row(F, tb + k + 2, C, sh, sc);
            p1_load(F, P1_ROWOF(k + 6), C);
            asm volatile("" ::: "memory"); __builtin_amdgcn_sched_barrier(0);
            p1_row(F, tb + k + 3, E, sh, sc);
        }
#undef P1_ROWOF
        p1_row(F, cb0, A, sh2, sc2);
        p1_row(F, cb0 + 1, B, sh2, sc2);
    }
}

struct SchedIn {
    int G, c; const char* Wt;
    __device__ __forceinline__ bool next(int i, g8::Unit& u) const {
        const int L = i * G + c; if (L >= 1792 + 128) return false;
        int pm, pn; if (L < 1792) g8::tile_of(L, 128, 14, pm, pn); else { g8::tile_of(L - 1792, 16, 8, pm, pn); pm += 128; }
        u.pm = pm; u.pn = pn; u.e = 0; u.aux = 0; u.B = Wt + (size_t)pn * 256 * 1024 * 2; return true; }
    __device__ __forceinline__ unsigned rowoff(const g8::Unit& u, int r) const { return (unsigned)(u.pm * 256 + r) * 2048u; }
};
struct EpiIn {
    unsigned char* ws; unsigned char* dout; LAS unsigned char* lds;
    __device__ __forceinline__ void tstore(const f32x4 (&v)[4], LAS bf16* scr, bf16* dst0, size_t colpitch, int lane, int fr, int fq) const {
#pragma unroll
        for (int m = 0; m < 4; ++m)
#pragma unroll
            for (int j = 0; j < 4; j += 2) { const unsigned w = pk2(v[m][j], v[m][j + 1]); scr[(4 * fq + j) * 72 + 16 * m + fr] = (bf16)(w & 0xffffu); scr[(4 * fq + j + 1) * 72 + 16 * m + fr] = (bf16)(w >> 16); }
        LDS_WAIT(); asm volatile("" ::: "memory");
#pragma unroll
        for (int i = 0; i < 2; ++i) { const int q = lane + 64 * i, cc = q >> 3, ch = q & 7;
            const u32x4 w = *(const LAS u32x4*)(scr + cc * 72 + ch * 8);
            *(u32x4*)(dst0 + (size_t)cc * colpitch + ch * 8) = w; }
        LDS_WAIT(); asm volatile("" ::: "memory");
    }
    __device__ __forceinline__ void operator()(const f32x4 (&acc)[2][2][4][2], const g8::Unit& u, int wr, int wc, int fr, int fq) const {
        const bool isctx = u.pm >= 128;
        const int lane = fr + 16 * fq, wid = wr * 4 + wc;
        LAS bf16* scr = (LAS bf16*)(lds + LDS_SCR_OFF + wid * 2304);
        const int row0 = u.pm * 256 + wr * 64 + fr;
        const int bb = isctx ? (u.pm - 128) : (u.pm >> 3);
        const int tt0 = isctx ? 0 : ((u.pm & 7) * 256);
        const size_t tp = isctx ? CTXL : TPITCH;
        const int pn = u.pn;
        if (pn < 2 || pn == 8 || pn == 9) {
            const float scale = (pn >= 8) ? 0.08838834764831845f : 1.0f;
            const int dd = 16 * wc + 4 * fq;
            f32x4 invf;
#pragma unroll
            for (int j = 0; j < 4; ++j) invf[j] = fexp2(-(float)((dd & 31) + j) * (13.287712379549449f / 32.0f));
#pragma unroll
            for (int ai = 0; ai < 2; ++ai)
#pragma unroll
                for (int bj = 0; bj < 2; ++bj) {
                    f32x4 o1[4], o2[4];
#pragma unroll
                    for (int m = 0; m < 4; ++m) { const int row = row0 + ai * 128 + m * 16;
                        f32x4 cs = (f32x4){1.f, 1.f, 1.f, 1.f}, sn = (f32x4){0.f, 0.f, 0.f, 0.f};
                        if (!isctx) { const float pos = (float)((wc < 2) ? (4 * (u.pm & 7) + wr + 2 * ai) : (fr + 16 * m));
#pragma unroll
                            for (int j = 0; j < 4; ++j) { const float ang = pos * invf[j]; cs[j] = __cosf(ang); sn[j] = __sinf(ang); } }
                        const f32x4 x1 = acc[ai][bj][m][0], x2 = acc[ai][bj][m][1];
                        o1[m] = (x1 * cs - x2 * sn) * scale; o2[m] = (x1 * sn + x2 * cs) * scale;
                        if (!isctx) { bf16* rp = (bf16*)(ws + WS_P) + (size_t)row * PW + (pn < 2 ? PO_RK + pn * 256 : PO_RQ + (pn - 8) * 256) + bj * 128 + dd;
                            *(u32x2*)(rp) = (u32x2){pk2(o1[m].x, o1[m].y), pk2(o1[m].z, o1[m].w)};
                            *(u32x2*)(rp + 64) = (u32x2){pk2(o2[m].x, o2[m].y), pk2(o2[m].z, o2[m].w)}; } }
                    if (pn < 2) {
                        const int head = pn * 2 + bj;
                        bf16* d0 = (bf16*)(dout + (isctx ? DO_KTRC : DO_KTR)) + ((size_t)(bb * 4 + head) * 128 + 16 * wc) * tp + tt0 + ai * 128 + wr * 64;
                        tstore(o1, scr, d0, tp, lane, fr, fq);
                        tstore(o2, scr, d0 + (size_t)64 * tp, tp, lane, fr, fq);
                    }
                }
        } else if (pn == 2 || pn == 3 || pn == 6 || pn == 7) {
#pragma unroll
            for (int ai = 0; ai < 2; ++ai)
#pragma unroll
                for (int bj = 0; bj < 2; ++bj)
#pragma unroll
                    for (int n = 0; n < 2; ++n) {
                        const int col = (pn & 1) * 256 + bj * 128 + wc * 32 + n * 16;
                        const size_t boff = (pn < 4) ? (isctx ? WS_VTRC : WS_VTR) : (isctx ? WS_VTNC : WS_VTN);
                        const size_t roff = (pn < 4) ? ((size_t)(bb * 4 + (col >> 7)) * 128 + (col & 127)) : ((size_t)(bb * 8 + (col >> 6)) * 64 + (col & 63));
                        bf16* d0 = (bf16*)(ws + boff) + roff * tp;
                        f32x4 v[4];
#pragma unroll
                        for (int m = 0; m < 4; ++m) v[m] = acc[ai][bj][m][n];
                        tstore(v, scr, d0 + tt0 + ai * 128 + wr * 64, tp, lane, fr, fq);
                    }
        } else {
            const float scale = (pn >= 12) ? 0.125f * 1.4426950408889634f : 1.0f;
            int ld = PW, c0; size_t boff = WS_P;
            if (pn < 6) { if (isctx) { boff = WS_PC; ld = PCW; } c0 = (isctx ? 0 : PO_NK) + (pn - 4) * 256; }
            else if (pn < 12) { c0 = PO_RG + (pn - 10) * 256; }
            else { c0 = PO_NQ + (pn - 12) * 256; }
            bf16* base = (bf16*)(ws + boff);
            const int rsub = isctx ? T : 0;
            const int col0 = c0 + wc * 32 + 8 * fq;
#pragma unroll
            for (int ai = 0; ai < 2; ++ai)
#pragma unroll
                for (int m = 0; m < 4; ++m) { bf16* rp = base + (size_t)(row0 + ai * 128 + m * 16 - rsub) * ld + col0;
#pragma unroll
                    for (int bj = 0; bj < 2; ++bj) { const f32x4 v0 = acc[ai][bj][m][0] * scale, v1 = acc[ai][bj][m][1] * scale;
                        *(u32x4*)(rp + bj * 128) = (u32x4){pk2(v0.x, v0.y), pk2(v0.z, v0.w), pk2(v1.x, v1.y), pk2(v1.z, v1.w)}; } }
        }
    }
};

__device__ __forceinline__ void dma16(const void* g, LAS unsigned char* l) { __builtin_amdgcn_global_load_lds((const unsigned*)g, (LAS unsigned*)l, 16, 0, 0); }
__device__ __forceinline__ bf16x8 frag256(const LAS unsigned char* tile, int row, int chunk) { return *(const LAS bf16x8*)(tile + row * 256 + ((chunk ^ (row & 15)) << 4)); }
__device__ __forceinline__ void phase3(const Ctx& F) {
    const bf16* KTr = (const bf16*)((const char*)F.H + DO_KTR); const bf16* KTrc = (const bf16*)((const char*)F.H + DO_KTRC);
    const bf16* VTr = (const bf16*)(F.ws + WS_VTR); const bf16* VTrc = (const bf16*)(F.ws + WS_VTRC);
    bf16* ST = (bf16*)((char*)F.H + DO_ST);
    const int lane = F.lane, r = lane & 31, hh = lane >> 5, dkt = F.wave & 3, dvs = F.wave >> 2, w = F.wave;
    for (int u0 = F.bid; u0 < 256; u0 += F.G) {
        const int unit = (F.G == 256) ? ((u0 & 7) * 32 + (u0 >> 3)) : u0;
        const int bh = unit >> 2, dvh = (unit >> 1) & 1, dir = unit & 1, h = bh & 3;
        const float lg2 = __log2f(1.0f - __expf(F.a->in[10][dir * 4 + h]));
        const float gstep = fexp2(dir == 0 ? -lg2 : lg2);
        const float cdec = fexp2(lg2 * 128.0f);
        f32x16 acc;
#pragma unroll
        for (int i = 0; i < 16; ++i) acc[i] = 0.f;
        __syncthreads();
#define P3_STAGE(s_) do { const int s__ = (s_); const bool cx = s__ < 2; const int ci = cx ? (dir == 0 ? s__ : 1 - s__) : (dir == 0 ? s__ - 2 : 17 - s__); \
            const bf16* kb = cx ? KTrc + (size_t)bh * 128 * CTXL + ci * 128 : KTr + (size_t)bh * 128 * TPITCH + ci * 128; \
            const bf16* vb = cx ? VTrc + ((size_t)bh * 128 + dvh * 64) * CTXL + ci * 128 : VTr + ((size_t)bh * 128 + dvh * 64) * TPITCH + ci * 128; \
            const size_t pitch = cx ? (size_t)CTXL : (size_t)TPITCH; \
            _Pragma("unroll") for (int i = 0; i < 6; ++i) { const int idx = (i < 4 ? i : i - 4) * 512 + w * 64 + lane, R = idx >> 4, cc = (idx & 15) ^ (R & 15); \
                dma16((i < 4 ? kb : vb) + (size_t)R * pitch + 8 * cc, F.lds + (s__ % 3) * 49152 + (i * 512 + w * 64) * 16); } } while (0)
        P3_STAGE(0); P3_STAGE(1);
#pragma unroll 1
        for (int s = 0; s < 18; ++s) {
            if (s >= 2) {
                const int c = dir == 0 ? s - 2 : 17 - s;
                bf16* sp = ST + ((((size_t)dir * 64 + bh) * 16 + c) * 128 + dvh * 64 + dvs * 32 + r) * 128 + dkt * 32 + 4 * hh;
#pragma unroll
                for (int g = 0; g < 4; ++g) *(u32x2*)(sp + 8 * g) = (u32x2){pk2(acc[4 * g], acc[4 * g + 1]), pk2(acc[4 * g + 2], acc[4 * g + 3])};
            }
            if (s < 2) asm volatile("s_waitcnt vmcnt(6)" ::: "memory"); else if (s < 17) asm volatile("s_waitcnt vmcnt(10)" ::: "memory"); else asm volatile("s_waitcnt vmcnt(0)" ::: "memory");
            __builtin_amdgcn_s_barrier(); asm volatile("" ::: "memory");
            if (s < 16) P3_STAGE(s + 2);
            if (s < 17) {
#pragma unroll
                for (int i = 0; i < 16; ++i) acc[i] *= cdec;
                const LAS unsigned char* kt = F.lds + (s % 3) * 49152; const LAS unsigned char* vt = kt + 32768;
#pragma unroll
                for (int ks = 0; ks < 8; ++ks) {
                    const bf16x8 af = frag256(kt, 32 * dkt + r, 2 * ks + hh); const bf16x8 vv = frag256(vt, 32 * dvs + r, 2 * ks + hh); bf16x8 bfr;
                    const int tk = 16 * ks + 8 * hh; float wgt = fexp2(lg2 * (float)(dir == 0 ? (127 - tk) : tk));
                    float wv8[8];
#pragma unroll
                    for (int j = 0; j < 8; ++j) { wv8[j] = bf2f((unsigned short)vv[j]) * wgt; wgt *= gstep; }
                    bfr = pack8((f32x4){wv8[0], wv8[1], wv8[2], wv8[3]}, (f32x4){wv8[4], wv8[5], wv8[6], wv8[7]});
                    acc = __builtin_amdgcn_mfma_f32_32x32x16_bf16(af, bfr, acc, 0, 0, 0);
                }
            }
        }
        asm volatile("s_waitcnt vmcnt(0) lgkmcnt(0)" ::: "memory");
        __syncthreads();
#undef P3_STAGE
    }
}

__device__ __forceinline__ void ret_unit(const Ctx& F, int unit) {
    const bf16* P = (const bf16*)(F.ws + WS_P); const bf16* ST = (const bf16*)((const char*)F.H + DO_ST); const bf16* VTr = (const bf16*)(F.ws + WS_VTR); bf16* Y = (bf16*)(F.ws + WS_XA);
    int lane = F.lane; asm volatile("" : "+v"(lane));
    const int li = lane & 15, kq = lane >> 4, w = F.wave;
    const int b = unit >> 6, h = (unit >> 4) & 3, c = unit & 15, bh = b * 4 + h;
    const size_t tok0 = (size_t)b * SEQ + c * 128;
    const int i0 = 16 * w;
    const float lgf = __log2f(1.0f - __expf(F.a->in[10][h])), lgb = __log2f(1.0f - __expf(F.a->in[10][4 + h]));
    constexpr int T_ST0 = 0, T_K = 65536, T_V = 98304;
    __syncthreads();
#pragma unroll
    for (int i = 0; i < 16; ++i) { const int tile = i >> 2; const int idx = (i & 3) * 512 + w * 64 + lane, R = idx >> 4, cc = (idx & 15) ^ (R & 15);
        const bf16* src;
        if (tile < 2) src = ST + ((((size_t)tile * 64 + bh) * 16 + c) * 128 + R) * 128 + 8 * cc;
        else if (tile == 2) src = P + (tok0 + R) * PW + PO_RK + h * 128 + 8 * cc;
        else src = VTr + ((size_t)bh * 128 + R) * TPITCH + c * 128 + 8 * cc;
        dma16(src, F.lds + (i * 512 + w * 64) * 16); }
    bf16x8 qf[4];
    { const bf16* qp = P + (tok0 + i0 + li) * PW + PO_RQ + h * 128 + 8 * kq;
#pragma unroll
      for (int ks = 0; ks < 4; ++ks) qf[ks] = *(const bf16x8*)(qp + 32 * ks); }
    asm volatile("s_waitcnt vmcnt(0)" ::: "memory");
    __syncthreads();
    f32x4 O[8];
#pragma unroll
    for (int dirn = 0; dirn < 2; ++dirn) {
        const LAS unsigned char* tl = F.lds + T_ST0 + dirn * 32768;
        float rs[4];
#pragma unroll
        for (int jj = 0; jj < 4; ++jj) { const int i = i0 + 4 * kq + jj; rs[jj] = dirn == 0 ? fexp2(lgf * (float)(i + 1)) : fexp2(lgb * (float)(128 - i)); }
#pragma unroll
        for (int nt = 0; nt < 8; ++nt) { f32x4 a = (f32x4){0.f, 0.f, 0.f, 0.f};
#pragma unroll
            for (int ks = 0; ks < 4; ++ks) a = __builtin_amdgcn_mfma_f32_16x16x32_bf16(qf[ks], frag256(tl, 16 * nt + li, 4 * ks + kq), a, 0, 0, 0);
#pragma unroll
            for (int jj = 0; jj < 4; ++jj) { const float v = a[jj] * rs[jj]; if (dirn == 0) O[nt][jj] = v; else O[nt][jj] += v; } }
    }
    bf16x8 pf[4];
    const int krow = 8 * (li >> 2) + (li & 3);
#pragma unroll
    for (int u = 0; u < 4; ++u) {
        f32x4 s2[2];
#pragma unroll
        for (int hf = 0; hf < 2; ++hf) { f32x4 a = (f32x4){0.f, 0.f, 0.f, 0.f};
#pragma unroll
            for (int ks = 0; ks < 4; ++ks) a = __builtin_amdgcn_mfma_f32_16x16x32_bf16(frag256(F.lds + T_K, 32 * u + krow + 4 * hf, 4 * ks + kq), qf[ks], a, 0, 0, 0);
#pragma unroll
            for (int jj = 0; jj < 4; ++jj) { const int dlt = (i0 + li) - (32 * u + 8 * kq + 4 * hf + jj);
                const float ex = fexp2((dlt > 0 ? lgf : lgb) * fabsf((float)dlt));
                a[jj] *= (dlt == 0) ? 2.0f : ex; }
            s2[hf] = a; }
        pf[u] = pack8(s2[0], s2[1]);
    }
#pragma unroll
    for (int u = 0; u < 4; ++u)
#pragma unroll
        for (int nt = 0; nt < 8; ++nt) O[nt] = __builtin_amdgcn_mfma_f32_16x16x32_bf16(pf[u], frag256(F.lds + T_V, 16 * nt + li, 4 * u + kq), O[nt], 0, 0, 0);
    __syncthreads();
    LAS float* osc = (LAS float*)(F.lds + w * 8448);
#pragma unroll
    for (int jj = 0; jj < 4; ++jj) {
        float sm = 0.f;
#pragma unroll
        for (int nt = 0; nt < 8; ++nt) sm += O[nt][jj];
        sm += __shfl_xor(sm, 1); sm += __shfl_xor(sm, 2); sm += __shfl_xor(sm, 4); sm += __shfl_xor(sm, 8);
        const float mean = sm * (1.0f / 128.0f); float q = 0.f;
#pragma unroll
        for (int nt = 0; nt < 8; ++nt) { const float d = O[nt][jj] - mean; q += d * d; }
        q += __shfl_xor(q, 1); q += __shfl_xor(q, 2); q += __shfl_xor(q, 4); q += __shfl_xor(q, 8);
        const float rstd = __builtin_amdgcn_rsqf(q * (1.0f / 128.0f) + LN_EPS);
#pragma unroll
        for (int nt = 0; nt < 8; ++nt) osc[(4 * kq + jj) * 132 + 16 * nt + li] = (O[nt][jj] - mean) * rstd;
    }
    LDS_WAIT(); asm volatile("" ::: "memory");
#pragma unroll
    for (int i = 0; i < 4; ++i) { const int q = lane + 64 * i, row = q >> 4, ch = q & 15; const size_t tk = tok0 + i0 + row;
        const f32x4 a = *(const LAS f32x4*)(osc + row * 132 + 8 * ch), c2 = *(const LAS f32x4*)(osc + row * 132 + 8 * ch + 4);
        const u32x4 g = *(const u32x4*)(P + tk * PW + PO_RG + h * 128 + 8 * ch);
        u32x4 o;
        o.x = pk2(silu_f(bflo(g.x)) * a.x, silu_f(bfhi(g.x)) * a.y); o.y = pk2(silu_f(bflo(g.y)) * a.z, silu_f(bfhi(g.y)) * a.w);
        o.z = pk2(silu_f(bflo(g.z)) * c2.x, silu_f(bfhi(g.z)) * c2.y); o.w = pk2(silu_f(bflo(g.w)) * c2.z, silu_f(bfhi(g.w)) * c2.w);
        if (ABL & 32) o = (u32x4){0u, 0u, 0u, 0u};
        *(u32x4*)(Y + tk * D + h * 128 + 8 * ch) = o; }
    LDS_WAIT(); asm volatile("" ::: "memory");
}
__device__ __forceinline__ void na_unit(const Ctx& F, int unit, bool load_ctx) {
    const bf16* P = (const bf16*)(F.ws + WS_P); const bf16* Pc = (const bf16*)(F.ws + WS_PC); bf16* Y = (bf16*)(F.ws + WS_XA);
    const bf16* VTn = (const bf16*)(F.ws + WS_VTN); const bf16* VTnc = (const bf16*)(F.ws + WS_VTNC);
    int lane = F.lane; asm volatile("" : "+v"(lane));
    const int li = lane & 15, kq = lane >> 4, w = F.wave;
    const int b = unit >> 7, nh = (unit >> 4) & 7, rp = unit & 15;
    const int r = 2 * rp + (w >> 2), cb = w & 3;
    const int rmin = min(max(2 * rp - 4, 0), GROWS - 8);
    const int r0 = min(max(r - 4, 0), GROWS - 8), kstart = min(max(16 * cb - 8, 0), GRIDW - 32);
    const int qc = 16 * cb + li; const int wstart = min(max(qc - 8, 0), GRIDW - 16);
    const size_t tokb = (size_t)b * SEQ;
    const int krow = 8 * (li >> 2) + (li & 3);
    constexpr int L_CTX = 73728, L_TBL = 106496, L_CTXV = 108544;
    __syncthreads();
#pragma unroll
    for (int i = 0; i < 13; ++i) { const int idx = i * 512 + w * 64 + lane; const bf16* src;
        if (i < 9) { const int R = idx >> 3, cc = (idx & 7) ^ (R & 7); const int kr = min(rmin + (R >> 6), GROWS - 1);
            src = P + (tokb + kr * 64 + (R & 63)) * PW + PO_NK + nh * 64 + 8 * cc; }
        else { if (!load_ctx) continue; const int id2 = idx - 4608, R = id2 >> 3, cc = (id2 & 7) ^ (R & 7); src = Pc + ((size_t)b * CTXL + R) * PCW + nh * 64 + 8 * cc; }
        dma16(src, F.lds + (i * 512 + w * 64) * 16); }
    if (load_ctx) {
#pragma unroll
        for (int i = 0; i < 4; ++i) { const int id2 = i * 512 + w * 64 + lane, Rd = id2 >> 5, cc = (id2 & 31) ^ (Rd & 7);
            dma16(VTnc + ((size_t)(b * 8 + nh) * 64 + Rd) * CTXL + 8 * cc, F.lds + L_CTXV + (i * 512 + w * 64) * 16); } }
    LAS float* tbl = (LAS float*)(F.lds + L_TBL);
    for (int q = F.tid; q < 15 * 32; q += 512) { const int rr = q >> 5, cc = q & 31; tbl[q] = cc < 31 ? F.a->in[11][(size_t)(nh * 15 + rr) * 31 + cc] * 1.4426950408889634f : -3.0e38f; }
    bf16x8 qf[2];
    { const bf16* qp = P + (tokb + r * 64 + qc) * PW + PO_NQ + nh * 64 + 8 * kq; qf[0] = *(const bf16x8*)qp; qf[1] = *(const bf16x8*)(qp + 32); }
    asm volatile("s_waitcnt vmcnt(0)" ::: "memory");
    __syncthreads();
    int cidx[8];
#pragma unroll
    for (int o = 0; o < 8; ++o) { const int kc = kstart + 8 * kq + o; const bool ok = (kc >= wstart) && (kc < wstart + 16); cidx[o] = ok ? (kc - qc + 15) : 31; }
    f32x4 sw[16], sc[16];
    float mx = -3.0e38f;
#pragma unroll
    for (int wt = 0; wt < 16; ++wt) {
        const int kr = r0 + (wt >> 1);
        f32x4 a;
#pragma unroll
        for (int jj = 0; jj < 4; ++jj) a[jj] = tbl[(kr - r + 7) * 32 + cidx[4 * (wt & 1) + jj]];
        const int R = (kr - rmin) * 64 + kstart + krow + 4 * (wt & 1);
        const LAS unsigned char* rowp = F.lds + R * 128;
        a = __builtin_amdgcn_mfma_f32_16x16x32_bf16(*(const LAS bf16x8*)(rowp + ((kq ^ (R & 7)) << 4)), qf[0], a, 0, 0, 0);
        a = __builtin_amdgcn_mfma_f32_16x16x32_bf16(*(const LAS bf16x8*)(rowp + (((4 + kq) ^ (R & 7)) << 4)), qf[1], a, 0, 0, 0);
#pragma unroll
        for (int jj = 0; jj < 4; ++jj) mx = fmaxf(mx, a[jj]);
        sw[wt] = a;
    }
#pragma unroll
    for (int ct = 0; ct < 16; ++ct) {
        const int R = 32 * (ct >> 1) + krow + 4 * (ct & 1);
        const LAS unsigned char* rowp = F.lds + L_CTX + R * 128;
        f32x4 a = (f32x4){0.f, 0.f, 0.f, 0.f};
        a = __builtin_amdgcn_mfma_f32_16x16x32_bf16(*(const LAS bf16x8*)(rowp + ((kq ^ (R & 7)) << 4)), qf[0], a, 0, 0, 0);
        a = __builtin_amdgcn_mfma_f32_16x16x32_bf16(*(const LAS bf16x8*)(rowp + (((4 + kq) ^ (R & 7)) << 4)), qf[1], a, 0, 0, 0);
#pragma unroll
        for (int jj = 0; jj < 4; ++jj) mx = fmaxf(mx, a[jj]);
        sc[ct] = a;
    }
    __syncthreads();
#pragma unroll
    for (int i = 0; i < 13; ++i) { const int idx = i * 512 + w * 64 + lane; const bf16* src;
        if (i < 9) { const int Rd = idx / 72, q = idx - Rd * 72, cc = q ^ (Rd & 7); const int kr = min(rmin + (cc >> 3), GROWS - 1);
            src = VTn + ((size_t)(b * 8 + nh) * 64 + Rd) * TPITCH + kr * 64 + (cc & 7) * 8; }
        else continue;
        dma16(src, F.lds + (i * 512 + w * 64) * 16); }
    mx = fmaxf(mx, __shfl_xor(mx, 16)); mx = fmaxf(mx, __shfl_xor(mx, 32));
    float sum = 0.f;
#pragma unroll
    for (int wt = 0; wt < 16; ++wt)
#pragma unroll
        for (int jj = 0; jj < 4; ++jj) { const float e = fexp2(sw[wt][jj] - mx); sw[wt][jj] = e; sum += e; }
#pragma unroll
    for (int ct = 0; ct < 16; ++ct)
#pragma unroll
        for (int jj = 0; jj < 4; ++jj) { const float e = fexp2(sc[ct][jj] - mx); sc[ct][jj] = e; sum += e; }
    sum += __shfl_xor(sum, 16); sum += __shfl_xor(sum, 32);
    asm volatile("s_waitcnt vmcnt(0)" ::: "memory");
    __syncthreads();
    f32x4 O[4];
#pragma unroll
    for (int nt = 0; nt < 4; ++nt) O[nt] = (f32x4){0.f, 0.f, 0.f, 0.f};
#pragma unroll
    for (int u = 0; u < 8; ++u) { bf16x8 pf;
        pf = pack8(sw[2 * u], sw[2 * u + 1]);
        const int cch = (r0 + u - rmin) * 8 + (kstart >> 3) + kq;
#pragma unroll
        for (int nt = 0; nt < 4; ++nt) { const int Rd = 16 * nt + li;
            O[nt] = __builtin_amdgcn_mfma_f32_16x16x32_bf16(pf, *(const LAS bf16x8*)(F.lds + Rd * 1152 + ((cch ^ (Rd & 7)) << 4)), O[nt], 0, 0, 0); } }
#pragma unroll
    for (int u = 0; u < 8; ++u) { bf16x8 pf;
        pf = pack8(sc[2 * u], sc[2 * u + 1]);
#pragma unroll
        for (int nt = 0; nt < 4; ++nt) { const int Rd = 16 * nt + li;
            O[nt] = __builtin_amdgcn_mfma_f32_16x16x32_bf16(pf, *(const LAS bf16x8*)(F.lds + L_CTXV + Rd * 512 + (((4 * u + kq) ^ (Rd & 7)) << 4)), O[nt], 0, 0, 0); } }
    __syncthreads();
    LAS float* osc = (LAS float*)(F.lds + w * 4352);
#pragma unroll
    for (int jj = 0; jj < 4; ++jj) {
        const float sq = __shfl(sum, 4 * kq + jj); const float inv = frcp(sq);
#pragma unroll
        for (int nt = 0; nt < 4; ++nt) osc[(4 * kq + jj) * 68 + 16 * nt + li] = O[nt][jj] * inv;
    }
    LDS_WAIT(); asm volatile("" ::: "memory");
#pragma unroll
    for (int i = 0; i < 2; ++i) { const int q = lane + 64 * i, row = q >> 3, ch = q & 7;
        const f32x4 a = *(const LAS f32x4*)(osc + row * 68 + 8 * ch), c2 = *(const LAS f32x4*)(osc + row * 68 + 8 * ch + 4);
        u32x4 o = (u32x4){pk2(a.x, a.y), pk2(a.z, a.w), pk2(c2.x, c2.y), pk2(c2.z, c2.w)};
        if (ABL & 16) o = (u32x4){0u, 0u, 0u, 0u};
        *(u32x4*)(Y + (tokb + r * 64 + 16 * cb + row) * D + 512 + nh * 64 + 8 * ch) = o; }
    LDS_WAIT(); asm volatile("" ::: "memory");
}
__device__ __forceinline__ void phase4(const Ctx& F) {
#ifndef P4MASK
#define P4MASK 3
#endif
    if (P4MASK & 1) for (int u = F.bid; u < 1024; u += F.G) ret_unit(F, u);
    if (P4MASK & 2) {
        if (F.G == 256) { const int vb = (F.bid & 7) * 32 + (F.bid >> 3);
            for (int k = 0; k < 8; ++k) na_unit(F, vb * 8 + k, k == 0); }
        else for (int u = F.bid; u < 2048; u += F.G) na_unit(F, u, true);
    }
}

struct SchedOut {
    int G, c; const char* Wt;
    __device__ __forceinline__ bool next(int i, g8::Unit& u) const {
        const int L = i * G + c; if (L >= 512) return false;
        int pm, pn; g8::tile_of(L, 128, 4, pm, pn); u.pm = pm; u.pn = pn; u.e = 0; u.aux = 0; u.B = Wt + (size_t)pn * 256 * 1024 * 2; return true; }
    __device__ __forceinline__ unsigned rowoff(const g8::Unit& u, int r) const { return (unsigned)(u.pm * 256 + r) * 2048u; }
};
struct EpiY {
    static constexpr bool IDEMP = true;
    bf16* Yg; const float* gate0; const float* cs; float abl;
    __device__ __forceinline__ void operator()(const f32x4 (&acc)[2][2][4][2], const g8::Unit& u, int wr, int wc, int fr, int fq) const {
        const int row0 = u.pm * 256 + wr * 64 + fr, col0 = u.pn * 256 + wc * 32 + 8 * fq;
        const float* gp = gate0 + (size_t)(row0 >> 11) * 6144 + col0;
        f32x4 gv[2][2];
#pragma unroll
        for (int bj = 0; bj < 2; ++bj)
#pragma unroll
            for (int n = 0; n < 2; ++n) { gv[bj][n] = *(const f32x4*)(gp + bj * 128 + n * 4) * abl; if (cs) gv[bj][n] *= *(const f32x4*)(cs + col0 + bj * 128 + n * 4); }
#pragma unroll
        for (int ai = 0; ai < 2; ++ai)
#pragma unroll
            for (int m = 0; m < 4; ++m) { bf16* rp = Yg + (size_t)(row0 + ai * 128 + m * 16) * D + col0;
#pragma unroll
                for (int bj = 0; bj < 2; ++bj) { const f32x4 v0 = acc[ai][bj][m][0] * gv[bj][0], v1 = acc[ai][bj][m][1] * gv[bj][1];
                    *(u32x4*)(rp + bj * 128) = (u32x4){pk2(v0.x, v0.y), pk2(v0.z, v0.w), pk2(v1.x, v1.y), pk2(v1.z, v1.w)}; } }
    }
};

struct LnVecs { f32x4 lg[4], lb[4], sh[4], sc1[4]; f32x4 br1; };
template <bool RES32> __device__ __forceinline__ void ln_load(const float* R32, const bf16* R16, const bf16* Yg, int t, int lane, f32x4 (&nr)[4], u32x2 (&ny)[4]) {
    const u32x2* yr = (const u32x2*)(Yg + (size_t)t * D) + lane;
    if (RES32) { const float* rr = R32 + (size_t)t * D;
#pragma unroll
        for (int j = 0; j < 4; ++j) nr[j] = *(const f32x4*)(rr + 4 * lane + 256 * j); }
    else { const u32x2* rr = (const u32x2*)(R16 + (size_t)t * D) + lane;
#pragma unroll
        for (int j = 0; j < 4; ++j) { const u32x2 h = rr[64 * j]; nr[j] = (f32x4){bflo(h.x), bfhi(h.x), bflo(h.y), bfhi(h.y)}; } }
#pragma unroll
    for (int j = 0; j < 4; ++j) ny[j] = yr[64 * j];
}
__device__ __forceinline__ void ln_row(const Ctx& F, int l, int t, const f32x4 (&nr)[4], const u32x2 (&ny)[4], const LnVecs& V, LAS f32x4* wl, LAS u32x4* rec_slot) {
    const int lane = F.lane; const LAS float* br2l = (const LAS float*)(F.lds + 149760);
    bf16* hm = (bf16*)(F.ws + WS_XA);
    unsigned long long* hr8 = (unsigned long long*)((bf16*)(F.ws + WS_H16) + (size_t)t * D) + lane;
    f32x4 v[4]; float s = 0.f;
#pragma unroll
    for (int j = 0; j < 4; ++j) { const u32x2 y = ny[j]; v[j] = nr[j] * ALPHA + (f32x4){bflo(y.x), bfhi(y.x), bflo(y.y), bfhi(y.y)}; s += (v[j].x + v[j].y) + (v[j].z + v[j].w); }
    const float mean = wave_sum(s) * (1.0f / D); float s2 = 0.f;
#pragma unroll
    for (int j = 0; j < 4; ++j) { v[j] = v[j] - mean; s2 += (v[j].x * v[j].x + v[j].y * v[j].y) + (v[j].z * v[j].z + v[j].w * v[j].w); }
    const float rstd = __builtin_amdgcn_rsqf(wave_sum(s2) * (1.0f / D) + LN_EPS);
    unsigned long long* o8 = (unsigned long long*)(hm + (size_t)t * D) + lane;
    float pg[4] = {0.f, 0.f, 0.f, 0.f};
#pragma unroll
    for (int j = 0; j < 4; ++j) { const int ci = 4 * lane + 256 * j;
        const f32x4 h1 = v[j] * rstd * V.lg[j] + V.lb[j];
        hr8[64 * j] = (unsigned long long)pk2(h1.x, h1.y) | ((unsigned long long)pk2(h1.z, h1.w) << 32);
        const f32x4 m = h1 * V.sc1[j] + V.sh[j];
        v[j] = m;
        o8[64 * j] = (unsigned long long)pk2(m.x, m.y) | ((unsigned long long)pk2(m.z, m.w) << 32);
#pragma unroll
        for (int e = 0; e < 4; ++e) { const f32x4 w = wl[(4 * j + e) * 64 + lane];
#pragma unroll
            for (int g = 0; g < 4; ++g) pg[g] += m[e] * w[g]; } }
    float lgt[4];
#pragma unroll
    for (int g = 0; g < 4; ++g) lgt[g] = wave_sum(pg[g]) + V.br1[g];
    int grp = 0; float gm = lgt[0];
#pragma unroll
    for (int g = 1; g < 4; ++g) if (lgt[g] > gm) { gm = lgt[g]; grp = g; }
    float gs = 0.f;
#pragma unroll
    for (int g = 0; g < 4; ++g) gs += __expf(lgt[g] - gm);
    const float gate_g = 1.0f / gs;
    float pe[8] = {0.f, 0.f, 0.f, 0.f, 0.f, 0.f, 0.f, 0.f};
#pragma unroll
    for (int j = 0; j < 4; ++j) {
#pragma unroll
        for (int e = 0; e < 4; ++e) { const f32x4 wa = wl[1024 + 2048 * grp + ((4 * j + e) * 2) * 64 + lane], wb = wl[1024 + 2048 * grp + ((4 * j + e) * 2 + 1) * 64 + lane];
#pragma unroll
            for (int q = 0; q < 4; ++q) { pe[q] += v[j][e] * wa[q]; pe[4 + q] += v[j][e] * wb[q]; } } }
    float le[8];
    {
        float a4[4], a2[2], a1;
#pragma unroll
        for (int q = 0; q < 4; ++q) { const float mine = (lane & 1) ? pe[q + 4] : pe[q], send = (lane & 1) ? pe[q] : pe[q + 4]; a4[q] = mine + __shfl_xor(send, 1); }
#pragma unroll
        for (int q = 0; q < 2; ++q) { const float mine = (lane & 2) ? a4[q + 2] : a4[q], send = (lane & 2) ? a4[q] : a4[q + 2]; a2[q] = mine + __shfl_xor(send, 2); }
        { const float mine = (lane & 4) ? a2[1] : a2[0], send = (lane & 4) ? a2[0] : a2[1]; a1 = mine + __shfl_xor(send, 4); }
        a1 += __shfl_xor(a1, 8); a1 += __shfl_xor(a1, 16); a1 += __shfl_xor(a1, 32);
#pragma unroll
        for (int q = 0; q < 8; ++q) { const int src = ((q >> 2) & 1) | (((q >> 1) & 1) << 1) | ((q & 1) << 2); le[q] = __shfl(a1, src) + br2l[grp * 8 + q]; }

    }
    int i0 = 0; float v0 = le[0];
#pragma unroll
    for (int q = 1; q < 8; ++q) if (le[q] > v0) { v0 = le[q]; i0 = q; }
    int i1 = -1; float v1 = -3.0e38f;
#pragma unroll
    for (int q = 0; q < 8; ++q) if (q != i0 && le[q] > v1) { v1 = le[q]; i1 = q; }
    const float e1 = __expf(v1 - v0); const float w0 = (ABL & 128) ? 0.f : gate_g / (1.0f + e1), w1 = (ABL & 1024) ? 1.0f : ((ABL & 64) ? 0.f : gate_g * e1 / (1.0f + e1));
    if (lane == 0) *rec_slot = (u32x4){(unsigned)(grp * 8 + i0), (unsigned)(grp * 8 + i1), __builtin_bit_cast(unsigned, w0), __builtin_bit_cast(unsigned, w1)};
}
template <bool RES32> __device__ __forceinline__ void phase_ln_router(const Ctx& F, int l, const float* R32, const bf16* Yg) {
    const bf16* R16 = (const bf16*)(F.ws + WS_H16);
    const int gw = F.bid * 8 + F.wave, lane = F.lane;
    int* tokinfo = (int*)(F.ws + WS_TOKINFO); int* list = (int*)(F.ws + WS_LIST);
    unsigned* cnt = (unsigned*)(F.ws + WS_CTL) + CW_CNT + 64 * (l * 32);
    LAS f32x4* wl = (LAS f32x4*)F.lds;
    __syncthreads();
    for (int k = F.tid; k < 1024; k += 512) { const int ln = (k & 255) >> 2, e = k & 3, j = k >> 8;
        wl[(4 * j + e) * 64 + ln] = *(const f32x4*)(F.a->in[14] + ((size_t)l * D + k) * 4);
#pragma unroll
        for (int g = 0; g < 4; ++g)
#pragma unroll
            for (int q = 0; q < 2; ++q) wl[1024 + 2048 * g + ((4 * j + e) * 2 + q) * 64 + ln] = *(const f32x4*)(F.a->in[16] + (((size_t)l * 4 + g) * D + k) * 8 + 4 * q); }
    if (F.tid < 32) ((LAS float*)(F.lds + 149760))[F.tid] = F.a->in[17][l * 32 + F.tid];
    __syncthreads();
    LAS u32x4* recs = (LAS u32x4*)(F.lds + 147456);
    const int t_lo = gw * 16;
    for (int tb = t_lo; tb < T; tb += F.G * 8 * 16) {
        const int b = tb >> 11;
        LnVecs V;
#pragma unroll
        for (int j = 0; j < 4; ++j) { const int ci = 4 * lane + 256 * j;
            V.lg[j] = *(const f32x4*)(F.a->in[6] + (l * 2 + 0) * D + ci); V.lb[j] = *(const f32x4*)(F.a->in[7] + (l * 2 + 0) * D + ci);
            V.sh[j] = *(const f32x4*)(modp(F, l, b, 3) + ci); V.sc1[j] = *(const f32x4*)(modp(F, l, b, 4) + ci) + 1.0f; }
        V.br1 = *(const f32x4*)(F.a->in[15] + l * 4);
        f32x4 rA[4], rB[4]; u32x2 yA[4], yB[4];
        ln_load<RES32>(R32, R16, Yg, tb, lane, rA, yA);
#pragma unroll 1
        for (int k = 0; k < 16; k += 2) {
            ln_load<RES32>(R32, R16, Yg, tb + k + 1, lane, rB, yB);
            asm volatile("" ::: "memory"); __builtin_amdgcn_sched_barrier(0);
            ln_row(F, l, tb + k, rA, yA, V, wl, recs + F.wave * 16 + k);
            ln_load<RES32>(R32, R16, Yg, tb + min(k + 2, 15), lane, rA, yA);
            asm volatile("" ::: "memory"); __builtin_amdgcn_sched_barrier(0);
            ln_row(F, l, tb + k + 1, rB, yB, V, wl, recs + F.wave * 16 + k + 1);
        }
        LAS int* lcnt = (LAS int*)(F.lds + 149504);
        __syncthreads();
        if (F.tid < 64) lcnt[F.tid] = 0;
        __syncthreads();
        int e = 0, lp = 0; unsigned wa = 0u, wb = 0u; const int which = F.tid & 1;
        const int r = F.tid >> 1; const int t = (tb - F.wave * 16) + r;
        if (F.tid < 256) { const u32x4 rec = recs[r]; e = which ? (int)rec.y : (int)rec.x; wa = rec.z; wb = rec.w;
            lp = __hip_atomic_fetch_add(&lcnt[e], 1, __ATOMIC_RELAXED, __HIP_MEMORY_SCOPE_WORKGROUP); }
        __syncthreads();
        if (F.tid < 32) lcnt[32 + F.tid] = (int)atomicAdd(cnt + 64 * F.tid, (unsigned)lcnt[F.tid]);
        __syncthreads();
        if (F.tid < 256) { const int pos = lcnt[32 + e] + lp;
            list[(size_t)e * LISTCAP + pos] = t;
            int* ti = tokinfo + (size_t)t * 8;
            *(u32x2*)(ti + 2 * which) = (u32x2){(unsigned)e, (unsigned)pos};
            if (which == 0) *(u32x2*)(ti + 4) = (u32x2){wa, wb}; }
    }
}

__device__ __forceinline__ void moe_table(const Ctx& F, int l) {
    LAS int* tab = (LAS int*)(F.lds + LDS_TAB_OFF);
    __syncthreads();
    if (F.tid < 32) tab[40 + F.tid] = (int)__hip_atomic_load((unsigned*)(F.ws + WS_CTL) + CW_CNT + 64 * (l * 32 + F.tid), __ATOMIC_RELAXED, __HIP_MEMORY_SCOPE_AGENT);
    __syncthreads();
    if (F.tid == 0) { int s = 0; for (int e = 0; e < 32; ++e) { tab[e] = s; s += (tab[40 + e] + 255) >> 8; } tab[32] = s; }
    __syncthreads();
}
__device__ __forceinline__ int moe_vc(int c, int G) { return (G == 256) ? (((c & 7) * 8 + (c >> 5)) * 4 + ((c >> 3) & 3)) : c; }
struct SchedMoe {
    int G, c; const char* Wt; size_t wstride; size_t pnstride; const LAS int* tab; const LAS int* tokl; int gather; unsigned lda2;
    __device__ __forceinline__ bool next(int i, g8::Unit& u) const {
        const int L = i * G + moe_vc(c, G); const int nrt = __builtin_amdgcn_readfirstlane(tab[32]); if (L >= 4 * nrt) return false;
        const int rt = L >> 2, pn = L & 3; int e = 0;
        for (int q = 1; q < 32; ++q) e = (tab[q] <= rt) ? q : e;
        e = __builtin_amdgcn_readfirstlane(e);
        u.pm = rt; u.pn = pn; u.e = e; u.aux = i; u.B = Wt + (size_t)e * wstride + (size_t)pn * pnstride; return true; }
    __device__ __forceinline__ unsigned rowoff(const g8::Unit& u, int r) const {
        if (gather) return (unsigned)tokl[u.aux * 256 + r] * lda2;
        return (unsigned)(u.pm * 256 + r) * lda2; }
};
constexpr int MOE_MAXU = 8, LDS_TOKL_OFF = LDSCTL_OFF + 1024;
static_assert(LDS_TOKL_OFF + MOE_MAXU * 256 * 4 <= LDS_BYTES && LDS_SCR_OFF + 8 * 2304 <= LDSCTL_OFF, "LDS map");
__device__ __forceinline__ void moe_tokl(const Ctx& F) {
    const LAS int* tab = (const LAS int*)(F.lds + LDS_TAB_OFF); LAS int* tokl = (LAS int*)(F.lds + LDS_TOKL_OFF);
    const int* list = (const int*)(F.ws + WS_LIST);
    for (int q = F.tid; q < MOE_MAXU * 256; q += 512) { const int i = q >> 8, r = q & 255; const int L = i * F.G + moe_vc(F.bid, F.G); int tk = 0;
        if (L < 4 * tab[32]) { const int rt = L >> 2; int e = 0; for (int k = 1; k < 32; ++k) e = (tab[k] <= rt) ? k : e;
            const int idx = (rt - tab[e]) * 256 + r; tk = list[(size_t)e * LISTCAP + (idx < tab[40 + e] ? idx : 0)]; }
        tokl[q] = tk; }
    __syncthreads();
}
struct EpiAct {
    bf16* act;
    __device__ __forceinline__ void operator()(const f32x4 (&acc)[2][2][4][2], const g8::Unit& u, int wr, int wc, int fr, int fq) const {
        const int row0 = u.pm * 256 + wr * 64 + fr, col0 = u.pn * 128 + wc * 32 + 8 * fq;
#pragma unroll
        for (int ai = 0; ai < 2; ++ai)
#pragma unroll
            for (int m = 0; m < 4; ++m) { bf16* rp = act + (size_t)(row0 + ai * 128 + m * 16) * HID + col0;
                const f32x4 g0 = acc[ai][0][m][0], u0 = acc[ai][0][m][1], g1 = acc[ai][1][m][0], u1 = acc[ai][1][m][1];
                *(u32x4*)rp = (u32x4){pk2(silu_f(g0.x) * u0.x, silu_f(g0.y) * u0.y), pk2(silu_f(g0.z) * u0.z, silu_f(g0.w) * u0.w),
                                      pk2(silu_f(g1.x) * u1.x, silu_f(g1.y) * u1.y), pk2(silu_f(g1.z) * u1.z, silu_f(g1.w) * u1.w)}; }
    }
};
struct EpiEo {
    bf16* eo;
    __device__ __forceinline__ void operator()(const f32x4 (&acc)[2][2][4][2], const g8::Unit& u, int wr, int wc, int fr, int fq) const {
        const int row0 = u.pm * 256 + wr * 64 + fr, col0 = u.pn * 256 + wc * 32 + 8 * fq;
#pragma unroll
        for (int ai = 0; ai < 2; ++ai)
#pragma unroll
            for (int m = 0; m < 4; ++m) { bf16* rp = eo + (size_t)(row0 + ai * 128 + m * 16) * D + col0;
#pragma unroll
                for (int bj = 0; bj < 2; ++bj) { const f32x4 v0 = acc[ai][bj][m][0], v1 = acc[ai][bj][m][1];
                    *(u32x4*)(rp + bj * 128) = (u32x4){pk2(v0.x, v0.y), pk2(v0.z, v0.w), pk2(v1.x, v1.y), pk2(v1.z, v1.w)}; } }
    }
};

struct CmbRow { u32x2 h[4]; u32x2 ea[4], eb[4]; };
__device__ __forceinline__ void cmb_load(const Ctx& F, const LAS int* tab, int t, const u32x4& ti, CmbRow& r) {
    const unsigned e0i = ti.x, p0i = ti.y, e1i = ti.z, p1i = ti.w;
    const size_t s0 = (size_t)tab[e0i] * 256 + p0i, s1 = (size_t)tab[e1i] * 256 + p1i;
    const bf16* eo = (const bf16*)(F.ws + WS_EO);
    const u32x2* e0 = (const u32x2*)(eo + s0 * D) + F.lane; const u32x2* e1 = (const u32x2*)(eo + s1 * D) + F.lane; const u32x2* hp = (const u32x2*)((const bf16*)(F.ws + WS_H16) + (size_t)t * D) + F.lane;
#pragma unroll
    for (int j = 0; j < 4; ++j) { r.ea[j] = e0[64 * j]; r.eb[j] = e1[64 * j]; r.h[j] = hp[64 * j]; }
}
__device__ __forceinline__ void cmb_row(const Ctx& F, int l, int t, const CmbRow& r, const u32x2& tw, const f32x4 (&gt)[4], const f32x4 (&lg)[4], const f32x4 (&lb)[4]) {
    const float ab = ((ABL >> (1 + 2 * l)) & 1) ? 0.f : 1.f;
    const unsigned twx = tw.x, twy = tw.y;
    const float w0 = ab * __uint_as_float(twx), w1 = ab * __uint_as_float(twy);
    f32x4 v[4]; float s = 0.f;
#pragma unroll
    for (int j = 0; j < 4; ++j) { const u32x2 a = r.ea[j], c2 = r.eb[j];
        f32x4 y; y.x = w0 * bflo(a.x) + w1 * bflo(c2.x); y.y = w0 * bfhi(a.x) + w1 * bfhi(c2.x); y.z = w0 * bflo(a.y) + w1 * bflo(c2.y); y.w = w0 * bfhi(a.y) + w1 * bfhi(c2.y);
        const u32x2 hh = r.h[j]; v[j] = (f32x4){bflo(hh.x), bfhi(hh.x), bflo(hh.y), bfhi(hh.y)} * ALPHA + gt[j] * y; s += (v[j].x + v[j].y) + (v[j].z + v[j].w); }
    const float mean = wave_sum(s) * (1.0f / D); float s2 = 0.f;
#pragma unroll
    for (int j = 0; j < 4; ++j) { v[j] = v[j] - mean; s2 += (v[j].x * v[j].x + v[j].y * v[j].y) + (v[j].z * v[j].z + v[j].w * v[j].w); }
    const float rstd = __builtin_amdgcn_rsqf(wave_sum(s2) * (1.0f / D) + LN_EPS);
    if (l == 1) { float* hr = F.H + (size_t)t * D;
#pragma unroll
        for (int j = 0; j < 4; ++j) *(f32x4*)(hr + 4 * F.lane + 256 * j) = v[j] * rstd * lg[j] + lb[j]; }
    else { unsigned long long* hr8 = (unsigned long long*)((bf16*)(F.ws + WS_H16) + (size_t)t * D) + F.lane;
#pragma unroll
        for (int j = 0; j < 4; ++j) { const f32x4 o = v[j] * rstd * lg[j] + lb[j]; hr8[64 * j] = (unsigned long long)pk2(o.x, o.y) | ((unsigned long long)pk2(o.z, o.w) << 32); } }
}
__device__ __forceinline__ void phase_combine(const Ctx& F, int l) {
    moe_table(F, l);
    const LAS int* tab = (const LAS int*)(F.lds + LDS_TAB_OFF);
    const int gw = F.bid * 8 + F.wave, lane = F.lane;
    const int* tokinfo = (const int*)(F.ws + WS_TOKINFO);
    for (int tb = gw * 16; tb < T; tb += F.G * 8 * 16) {
        const int b = tb >> 11;
        f32x4 gt[4], lg[4], lb[4];
#pragma unroll
        for (int j = 0; j < 4; ++j) { const int ci = 4 * lane + 256 * j; gt[j] = *(const f32x4*)(modp(F, l, b, 5) + ci);
            lg[j] = *(const f32x4*)(F.a->in[6] + (l * 2 + 1) * D + ci); lb[j] = *(const f32x4*)(F.a->in[7] + (l * 2 + 1) * D + ci); }
        u32x4 tiv = (u32x4){0u, 0u, 0u, 0u}; u32x2 twv = (u32x2){0u, 0u};
        if (lane < 16) { tiv = *(const u32x4*)(tokinfo + (size_t)(tb + lane) * 8); twv = *(const u32x2*)(tokinfo + (size_t)(tb + lane) * 8 + 4); }
#define CMB_TI(k_) ((u32x4){(unsigned)__shfl((int)tiv.x, (k_)), (unsigned)__shfl((int)tiv.y, (k_)), (unsigned)__shfl((int)tiv.z, (k_)), (unsigned)__shfl((int)tiv.w, (k_))})
#define CMB_TW(k_) ((u32x2){(unsigned)__shfl((int)twv.x, (k_)), (unsigned)__shfl((int)twv.y, (k_))})
        CmbRow A, B;
        cmb_load(F, tab, tb, CMB_TI(0), A);
#pragma unroll 1
        for (int k = 0; k < 16; k += 2) {
            cmb_load(F, tab, tb + k + 1, CMB_TI(k + 1), B);
            asm volatile("" ::: "memory");
            cmb_row(F, l, tb + k, A, CMB_TW(k), gt, lg, lb);
            if (k + 2 < 16) cmb_load(F, tab, tb + k + 2, CMB_TI(k + 2), A);
            asm volatile("" ::: "memory");
            cmb_row(F, l, tb + k + 1, B, CMB_TW(k + 1), gt, lg, lb);
        }
#undef CMB_TI
#undef CMB_TW
    }
}

template <int WH> __device__ __forceinline__ void pool_item(const Ctx& F, bf16* zp, int b, int p0, int ch) {
    const bf16* hb = (const bf16*)(F.ws + WS_H16) + (size_t)b * SEQ * D + ch;
    const f32x4 sc1 = *(const f32x4*)(modp(F, 1, b, 1) + ch) + 1.0f;
    u32x2 rw[8 + 2 * WH];
#pragma unroll
    for (int i = 0; i < 8 + 2 * WH; ++i) { const int p = p0 - WH + i; const bool ok = (p >= 0) && (p < SEQ); const u32x2 v = *(const u32x2*)(hb + (size_t)(ok ? p : p0) * D); rw[i] = ok ? v : (u32x2){0u, 0u}; }
#define PZ_ROW(i_) ((f32x4){bflo(rw[i_].x), bfhi(rw[i_].x), bflo(rw[i_].y), bfhi(rw[i_].y)})
    f32x4 sum = (f32x4){0.f, 0.f, 0.f, 0.f};
#pragma unroll
    for (int i = 0; i < 2 * WH; ++i) sum += PZ_ROW(i);
#pragma unroll
    for (int j = 0; j < 8; ++j) { const int p = p0 + j; const int cnt = min(p + WH, SEQ) - max(p - WH, 0);
        const f32x4 z = (sum * frcp((float)cnt) - PZ_ROW(j + WH)) * sc1;
        *(u32x2*)(zp + ((size_t)b * SEQ + p) * D + ch) = (u32x2){pk2(z.x, z.y), pk2(z.z, z.w)};
        sum += PZ_ROW(j + 2 * WH) - PZ_ROW(j); }
#undef PZ_ROW
}
__device__ __forceinline__ void phase_pool(const Ctx& F) {
    bf16* zp = (bf16*)(F.ws + WS_XA);
    for (int item = F.bid * 512 + F.tid; item < 4096 * 256; item += F.G * 512) {
        const int strip = item >> 8, ct = item & 255, b = strip >> 8, p0 = (strip & 255) * 8, ch = 4 * ct;
        const int g = __builtin_amdgcn_readfirstlane(ct >> 6);
        if (g == 0) pool_item<1>(F, zp, b, p0, ch); else if (g == 1) pool_item<2>(F, zp, b, p0, ch); else if (g == 2) pool_item<4>(F, zp, b, p0, ch); else pool_item<8>(F, zp, b, p0, ch);
    }
}
struct SchedPool {
    int G, c; const char* Wt;
    __device__ __forceinline__ bool next(int i, g8::Unit& u) const {
        const int L = i * G + c; if (L >= 512) return false;
        int pm, pn; g8::tile_of(L, 128, 4, pm, pn); u.pm = pm; u.pn = pn; u.e = 0; u.aux = 0; u.B = Wt + (size_t)pn * 256 * 256 * 2; return true; }
    __device__ __forceinline__ unsigned rowoff(const g8::Unit& u, int r) const { return (unsigned)(u.pm * 256 + r) * 2048u + (unsigned)u.pn * 512u; }
};

__global__ void __launch_bounds__(512, 2) mk_fwd(Args args) {
    extern __shared__ __attribute__((aligned(16))) unsigned char lds_raw[];
    Ctx F;
    F.lds = (LAS unsigned char*)lds_raw;
    F.tid = threadIdx.x; F.lane = F.tid & 63; F.wave = __builtin_amdgcn_readfirstlane(F.tid >> 6); F.G = gridDim.x; F.bid = blockIdx.x;
    F.a = (KArgs)__builtin_amdgcn_kernarg_segment_ptr();
    F.H = args.out; F.ws = args.ws;
    for (int u = F.tid; u < (LDS_BYTES - LDSCTL_OFF) / 4; u += 512) ((LAS unsigned*)(F.lds + LDSCTL_OFF))[u] = 0u;
    __syncthreads();
    XcdBarrier bar; bar.bar = (unsigned*)(F.ws + WS_CTL) + CW_BAR; bar.x = 0; bar.st = nullptr;
    if (MK_N_LAUNCHES == 1) bar = xcd_barrier_post((unsigned*)(F.ws + WS_CTL) + CW_BAR, (volatile LAS unsigned*)(F.lds + LDSCTL_OFF));
    const int lo = args.ph_lo, hi = args.ph_hi;
#ifndef PHMASK
#define PHMASK 0xFFFF
#endif
#define IN(k) (((PHMASK >> (k)) & 1) && lo <= (k) && (k) < hi)
#define FRESH() do { asm volatile("" : "+s"(F.a)); } while (0)
#define SEAM(k) do { if (IN(k) && IN((k) + 1)) xcd_barrier(bar); } while (0)

    if (IN(0)) { FRESH(); phase0(F); if (RPT & 1) { __syncthreads(); phase0(F); } } SEAM(0);
    if (IN(1)) { FRESH(); phase1(F); if (RPT & 2) { __syncthreads(); phase1(F); } } SEAM(1);
    if (IN(2)) { FRESH();
        SchedIn S{F.G, F.bid, (const char*)(F.ws + WS_WIN)};
        EpiIn E{F.ws, (unsigned char*)F.H, F.lds};
        g8::gemm_phase(F.lds, (const char*)(F.ws + WS_XA), 1024, S, E);
        convert_tail(F, F.bid, (1792 + 128) % 256, 0, 10240);
    } SEAM(2);
    if (IN(3)) { FRESH(); phase3(F); if (RPT & 8) { __syncthreads(); phase3(F); } } SEAM(3);
    if (IN(4)) { FRESH(); phase4(F); if (RPT & 16) { __syncthreads(); phase4(F); } } SEAM(4);
    if (IN(5)) { FRESH();
        SchedOut S{F.G, F.bid, (const char*)(F.ws + WS_WOUT)};
        EpiY E{(bf16*)(F.ws + WS_P), modp(F, 0, 0, 2), nullptr, (ABL & 1) ? 0.f : 1.f};
        g8::gemm_phase(F.lds, (const char*)(F.ws + WS_XA), 1024, S, E); if ((RPT >> 5) & 1) { __syncthreads(); g8::gemm_phase(F.lds, (const char*)(F.ws + WS_XA), 1024, S, E); }
    } SEAM(5);
    if (IN(6)) { FRESH(); phase_ln_router<true>(F, 0, F.a->in[0], (const bf16*)(F.ws + WS_P)); } SEAM(6);
    if (IN(7)) { FRESH();
        moe_table(F, 0); moe_tokl(F);
        SchedMoe S{F.G, F.bid, (const char*)(F.ws + WS_WGU), (size_t)1024 * 1024 * 2, (size_t)256 * 1024 * 2, (const LAS int*)(F.lds + LDS_TAB_OFF), (const LAS int*)(F.lds + LDS_TOKL_OFF), 1, 2048u};
        EpiAct E{(bf16*)(F.ws + WS_ACT)};
        g8::gemm_phase(F.lds, (const char*)(F.ws + WS_XA), 1024, S, E);
        convert_tail(F, moe_vc(F.bid, F.G), (4 * ((const LAS int*)(F.lds + LDS_TAB_OFF))[32]) % 256, 10240, 20480); if ((RPT >> 7) & 1) { __syncthreads(); g8::gemm_phase(F.lds, (const char*)(F.ws + WS_XA), 1024, S, E); }
    } SEAM(7);
    if (IN(8)) { FRESH();
        moe_table(F, 0);
        SchedMoe S{F.G, F.bid, (const char*)(F.ws + WS_WDN), (size_t)1024 * 512 * 2, (size_t)256 * 512 * 2, (const LAS int*)(F.lds + LDS_TAB_OFF), (const LAS int*)(F.lds + LDS_TOKL_OFF), 0, 1024u};
        EpiEo E{(bf16*)(F.ws + WS_EO)};
        g8::gemm_phase(F.lds, (const char*)(F.ws + WS_ACT), 512, S, E);
        convert_tail(F, moe_vc(F.bid, F.G), (4 * ((const LAS int*)(F.lds + LDS_TAB_OFF))[32]) % 256, 20480, I_E1); if ((RPT >> 8) & 1) { __syncthreads(); g8::gemm_phase(F.lds, (const char*)(F.ws + WS_ACT), 512, S, E); }
    } SEAM(8);
    if (IN(9)) { FRESH(); phase_combine(F, 0); } SEAM(9);
    if (IN(10)) { FRESH(); phase_pool(F); if (RPT & 1024) { __syncthreads(); phase_pool(F); } } SEAM(10);
    if (IN(11)) { FRESH();
        SchedPool S{F.G, F.bid, (const char*)(F.ws + WS_WPOOL)};
        EpiY E{(bf16*)(F.ws + WS_ACT), modp(F, 1, 0, 2), F.a->in[13], (ABL & 4) ? 0.f : 1.f};
        g8::gemm_phase(F.lds, (const char*)(F.ws + WS_XA), 256, S, E);
    } SEAM(11);
    if (IN(12)) { FRESH(); phase_ln_router<false>(F, 1, nullptr, (const bf16*)(F.ws + WS_ACT)); } SEAM(12);
    if (IN(13)) { FRESH();
        moe_table(F, 1); moe_tokl(F);
        SchedMoe S{F.G, F.bid, (const char*)(F.ws + WS_WGU) + (size_t)32 * 1024 * 1024 * 2, (size_t)1024 * 1024 * 2, (size_t)256 * 1024 * 2, (const LAS int*)(F.lds + LDS_TAB_OFF), (const LAS int*)(F.lds + LDS_TOKL_OFF), 1, 2048u};
        EpiAct E{(bf16*)(F.ws + WS_ACT)};
        g8::gemm_phase(F.lds, (const char*)(F.ws + WS_XA), 1024, S, E);
    } SEAM(13);
    if (IN(14)) { FRESH();
        moe_table(F, 1);
        SchedMoe S{F.G, F.bid, (const char*)(F.ws + WS_WDN) + (size_t)32 * 1024 * 512 * 2, (size_t)1024 * 512 * 2, (size_t)256 * 512 * 2, (const LAS int*)(F.lds + LDS_TAB_OFF), (const LAS int*)(F.lds + LDS_TOKL_OFF), 0, 1024u};
        EpiEo E{(bf16*)(F.ws + WS_EO)};
        g8::gemm_phase(F.lds, (const char*)(F.ws + WS_ACT), 512, S, E);
    } SEAM(14);
    if (IN(15)) { FRESH(); phase_combine(F, 1); }
#undef IN
#undef SEAM
}

extern "C" void kernel_launch(void* const* d_in, const int* in_sizes, int n_in, void* d_out, int out_size, void* d_ws, size_t ws_size, hipStream_t stream) {
    static int grid = 0;
    if (grid == 0) {
        if (n_in != 21 || in_sizes[0] != T * D || out_size != T * D || ws_size < WS_END) { fprintf(stderr, "kernel_launch: unexpected shapes (n_in %d, ws %zu); nothing launched\n", n_in, ws_size); grid = -1; return; }
        int dev = 0, cus = 0, per_cu = 0;
        if (hipGetDevice(&dev) != hipSuccess || hipDeviceGetAttribute(&cus, hipDeviceAttributeMultiprocessorCount, dev) != hipSuccess) { grid = -1; return; }
        if (hipFuncSetAttribute((const void*)mk_fwd, hipFuncAttributeMaxDynamicSharedMemorySize, LDS_BYTES) != hipSuccess) { fprintf(stderr, "kernel_launch: hipFuncSetAttribute failed\n"); grid = -1; return; }
        if (hipOccupancyMaxActiveBlocksPerMultiprocessor(&per_cu, (const void*)mk_fwd, 512, LDS_BYTES) != hipSuccess || per_cu < 1) { fprintf(stderr, "kernel_launch: occupancy query reports %d\n", per_cu); }
        (void)hipGetLastError();
        grid = cus;
    }
    if (grid < 0) return;
    if (hipMemsetAsync((char*)d_ws + WS_CTL, 0, CTL_ZERO_BYTES, stream) != hipSuccess) return;
    Args a{};
    for (int i = 0; i < 21; ++i) a.in[i] = (const float*)d_in[i];
    a.out = (float*)d_out; a.ws = (unsigned char*)d_ws;
    if (MK_N_LAUNCHES == 1) { a.ph_lo = 0; a.ph_hi = NPHASE; hipLaunchKernelGGL(mk_fwd, dim3(grid), dim3(512), LDS_BYTES, stream, a); }
    else for (int p = 0; p < NPHASE; ++p) { a.ph_lo = p; a.ph_hi = p + 1; hipLaunchKernelGGL(mk_fwd, dim3(grid), dim3(512), LDS_BYTES, stream, a); }
}
```

```cpp
#include <hip/hip_runtime.h>
#include <cstdio>
#include <cstdint>

#ifndef ABL
#define ABL 0
#endif
#ifndef RPT
#define RPT 0
#endif
#ifndef MK_N_LAUNCHES
#define MK_N_LAUNCHES 1
#endif

#define GAS __attribute__((address_space(1)))
#define LAS __attribute__((address_space(3)))
typedef unsigned short bf16;
typedef short bf16x8 __attribute__((ext_vector_type(8)));
typedef float f32x4 __attribute__((ext_vector_type(4)));
typedef float f32x16 __attribute__((ext_vector_type(16)));
typedef unsigned u32x4 __attribute__((ext_vector_type(4)));
typedef unsigned u32x2 __attribute__((ext_vector_type(2)));

constexpr int D = 1024, NB = 16, SEQ = 2048, T = NB * SEQ, CTXL = 256, TC = NB * CTXL;
constexpr int GRIDW = 64, GROWS = SEQ / GRIDW;
constexpr int OFF_RK = 0, OFF_RV = 512, OFF_NK = 1024, OFF_NV = 1536, KV_COLS = 2048, OFF_RQ = 2048, OFF_RG = 2560, OFF_NQ = 3072, IN_COLS = 3584;
constexpr int NEXP = 32, HID = 512, LISTCAP = T;
constexpr int MAXSLOT = 73728;
constexpr float LN_EPS = 1e-5f;
constexpr float ALPHA = 1.41421356237309515f;
constexpr int NPHASE = 16;

constexpr size_t MiB = 1u << 20;
constexpr size_t WS_CTL = 0, CTL_ZERO_BYTES = 128 * 1024;
constexpr size_t WS_MOD = 1 * MiB;
constexpr size_t WS_TOKINFO = 2 * MiB;
constexpr size_t WS_LIST = 3 * MiB;
constexpr size_t WS_WIN = 8 * MiB, WS_WOUT = 15 * MiB, WS_WPOOL = 17 * MiB, WS_WGU = 18 * MiB, WS_WDN = 146 * MiB;
constexpr size_t WS_XA = 210 * MiB;
constexpr size_t WS_P = 282 * MiB;
constexpr size_t WS_ACT = 282 * MiB, WS_EO = 354 * MiB;
constexpr int TPITCH = SEQ + 64;
constexpr size_t WS_VTR = 446 * MiB, WS_VTRC = 480 * MiB;
constexpr size_t WS_VTN = 484 * MiB, WS_VTNC = 518 * MiB;
constexpr size_t WS_PC = 522 * MiB;
constexpr size_t WS_H16 = 526 * MiB;
constexpr size_t WS_END = 590 * MiB;
constexpr size_t DO_ST = 0;
constexpr size_t DO_KTR = 64 * MiB, DO_KTRC = 98 * MiB;
constexpr int PW = 2624, PO_RK = 0, PO_NK = 512, PO_RQ = 1024, PO_RG = 1536, PO_NQ = 2048, PCW = 512;
static_assert(WS_EO + (size_t)MAXSLOT * 1024 * 2 <= 498 * MiB && WS_ACT + (size_t)MAXSLOT * 512 * 2 <= WS_EO, "ws map");
static_assert(WS_P + (size_t)T * PW * 2 <= WS_VTR && WS_VTR + (size_t)64 * 128 * TPITCH * 2 <= WS_VTRC && WS_VTN + (size_t)128 * 64 * TPITCH * 2 <= WS_VTNC && DO_KTR + (size_t)64 * 128 * TPITCH * 2 <= DO_KTRC && WS_XA + (size_t)(T + TC) * D * 2 <= WS_P, "ws map");
constexpr int CW_BAR = 4096, XCD_BAR_WORDS_C = 3456;
constexpr int CW_CNT = 16384;
static_assert((CW_CNT + 64 * 64) * 4 <= (int)CTL_ZERO_BYTES && (CW_BAR + XCD_BAR_WORDS_C) * 4 <= (int)CTL_ZERO_BYTES, "ctl words inside the memset");

constexpr int RING_BYTES = 131072, LDS_SCR_OFF = RING_BYTES, LDSCTL_OFF = 154112, LDS_TAB_OFF = LDSCTL_OFF + 256, LDS_BYTES = 163840;

__device__ __forceinline__ unsigned f2bf(float f) { unsigned u = __builtin_bit_cast(unsigned, f); return (u + 0x7fffu + ((u >> 16) & 1u)) >> 16; }
__device__ __forceinline__ unsigned pk2(float lo, float hi) { unsigned r; asm("v_cvt_pk_bf16_f32 %0, %1, %2" : "=v"(r) : "v"(lo), "v"(hi)); return r; }
__device__ __forceinline__ bf16x8 pack8(const f32x4& a, const f32x4& b) { const u32x4 w = (u32x4){pk2(a.x, a.y), pk2(a.z, a.w), pk2(b.x, b.y), pk2(b.z, b.w)}; return __builtin_bit_cast(bf16x8, w); }
__device__ __forceinline__ float bf2f(unsigned h) { return __builtin_bit_cast(float, h << 16); }
__device__ __forceinline__ float bflo(unsigned w) { return __builtin_bit_cast(float, w << 16); }
__device__ __forceinline__ float bfhi(unsigned w) { return __builtin_bit_cast(float, w & 0xffff0000u); }
__device__ __forceinline__ float wave_sum(float v) {
    int x = __builtin_bit_cast(int, v);
#define WS_STEP(ctrl, rmask) do { const int t_ = __builtin_amdgcn_update_dpp(0, x, (ctrl), (rmask), 0xF, false); x = __builtin_bit_cast(int, __builtin_bit_cast(float, x) + __builtin_bit_cast(float, t_)); } while (0)
    WS_STEP(0xB1, 0xF);
    WS_STEP(0x4E, 0xF);
    WS_STEP(0x141, 0xF);
    WS_STEP(0x140, 0xF);
    WS_STEP(0x142, 0xA);
    WS_STEP(0x143, 0xC);
#undef WS_STEP
    return __builtin_bit_cast(float, __builtin_amdgcn_readlane(x, 63));
}
typedef float f32x2 __attribute__((ext_vector_type(2)));
__device__ __forceinline__ void pkfma_bc(f32x2& acc, const f32x2 w, const f32x2 mp, const bool hi) {
    if (hi) asm("v_pk_fma_f32 %0, %1, %2, %0 op_sel:[0,1,0] op_sel_hi:[1,1,1]" : "+v"(acc) : "v"(w), "v"(mp));
    else asm("v_pk_fma_f32 %0, %1, %2, %0 op_sel:[0,0,0] op_sel_hi:[1,0,1]" : "+v"(acc) : "v"(w), "v"(mp));
}
template <int CTRL> __device__ __forceinline__ float dppf(float x) { return __builtin_bit_cast(float, __builtin_amdgcn_update_dpp(0, __builtin_bit_cast(int, x), CTRL, 0xF, 0xF, false)); }
__device__ __forceinline__ float max8(float v) {
#define M8_STEP(ctrl) do { const int t_ = __builtin_amdgcn_update_dpp(0, __builtin_bit_cast(int, v), (ctrl), 0xF, 0xF, false); v = fmaxf(v, __builtin_bit_cast(float, t_)); } while (0)
    M8_STEP(0xB1); M8_STEP(0x4E); M8_STEP(0x141);
#undef M8_STEP
    return v;
}
__device__ __forceinline__ float frcp(float x) { return __builtin_amdgcn_rcpf(x); }
__device__ __forceinline__ float silu_f(float v) { return v * frcp(1.0f + __expf(-v)); }
__device__ __forceinline__ float fexp2(float x) { return __builtin_amdgcn_exp2f(x); }
#define LDS_WAIT() asm volatile("s_waitcnt lgkmcnt(0)" ::: "memory")

#define XB_TMO      128
#define XB_XCNT(j)  (256  + 64 * (j))
#define XB_XSUB(j)  (1280 + 64 * (j))
#define XB_XGEN(j)  (2304 + 64 * (j))
#define XB_TOP      3328
#define XB_TOPGEN   3392
#define XCD_BAR_WORDS 3456
#define XB_SPIN_CAP (1u << 18)
__device__ __forceinline__ unsigned xb_ld(unsigned* p)              { return __hip_atomic_load(p, __ATOMIC_RELAXED, __HIP_MEMORY_SCOPE_AGENT); }
__device__ __forceinline__ unsigned xb_add(unsigned* p, unsigned v) { return __hip_atomic_fetch_add(p, v, __ATOMIC_RELAXED, __HIP_MEMORY_SCOPE_AGENT); }
__device__ __forceinline__ unsigned xb_xcc_id() { return (unsigned)__builtin_amdgcn_s_getreg((3 << 11) | 20) & 0xFu; }
#define XB_SPIN(cond, bar) do { unsigned _sp = 0; while (cond) { __builtin_amdgcn_s_sleep(1); \
    if ((++_sp & 255u) == 0u) { if (xb_ld(&(bar)[XB_TMO])) break; if (_sp > XB_SPIN_CAP) { atomicAdd(&(bar)[XB_TMO], 1u); break; } } } } while (0)
struct XcdBarrier { unsigned* bar; unsigned x; volatile LAS unsigned* st; };
__device__ __forceinline__ XcdBarrier xcd_barrier_post(unsigned* bar, volatile LAS unsigned* st) {
    XcdBarrier b; b.bar = bar; b.x = xb_xcc_id(); b.st = st;
    if (threadIdx.x == 0) (void)xb_add(&bar[XB_XCNT(b.x)], 1u);
    return b;
}
__device__ __forceinline__ void xcd_barrier_complete(unsigned* bar, unsigned x, unsigned& nloc, unsigned& nx) {
    const unsigned G = gridDim.x * gridDim.y * gridDim.z;
    unsigned sum, cnt, mine, sp = 0u;
    for (;;) {
        sum = 0u; cnt = 0u; mine = 0u;
#pragma unroll
        for (unsigned j = 0; j < 16; ++j) { const unsigned c = xb_ld(&bar[XB_XCNT(j)]); sum += c; cnt += (c > 0u) ? 1u : 0u; mine = (j == x) ? c : mine; }
        if (sum == G) break;
        __builtin_amdgcn_s_sleep(1);
        if ((++sp & 255u) == 0u) { if (xb_ld(&bar[XB_TMO])) break; if (sp > XB_SPIN_CAP) { atomicAdd(&bar[XB_TMO], 1u); break; } }
    }
    nloc = mine > 0u ? mine : 1u; nx = cnt > 0u ? cnt : 1u;
}
__device__ __forceinline__ void xcd_barrier(const XcdBarrier& b) {
    asm volatile("s_waitcnt vmcnt(0)" ::: "memory");
    __syncthreads();
    if (threadIdx.x == 0) {
        unsigned* bar = b.bar;
        __builtin_amdgcn_s_waitcnt(0);
        unsigned nloc = b.st[0], nx = b.st[1];
        if (nloc == 0u) { xcd_barrier_complete(bar, b.x, nloc, nx); b.st[0] = nloc; b.st[1] = nx; }
        const unsigned old = xb_add(&bar[XB_XSUB(b.x)], 1u);
        const unsigned gen = old / nloc;
        if (old + 1u == (gen + 1u) * nloc) {
            __builtin_amdgcn_fence(__ATOMIC_RELEASE, "agent");
            asm volatile("s_waitcnt vmcnt(0)" ::: "memory");
            const unsigned og = xb_add(&bar[XB_TOP], 1u);
            const unsigned tg = og / nx;
            if (og + 1u == (tg + 1u) * nx) xb_add(&bar[XB_TOPGEN], 1u);
            else XB_SPIN(xb_ld(&bar[XB_TOPGEN]) == tg, bar);
            __builtin_amdgcn_fence(__ATOMIC_ACQUIRE, "agent");
            xb_add(&bar[XB_XGEN(b.x)], 1u);
            asm volatile("s_waitcnt vmcnt(0)" ::: "memory");
        } else {
            XB_SPIN(xb_ld(&bar[XB_XGEN(b.x)]) == gen, bar);
            __builtin_amdgcn_fence(__ATOMIC_ACQUIRE, "agent");
            asm volatile("s_waitcnt vmcnt(0)" ::: "memory");
        }
    }
    __syncthreads();
}

struct Args { const float* in[21]; float* out; unsigned char* ws; int ph_lo, ph_hi; };
typedef const __attribute__((address_space(4))) Args* KArgs;
struct Ctx {
    LAS unsigned char* lds;
    int tid, lane, wave, G, bid;
    KArgs a;
    float* H;
    unsigned char* ws;
};
__device__ __forceinline__ const float* modp(const Ctx& F, int l, int row, int part) { return (const float*)(F.ws + WS_MOD) + (size_t)(l * 17 + row) * 6144 + part * 1024; }

namespace g8 {
constexpr int BM = 256, BK = 64, HALF = 128, HTB = HALF * BK * 2, STAGE_BYTES = 8 * HTB;
__device__ __forceinline__ int lds_byte(int r, int c) { const int st = (r >> 4) * 2 + (c >> 5), rr = r & 15, cc = c & 31, ob = rr * 64 + cc * 2; return st * 1024 + (ob ^ (((ob >> 9) & 1) << 5)); }
__device__ __forceinline__ void stage_rc(int b, int& R, int& C) { const int st = b / 1024, sb = b % 1024, swz = sb ^ (((sb >> 9) & 1) << 5); R = (st >> 1) * 16 + swz / 64; C = (st & 1) * 32 + (swz % 64) / 2; }
struct Unit { const char* B; int pm, pn, e, aux; };
__device__ __forceinline__ void tile_of(int L, int nM, int nN, int& pm, int& pn) {
    const int nwg = nM * nN; int wgid = L; { const int q = nwg / 8, r = nwg % 8, xcd = wgid % 8, off = wgid / 8; wgid = (xcd < r ? xcd * (q + 1) : r * (q + 1) + (xcd - r) * q) + off; }
    const int nig = 8 * nN, gid = wgid / nig, fm = gid * 8, gsz = (nM - fm) < 8 ? (nM - fm) : 8;
    pm = fm + ((wgid % nig) % gsz); pn = (wgid % nig) / gsz;
}
template <class Epi, class Sched>
__device__ __forceinline__ void gemm_phase(LAS unsigned char* lds, const char* Abase, const int K, const Sched& S, const Epi& E) {
    const int tid = threadIdx.x, wid = __builtin_amdgcn_readfirstlane(tid >> 6), lane = tid & 63, wr = wid >> 2, wc = wid & 3, fr = lane & 15, fq = lane >> 4;
    const int nt = K / BK;
    int R0, C0, R1, C1; stage_rc(tid * 16, R0, C0); stage_rc(tid * 16 + 8192, R1, C1);
    unsigned voffB[2]; voffB[0] = (unsigned)(R0 * K + C0) * 2u; voffB[1] = (unsigned)(R1 * K + C1) * 2u;
    const unsigned kstep = (unsigned)(BK * 2);
    const size_t hstepB = (size_t)HALF * K * 2;
    const unsigned ldsw = (unsigned)wid * 1024u;
    const int aoff = lds_byte(wr * 64 + fr, fq * 8), boff = lds_byte(wc * 32 + fr, fq * 8);
#define G8_SA(b, h) (((b) * 2 + (h)) * HTB)
#define G8_SB(b, h) ((4 + (b) * 2 + (h)) * HTB)
#define G8_STAGEB(bufoff, gbase) do { _Pragma("unroll") for (int _i = 0; _i < 2; ++_i) \
        __builtin_amdgcn_global_load_lds((const unsigned*)((const char*)(gbase) + voffB[_i]), (LAS unsigned*)(lds + (bufoff) + ldsw + _i * 8192), 16, 0, 0); } while (0)
#define G8_STAGEA(bufoff, offs, h, koff) do { _Pragma("unroll") for (int _i = 0; _i < 2; ++_i) \
        __builtin_amdgcn_global_load_lds((const unsigned*)((Abase + (koff)) + (offs)[h][_i]), (LAS unsigned*)(lds + (bufoff) + ldsw + _i * 8192), 16, 0, 0); } while (0)
#define G8_LDA(dst, b, h) do { _Pragma("unroll") for (int m = 0; m < 4; ++m) _Pragma("unroll") for (int k = 0; k < 2; ++k) dst[m][k] = *(const LAS bf16x8*)(lds + G8_SA(b, h) + aoff + m * 2048 + k * 1024); } while (0)
#define G8_LDB(dst, b, h) do { _Pragma("unroll") for (int n = 0; n < 2; ++n) _Pragma("unroll") for (int k = 0; k < 2; ++k) dst[n][k] = *(const LAS bf16x8*)(lds + G8_SB(b, h) + boff + n * 2048 + k * 1024); } while (0)
#define G8_MMA(ai, bj, At, Bt) do { __builtin_amdgcn_s_setprio(1); _Pragma("unroll") for (int m = 0; m < 4; ++m) _Pragma("unroll") for (int n = 0; n < 2; ++n) _Pragma("unroll") for (int k = 0; k < 2; ++k) \
        acc[ai][bj][m][n] = __builtin_amdgcn_mfma_f32_16x16x32_bf16(Bt[n][k], At[m][k], acc[ai][bj][m][n], 0, 0, 0); __builtin_amdgcn_s_setprio(0); } while (0)
#define G8_WAIT_V(n) asm volatile("s_waitcnt vmcnt(" #n ")" ::: "memory")
#define G8_WAIT_L(n) asm volatile("s_waitcnt lgkmcnt(" #n ")" ::: "memory")
#define G8_BAR __builtin_amdgcn_s_barrier()
#define G8_SCHED __builtin_amdgcn_sched_barrier(0)
    Unit cur, nxt; int ui = 0;
    if (!S.next(0, cur)) return;
    f32x4 acc[2][2][4][2];
#pragma unroll
    for (int a = 0; a < 2; ++a)
#pragma unroll
        for (int b = 0; b < 2; ++b)
#pragma unroll
            for (int m = 0; m < 4; ++m)
#pragma unroll
                for (int n = 0; n < 2; ++n) acc[a][b][m][n] = (f32x4){0.f, 0.f, 0.f, 0.f};
    bf16x8 At[4][2], B0[2][2], B1[2][2];
    unsigned ac[2][2];
    ac[0][0] = S.rowoff(cur, R0) + (unsigned)C0 * 2u; ac[0][1] = S.rowoff(cur, R1) + (unsigned)C1 * 2u;
    ac[1][0] = S.rowoff(cur, HALF + R0) + (unsigned)C0 * 2u; ac[1][1] = S.rowoff(cur, HALF + R1) + (unsigned)C1 * 2u;
    const char* cB = cur.B;
    G8_STAGEB(G8_SB(0, 0), cB); G8_STAGEB(G8_SB(0, 1), cB + hstepB); G8_STAGEA(G8_SA(0, 0), ac, 0, 0); G8_STAGEA(G8_SA(0, 1), ac, 1, 0);
    if (wr == 1) G8_BAR;
    G8_WAIT_V(2); G8_BAR;
    G8_STAGEB(G8_SB(1, 0), cB + kstep); G8_STAGEA(G8_SA(1, 0), ac, 0, kstep); G8_STAGEB(G8_SB(1, 1), cB + hstepB + kstep);
    G8_WAIT_V(6); G8_BAR;
    for (;;) {
        const bool has_next = S.next(ui + 1, nxt);
        const char* nB = has_next ? nxt.B : cB;
#pragma unroll 1
        for (int t = 0; t < nt; t += 2) {
            const bool last = (t == nt - 2);
            const unsigned k1 = (unsigned)(t + 1) * kstep;
            const unsigned k2 = last ? 0u : (unsigned)(t + 2) * kstep;
            const unsigned k3 = k2 + kstep;
            const char* b2 = last ? nB : cB + k2; const char* b3 = b2 + kstep;
            G8_LDB(B0, 0, 0); G8_LDB(B1, 0, 1); G8_SCHED; G8_LDA(At, 0, 0); G8_STAGEA(G8_SA(1, 1), ac, 1, k1);
            if (last && has_next) {
                ac[0][0] = S.rowoff(nxt, R0) + (unsigned)C0 * 2u; ac[0][1] = S.rowoff(nxt, R1) + (unsigned)C1 * 2u;
                ac[1][0] = S.rowoff(nxt, HALF + R0) + (unsigned)C0 * 2u; ac[1][1] = S.rowoff(nxt, HALF + R1) + (unsigned)C1 * 2u;
            }
            G8_WAIT_V(8); G8_WAIT_L(0); G8_BAR; G8_MMA(0, 0, At, B0); G8_MMA(0, 1, At, B1); G8_BAR; G8_SCHED;
            G8_LDA(At, 0, 1); G8_STAGEB(G8_SB(0, 0), b2); G8_STAGEB(G8_SB(0, 1), b2 + hstepB); G8_STAGEA(G8_SA(0, 0), ac, 0, k2);
            G8_WAIT_V(8); G8_WAIT_L(0); G8_BAR; G8_MMA(1, 0, At, B0); G8_MMA(1, 1, At, B1); G8_BAR; G8_SCHED;
            G8_LDB(B0, 1, 0); G8_LDB(B1, 1, 1); G8_SCHED; G8_LDA(At, 1, 0); G8_STAGEA(G8_SA(0, 1), ac, 1, k2);
            G8_WAIT_V(8); G8_WAIT_L(0); G8_BAR; G8_MMA(0, 0, At, B0); G8_MMA(0, 1, At, B1); G8_BAR; G8_SCHED;
            G8_LDA(At, 1, 1); G8_STAGEB(G8_SB(1, 0), b3); G8_STAGEB(G8_SB(1, 1), b3 + hstepB); G8_STAGEA(G8_SA(1, 0), ac, 0, k3);
            G8_WAIT_V(8); G8_WAIT_L(0); G8_BAR; G8_MMA(1, 0, At, B0); G8_MMA(1, 1, At, B1); G8_BAR; G8_SCHED;
        }
        if (wr == 0) G8_BAR;
        E(acc, cur, wr, wc, fr, fq);
        if (!has_next) break;
#pragma unroll
        for (int a = 0; a < 2; ++a)
#pragma unroll
            for (int b = 0; b < 2; ++b)
#pragma unroll
                for (int m = 0; m < 4; ++m)
#pragma unroll
                    for (int n = 0; n < 2; ++n) acc[a][b][m][n] = (f32x4){0.f, 0.f, 0.f, 0.f};
        cur = nxt; cB = nB; ++ui;
        if (wr == 1) G8_BAR;
    }
    G8_WAIT_V(0);
    G8_BAR;
#undef G8_SA
#undef G8_SB
#undef G8_STAGEA
#undef G8_STAGEB
#undef G8_LDA
#undef G8_LDB
#undef G8_MMA
#undef G8_WAIT_V
#undef G8_WAIT_L
#undef G8_BAR
#undef G8_SCHED
}
}

struct CvDesc { const float* W; bf16* WT; int ldw, ldo, k0, n0, kind, aux; };
struct RmId   { __device__ __forceinline__ int operator()(int n) const { return n; } };
struct RmGate { int up; __device__ __forceinline__ int operator()(int h) const { return 256 * (h >> 7) + 128 * ((h >> 2) & 1) + 32 * ((h >> 5) & 3) + 16 * up + 4 * ((h >> 3) & 3) + (h & 3); } };
struct RmPerm { __device__ __forceinline__ int operator()(int c) const { const int q = c & 31; return (c & ~31) + 16 * ((q >> 2) & 1) + 4 * (q >> 3) + (q & 3); } };
struct RmIn   { __device__ __forceinline__ int operator()(int n) const {
    const bool rope = (n < 512) || (n >= OFF_RQ && n < OFF_RQ + 512);
    const bool tokmaj = (n >= OFF_NK && n < OFF_NV) || (n >= OFF_RG);
    const int d = n & 127; return rope ? ((n & ~127) + 32 * ((d >> 4) & 3) + 16 * (d >> 6) + (d & 15)) : (tokmaj ? RmPerm{}(n) : n); } };

__device__ __forceinline__ int cv_rowmap(const CvDesc& d, int n) { return d.kind == 1 ? RmGate{d.aux}(n) : (d.kind == 2 ? RmPerm{}(n) : (d.kind == 3 ? RmIn{}(n) : n)); }
__device__ __forceinline__ void cv_load(const CvDesc& d, int lane, f32x4 (&buf)[8]) {
    const float* p = d.W + (size_t)(d.k0 + (lane >> 3)) * d.ldw + d.n0 + 4 * (lane & 7);
#pragma unroll
    for (int i = 0; i < 8; ++i) buf[i] = __builtin_nontemporal_load((const f32x4*)(p + (size_t)(8 * i) * d.ldw));
}
__device__ __forceinline__ void cv_store(const CvDesc& d, int lane, const f32x4 (&buf)[8], LAS float* scr) {
#pragma unroll
    for (int i = 0; i < 8; ++i) { LAS float* wp = scr + (8 * i + (lane >> 3)) * 33 + 4 * (lane & 7); wp[0] = buf[i].x; wp[1] = buf[i].y; wp[2] = buf[i].z; wp[3] = buf[i].w; }
    LDS_WAIT(); asm volatile("" ::: "memory");
    const int c = lane & 7;
#pragma unroll
    for (int j = 0; j < 4; ++j) { const int n = (lane >> 3) + 8 * j; const LAS float* sp = scr + (8 * c) * 33 + n;
        u32x4 o; o.x = pk2(sp[0 * 33], sp[1 * 33]); o.y = pk2(sp[2 * 33], sp[3 * 33]); o.z = pk2(sp[4 * 33], sp[5 * 33]); o.w = pk2(sp[6 * 33], sp[7 * 33]);
        *(u32x4*)(d.WT + (size_t)cv_rowmap(d, d.n0 + n) * d.ldo + d.k0 + 8 * c) = o; }
    LDS_WAIT(); asm volatile("" ::: "memory");
}
constexpr int I_E1 = 3 * 32 * 256;
__device__ __forceinline__ CvDesc cv_expert(const Ctx& F, int l, int q) {
    const int mat = q >> 13, r = q & 8191, le = l * 32 + (r >> 8), w = r & 255; CvDesc d;
    if (mat < 2) { d.W = (mat ? F.a->in[19] : F.a->in[18]) + (size_t)le * 1024 * 512; d.ldw = 512; d.WT = (bf16*)(F.ws + WS_WGU) + (size_t)le * 1024 * 1024; d.ldo = 1024; d.kind = 1; d.aux = mat; d.k0 = 64 * (w >> 4); d.n0 = 32 * (w & 15); }
    else { d.W = F.a->in[20] + (size_t)le * 512 * 1024; d.ldw = 1024; d.WT = (bf16*)(F.ws + WS_WDN) + (size_t)le * 1024 * 512; d.ldo = 512; d.kind = 2; d.aux = 0; d.k0 = 64 * (w >> 5); d.n0 = 32 * (w & 31); }
    return d;
}
constexpr int I_IN = 16 * 112, I_OUT = 16 * 32, I_POOL = 4 * 32;
__device__ __forceinline__ CvDesc cv_phase0(const Ctx& F, int r, int nexp) {
    if (r < nexp) return cv_expert(F, r < I_E1 ? 0 : 1, r < I_E1 ? r : r - I_E1);
    r -= nexp; CvDesc d; d.aux = 0;
    if (r < I_IN) { d.W = F.a->in[8]; d.ldw = IN_COLS; d.WT = (bf16*)(F.ws + WS_WIN); d.ldo = 1024; d.kind = 3; d.k0 = 64 * (r / 112); d.n0 = 32 * (r % 112); return d; }
    r -= I_IN;
    if (r < I_OUT) { d.W = F.a->in[9]; d.ldw = 1024; d.WT = (bf16*)(F.ws + WS_WOUT); d.ldo = 1024; d.kind = 2; d.k0 = 64 * (r >> 5); d.n0 = 32 * (r & 31); return d; }
    r -= I_OUT;
    { const int g = r >> 5, q = r & 31; d.W = F.a->in[12] + (size_t)g * 65536; d.ldw = 256; d.WT = (bf16*)(F.ws + WS_WPOOL) + (size_t)g * 65536; d.ldo = 256; d.kind = 2; d.k0 = 64 * (q >> 3); d.n0 = 32 * (q & 7); return d; }
}
#define CV_RUN(first, end, stride, GEN) do { f32x4 bA_[8], bB_[8]; const int end_ = (end), st_ = (stride); \
    for (int it_ = (first); it_ < end_; it_ += 2 * st_) { const bool h1_ = it_ + st_ < end_; \
        const CvDesc dA_ = GEN(it_); const CvDesc dB_ = GEN(h1_ ? it_ + st_ : it_); \
        cv_load(dA_, F.lane, bA_); cv_load(dB_, F.lane, bB_);     \
        cv_store(dA_, F.lane, bA_, scr); if (h1_) cv_store(dB_, F.lane, bB_, scr); } } while (0)
__device__ __forceinline__ void phase0(const Ctx& F) {
    LAS float* sil = (LAS float*)F.lds;
    LAS float* red = (LAS float*)(F.lds + 17 * 1024 * 4);
    float* mod = (float*)(F.ws + WS_MOD);
    for (int it = F.bid; it < 192; it += F.G) {
        const int l = it / 96, col0 = (it % 96) * 64;
        for (int idx = F.tid; idx < 17 * 1024; idx += 512) { const int r = idx >> 10, k = idx & 1023; const float v = r < 16 ? F.a->in[1][r * 1024 + k] : F.a->in[3][k]; sil[idx] = silu_f(v); }
        __syncthreads();
        float a[17];
#pragma unroll
        for (int r = 0; r < 17; ++r) a[r] = 0.f;
        const int k0 = F.wave * 128;
        const float* wp = F.a->in[4] + ((size_t)l * 1024 + k0) * 6144 + col0 + F.lane;
#pragma unroll 2
        for (int kk = 0; kk < 128; kk += 4) {
            float w4[4];
#pragma unroll
            for (int i = 0; i < 4; ++i) w4[i] = wp[(size_t)(kk + i) * 6144];
#pragma unroll
            for (int r = 0; r < 17; ++r) { const f32x4 s4 = *(const LAS f32x4*)(sil + r * 1024 + k0 + kk); a[r] += (s4.x * w4[0] + s4.y * w4[1]) + (s4.z * w4[2] + s4.w * w4[3]); } }
#pragma unroll
        for (int r = 0; r < 17; ++r) red[(F.wave * 17 + r) * 64 + F.lane] = a[r];
        __syncthreads();
        for (int idx = F.tid; idx < 17 * 64; idx += 512) { const int r = idx >> 6, cc = idx & 63; float s = F.a->in[5][l * 6144 + col0 + cc];
#pragma unroll
            for (int w8 = 0; w8 < 8; ++w8) s += red[(w8 * 17 + r) * 64 + cc];
            mod[(size_t)(l * 17 + r) * 6144 + col0 + cc] = s; }
        __syncthreads();
    }
    __syncthreads();
    LAS float* scr = (LAS float*)(F.lds + F.wave * 16384);
    const int gw = F.bid * 8 + F.wave, NGW = F.G * 8;
    const int nexp_items = (F.G == 256) ? I_E1 : 2 * I_E1;
    const int NITEMS = nexp_items + I_IN + I_OUT + I_POOL;
#define CV_GEN0(i_) cv_phase0(F, (i_), nexp_items)
    CV_RUN(gw, NITEMS, NGW, CV_GEN0);
#undef CV_GEN0
}
__device__ __forceinline__ void convert_tail(const Ctx& F, int vc, int first, int lo, int hi) {
    if (F.G != 256) return;
    if (first >= F.G) first = 0;
    if (vc < first) return;
    LAS float* scr = (LAS float*)(F.lds + F.wave * 16384);
    const int nw = (F.G - first) * 8;
#define CV_GEN1(i_) cv_expert(F, 1, (i_))
    CV_RUN(lo + (vc - first) * 8 + F.wave, hi, nw, CV_GEN1);
#undef CV_GEN1
}

__device__ __forceinline__ void p1_load(const Ctx& F, int row, f32x4 (&b)[4]) {
    const float* src = row < T ? F.a->in[0] + (size_t)row * D : F.a->in[2] + (size_t)(row - T) * D;
#pragma unroll
    for (int j = 0; j < 4; ++j) b[j] = *(const f32x4*)(src + 4 * F.lane + 256 * j);
}
__device__ __forceinline__ void p1_row(const Ctx& F, int row, const f32x4 (&v)[4], const f32x4 (&sh)[4], const f32x4 (&sc)[4]) {
    unsigned long long* o8 = (unsigned long long*)((bf16*)(F.ws + WS_XA) + (size_t)row * D) + F.lane;
#pragma unroll
    for (int j = 0; j < 4; ++j) { const f32x4 y = v[j] * sc[j] + sh[j];
        o8[64 * j] = (unsigned long long)pk2(y.x, y.y) | ((unsigned long long)pk2(y.z, y.w) << 32); }
}
__device__ __forceinline__ void phase1(const Ctx& F) {
    const int gw = F.bid * 8 + F.wave, NGW = F.G * 8;
    for (int run = gw; run < T / 16; run += NGW) {
        const int tb = run * 16, cb0 = T + run * 2, b = tb >> 11;
        f32x4 A[4], B[4], C[4], E[4], sh[4], sc[4], sh2[4], sc2[4];
#pragma unroll
        for (int j = 0; j < 4; ++j) { sh[j] = *(const f32x4*)(modp(F, 0, b, 0) + 4 * F.lane + 256 * j); sc[j] = *(const f32x4*)(modp(F, 0, b, 1) + 4 * F.lane + 256 * j) + 1.0f;
            sh2[j] = *(const f32x4*)(modp(F, 0, 16, 0) + 4 * F.lane + 256 * j); sc2[j] = *(const f32x4*)(modp(F, 0, 16, 1) + 4 * F.lane + 256 * j) + 1.0f; }
#define P1_ROWOF(i_) ((i_) < 16 ? tb + (i_) : cb0 + min((i_) - 16, 1))
        p1_load(F, tb, A); p1_load(F, tb + 1, B); p1_load(F, tb + 2, C);
#pragma unroll
        for (int k = 0; k < 16; k += 4) {
            p1_load(F, tb + k + 3, E);
            asm volatile("" ::: "memory"); __builtin_amdgcn_sched_barrier(0);
            p1_row(F, tb + k, A, sh, sc);
            p1_load(F, P1_ROWOF(k + 4), A);
            asm volatile("" ::: "memory"); __builtin_amdgcn_sched_barrier(0);
            p1_row(F, tb + k + 1, B, sh, sc);
            p1_load(F, P1_ROWOF(k + 5), B);
            asm volatile("" ::: "memory"); __builtin_amdgcn_sched_barrier(0);
            p1_row(F, tb + k + 2, C, sh, sc);
            p1_load(F, P1_ROWOF(k + 6), C);
            asm volatile("" ::: "memory"); __builtin_amdgcn_sched_barrier(0);
            p1_row(F, tb + k + 3, E, sh, sc);
        }
#undef P1_ROWOF
        p1_row(F, cb0, A, sh2, sc2);
        p1_row(F, cb0 + 1, B, sh2, sc2);
    }
}

struct SchedIn {
    int G, c; const char* Wt;
    __device__ __forceinline__ bool next(int i, g8::Unit& u) const {
        const int L = i * G + c; if (L >= 1792 + 128) return false;
        int pm, pn; if (L < 1792) g8::tile_of(L, 128, 14, pm, pn); else { g8::tile_of(L - 1792, 16, 8, pm, pn); pm += 128; }
        u.pm = pm; u.pn = pn; u.e = 0; u.aux = 0; u.B = Wt + (size_t)pn * 256 * 1024 * 2; return true; }
    __device__ __forceinline__ unsigned rowoff(const g8::Unit& u, int r) const { return (unsigned)(u.pm * 256 + r) * 2048u; }
};
struct EpiIn {
    unsigned char* ws; unsigned char* dout; LAS unsigned char* lds;
    __device__ __forceinline__ void tstore(const f32x4 (&v)[4], LAS bf16* scr, bf16* dst0, size_t colpitch, int lane, int fr, int fq) const {
#pragma unroll
        for (int m = 0; m < 4; ++m)
#pragma unroll
            for (int j = 0; j < 4; j += 2) { const unsigned w = pk2(v[m][j], v[m][j + 1]); scr[(4 * fq + j) * 72 + 16 * m + fr] = (bf16)(w & 0xffffu); scr[(4 * fq + j + 1) * 72 + 16 * m + fr] = (bf16)(w >> 16); }
        LDS_WAIT(); asm volatile("" ::: "memory");
#pragma unroll
        for (int i = 0; i < 2; ++i) { const int q = lane + 64 * i, cc = q >> 3, ch = q & 7;
            const u32x4 w = *(const LAS u32x4*)(scr + cc * 72 + ch * 8);
            *(u32x4*)(dst0 + (size_t)cc * colpitch + ch * 8) = w; }
        LDS_WAIT(); asm volatile("" ::: "memory");
    }
    __device__ __forceinline__ void operator()(const f32x4 (&acc)[2][2][4][2], const g8::Unit& u, int wr, int wc, int fr, int fq) const {
        const bool isctx = u.pm >= 128;
        const int lane = fr + 16 * fq, wid = wr * 4 + wc;
        LAS bf16* scr = (LAS bf16*)(lds + LDS_SCR_OFF + wid * 2304);
        const int row0 = u.pm * 256 + wr * 64 + fr;
        const int bb = isctx ? (u.pm - 128) : (u.pm >> 3);
        const int tt0 = isctx ? 0 : ((u.pm & 7) * 256);
        const size_t tp = isctx ? CTXL : TPITCH;
        const int pn = u.pn;
        if (pn < 2 || pn == 8 || pn == 9) {
            const float scale = (pn >= 8) ? 0.08838834764831845f : 1.0f;
            const int dd = 16 * wc + 4 * fq;
            f32x4 invf;
#pragma unroll
            for (int j = 0; j < 4; ++j) invf[j] = fexp2(-(float)((dd & 31) + j) * (13.287712379549449f / 32.0f));
#pragma unroll
            for (int ai = 0; ai < 2; ++ai)
#pragma unroll
                for (int bj = 0; bj < 2; ++bj) {
                    f32x4 o1[4], o2[4];
#pragma unroll
                    for (int m = 0; m < 4; ++m) { const int row = row0 + ai * 128 + m * 16;
                        f32x4 cs = (f32x4){1.f, 1.f, 1.f, 1.f}, sn = (f32x4){0.f, 0.f, 0.f, 0.f};
                        if (!isctx) { const float pos = (float)((wc < 2) ? (4 * (u.pm & 7) + wr + 2 * ai) : (fr + 16 * m));
#pragma unroll
                            for (int j = 0; j < 4; ++j) { const float ang = pos * invf[j]; cs[j] = __cosf(ang); sn[j] = __sinf(ang); } }
                        const f32x4 x1 = acc[ai][bj][m][0], x2 = acc[ai][bj][m][1];
                        o1[m] = (x1 * cs - x2 * sn) * scale; o2[m] = (x1 * sn + x2 * cs) * scale;
                        if (!isctx) { bf16* rp = (bf16*)(ws + WS_P) + (size_t)row * PW + (pn < 2 ? PO_RK + pn * 256 : PO_RQ + (pn - 8) * 256) + bj * 128 + dd;
                            *(u32x2*)(rp) = (u32x2){pk2(o1[m].x, o1[m].y), pk2(o1[m].z, o1[m].w)};
                            *(u32x2*)(rp + 64) = (u32x2){pk2(o2[m].x, o2[m].y), pk2(o2[m].z, o2[m].w)}; } }
                    if (pn < 2) {
                        const int head = pn * 2 + bj;
                        bf16* d0 = (bf16*)(dout + (isctx ? DO_KTRC : DO_KTR)) + ((size_t)(bb * 4 + head) * 128 + 16 * wc) * tp + tt0 + ai * 128 + wr * 64;
                        tstore(o1, scr, d0, tp, lane, fr, fq);
                        tstore(o2, scr, d0 + (size_t)64 * tp, tp, lane, fr, fq);
                    }
                }
        } else if (pn == 2 || pn == 3 || pn == 6 || pn == 7) {
#pragma unroll
            for (int ai = 0; ai < 2; ++ai)
#pragma unroll
                for (int bj = 0; bj < 2; ++bj)
#pragma unroll
                    for (int n = 0; n < 2; ++n) {
                        const int col = (pn & 1) * 256 + bj * 128 + wc * 32 + n * 16;
                        const size_t boff = (pn < 4) ? (isctx ? WS_VTRC : WS_VTR) : (isctx ? WS_VTNC : WS_VTN);
                        const size_t roff = (pn < 4) ? ((size_t)(bb * 4 + (col >> 7)) * 128 + (col & 127)) : ((size_t)(bb * 8 + (col >> 6)) * 64 + (col & 63));
                        bf16* d0 = (bf16*)(ws + boff) + roff * tp;
                        f32x4 v[4];
#pragma unroll
                        for (int m = 0; m < 4; ++m) v[m] = acc[ai][bj][m][n];
                        tstore(v, scr, d0 + tt0 + ai * 128 + wr * 64, tp, lane, fr, fq);
                    }
        } else {
            const float scale = (pn >= 12) ? 0.125f * 1.4426950408889634f : 1.0f;
            int ld = PW, c0; size_t boff = WS_P;
            if (pn < 6) { if (isctx) { boff = WS_PC; ld = PCW; } c0 = (isctx ? 0 : PO_NK) + (pn - 4) * 256; }
            else if (pn < 12) { c0 = PO_RG + (pn - 10) * 256; }
            else { c0 = PO_NQ + (pn - 12) * 256; }
            bf16* base = (bf16*)(ws + boff);
            const int rsub = isctx ? T : 0;
            const int col0 = c0 + wc * 32 + 8 * fq;
#pragma unroll
            for (int ai = 0; ai < 2; ++ai)
#pragma unroll
                for (int m = 0; m < 4; ++m) { bf16* rp = base + (size_t)(row0 + ai * 128 + m * 16 - rsub) * ld + col0;
#pragma unroll
                    for (int bj = 0; bj < 2; ++bj) { const f32x4 v0 = acc[ai][bj][m][0] * scale, v1 = acc[ai][bj][m][1] * scale;
                        *(u32x4*)(rp + bj * 128) = (u32x4){pk2(v0.x, v0.y), pk2(v0.z, v0.w), pk2(v1.x, v1.y), pk2(v1.z, v1.w)}; } }
        }
    }
};

__device__ __forceinline__ void dma16(const void* g, LAS unsigned char* l) { __builtin_amdgcn_global_load_lds((const unsigned*)g, (LAS unsigned*)l, 16, 0, 0); }
__device__ __forceinline__ bf16x8 frag256(const LAS unsigned char* tile, int row, int chunk) { return *(const LAS bf16x8*)(tile + row * 256 + ((chunk ^ (row & 15)) << 4)); }
__device__ __forceinline__ void phase3(const Ctx& F) {
    const bf16* KTr = (const bf16*)((const char*)F.H + DO_KTR); const bf16* KTrc = (const bf16*)((const char*)F.H + DO_KTRC);
    const bf16* VTr = (const bf16*)(F.ws + WS_VTR); const bf16* VTrc = (const bf16*)(F.ws + WS_VTRC);
    bf16* ST = (bf16*)((char*)F.H + DO_ST);
    const int lane = F.lane, r = lane & 31, hh = lane >> 5, dkt = F.wave & 3, dvs = F.wave >> 2, w = F.wave;
    for (int u0 = F.bid; u0 < 256; u0 += F.G) {
        const int unit = (F.G == 256) ? ((u0 & 7) * 32 + (u0 >> 3)) : u0;
        const int bh = unit >> 2, dvh = (unit >> 1) & 1, dir = unit & 1, h = bh & 3;
        const float lg2 = __log2f(1.0f - __expf(F.a->in[10][dir * 4 + h]));
        const float gstep = fexp2(dir == 0 ? -lg2 : lg2);
        const float cdec = fexp2(lg2 * 128.0f);
        f32x16 acc;
#pragma unroll
        for (int i = 0; i < 16; ++i) acc[i] = 0.f;
        __syncthreads();
#define P3_STAGE(s_) do { const int s__ = (s_); const bool cx = s__ < 2; const int ci = cx ? (dir == 0 ? s__ : 1 - s__) : (dir == 0 ? s__ - 2 : 17 - s__); \
            const bf16* kb = cx ? KTrc + (size_t)bh * 128 * CTXL + ci * 128 : KTr + (size_t)bh * 128 * TPITCH + ci * 128; \
            const bf16* vb = cx ? VTrc + ((size_t)bh * 128 + dvh * 64) * CTXL + ci * 128 : VTr + ((size_t)bh * 128 + dvh * 64) * TPITCH + ci * 128; \
            const size_t pitch = cx ? (size_t)CTXL : (size_t)TPITCH; \
            _Pragma("unroll") for (int i = 0; i < 6; ++i) { const int idx = (i < 4 ? i : i - 4) * 512 + w * 64 + lane, R = idx >> 4, cc = (idx & 15) ^ (R & 15); \
                dma16((i < 4 ? kb : vb) + (size_t)R * pitch + 8 * cc, F.lds + (s__ % 3) * 49152 + (i * 512 + w * 64) * 16); } } while (0)
        P3_STAGE(0); P3_STAGE(1);
#pragma unroll 1
        for (int s = 0; s < 18; ++s) {
            if (s >= 2) {
                const int c = dir == 0 ? s - 2 : 17 - s;
                bf16* sp = ST + ((((size_t)dir * 64 + bh) * 16 + c) * 128 + dvh * 64 + dvs * 32 + r) * 128 + dkt * 32 + 4 * hh;
#pragma unroll
                for (int g = 0; g < 4; ++g) *(u32x2*)(sp + 8 * g) = (u32x2){pk2(acc[4 * g], acc[4 * g + 1]), pk2(acc[4 * g + 2], acc[4 * g + 3])};
            }
            if (s < 2) asm volatile("s_waitcnt vmcnt(6)" ::: "memory"); else if (s < 17) asm volatile("s_waitcnt vmcnt(10)" ::: "memory"); else asm volatile("s_waitcnt vmcnt(0)" ::: "memory");
            __builtin_amdgcn_s_barrier(); asm volatile("" ::: "memory");
            if (s < 16) P3_STAGE(s + 2);
            if (s < 17) {
#pragma unroll
                for (int i = 0; i < 16; ++i) acc[i] *= cdec;
                const LAS unsigned char* kt = F.lds + (s % 3) * 49152; const LAS unsigned char* vt = kt + 32768;
#pragma unroll
                for (int ks = 0; ks < 8; ++ks) {
                    const bf16x8 af = frag256(kt, 32 * dkt + r, 2 * ks + hh); const bf16x8 vv = frag256(vt, 32 * dvs + r, 2 * ks + hh); bf16x8 bfr;
                    const int tk = 16 * ks + 8 * hh; float wgt = fexp2(lg2 * (float)(dir == 0 ? (127 - tk) : tk));
                    float wv8[8];
#pragma unroll
                    for (int j = 0; j < 8; ++j) { wv8[j] = bf2f((unsigned short)vv[j]) * wgt; wgt *= gstep; }
                    bfr = pack8((f32x4){wv8[0], wv8[1], wv8[2], wv8[3]}, (f32x4){wv8[4], wv8[5], wv8[6], wv8[7]});
                    acc = __builtin_amdgcn_mfma_f32_32x32x16_bf16(af, bfr, acc, 0, 0, 0);
                }
            }
        }
        asm volatile("s_waitcnt vmcnt(0) lgkmcnt(0)" ::: "memory");
        __syncthreads();
#undef P3_STAGE
    }
}

__device__ __forceinline__ void ret_unit(const Ctx& F, int unit) {
    const bf16* P = (const bf16*)(F.ws + WS_P); const bf16* ST = (const bf16*)((const char*)F.H + DO_ST); const bf16* VTr = (const bf16*)(F.ws + WS_VTR); bf16* Y = (bf16*)(F.ws + WS_XA);
    int lane = F.lane; asm volatile("" : "+v"(lane));
    const int li = lane & 15, kq = lane >> 4, w = F.wave;
    const int b = unit >> 6, h = (unit >> 4) & 3, c = unit & 15, bh = b * 4 + h;
    const size_t tok0 = (size_t)b * SEQ + c * 128;
    const int i0 = 16 * w;
    const float lgf = __log2f(1.0f - __expf(F.a->in[10][h])), lgb = __log2f(1.0f - __expf(F.a->in[10][4 + h]));
    constexpr int T_ST0 = 0, T_K = 65536, T_V = 98304;
    __syncthreads();
#pragma unroll
    for (int i = 0; i < 16; ++i) { const int tile = i >> 2; const int idx = (i & 3) * 512 + w * 64 + lane, R = idx >> 4, cc = (idx & 15) ^ (R & 15);
        const bf16* src;
        if (tile < 2) src = ST + ((((size_t)tile * 64 + bh) * 16 + c) * 128 + R) * 128 + 8 * cc;
        else if (tile == 2) src = P + (tok0 + R) * PW + PO_RK + h * 128 + 8 * cc;
        else src = VTr + ((size_t)bh * 128 + R) * TPITCH + c * 128 + 8 * cc;
        dma16(src, F.lds + (i * 512 + w * 64) * 16); }
    bf16x8 qf[4];
    { const bf16* qp = P + (tok0 + i0 + li) * PW + PO_RQ + h * 128 + 8 * kq;
#pragma unroll
      for (int ks = 0; ks < 4; ++ks) qf[ks] = *(const bf16x8*)(qp + 32 * ks); }
    asm volatile("s_waitcnt vmcnt(0)" ::: "memory");
    __syncthreads();
    f32x4 O[8];
#pragma unroll
    for (int dirn = 0; dirn < 2; ++dirn) {
        const LAS unsigned char* tl = F.lds + T_ST0 + dirn * 32768;
        float rs[4];
#pragma unroll
        for (int jj = 0; jj < 4; ++jj) { const int i = i0 + 4 * kq + jj; rs[jj] = dirn == 0 ? fexp2(lgf * (float)(i + 1)) : fexp2(lgb * (float)(128 - i)); }
#pragma unroll
        for (int nt = 0; nt < 8; ++nt) { f32x4 a = (f32x4){0.f, 0.f, 0.f, 0.f};
#pragma unroll
            for (int ks = 0; ks < 4; ++ks) a = __builtin_amdgcn_mfma_f32_16x16x32_bf16(qf[ks], frag256(tl, 16 * nt + li, 4 * ks + kq), a, 0, 0, 0);
#pragma unroll
            for (int jj = 0; jj < 4; ++jj) { const float v = a[jj] * rs[jj]; if (dirn == 0) O[nt][jj] = v; else O[nt][jj] += v; } }
    }
    bf16x8 pf[4];
    const int krow = 8 * (li >> 2) + (li & 3);
#pragma unroll
    for (int u = 0; u < 4; ++u) {
        f32x4 s2[2];
#pragma unroll
        for (int hf = 0; hf < 2; ++hf) { f32x4 a = (f32x4){0.f, 0.f, 0.f, 0.f};
#pragma unroll
            for (int ks = 0; ks < 4; ++ks) a = __builtin_amdgcn_mfma_f32_16x16x32_bf16(frag256(F.lds + T_K, 32 * u + krow + 4 * hf, 4 * ks + kq), qf[ks], a, 0, 0, 0);
#pragma unroll
            for (int jj = 0; jj < 4; ++jj) { const int dlt = (i0 + li) - (32 * u + 8 * kq + 4 * hf + jj);
                const float ex = fexp2((dlt > 0 ? lgf : lgb) * fabsf((float)dlt));
                a[jj] *= (dlt == 0) ? 2.0f : ex; }
            s2[hf] = a; }
        pf[u] = pack8(s2[0], s2[1]);
    }
#pragma unroll
    for (int u = 0; u < 4; ++u)
#pragma unroll
        for (int nt = 0; nt < 8; ++nt) O[nt] = __builtin_amdgcn_mfma_f32_16x16x32_bf16(pf[u], frag256(F.lds + T_V, 16 * nt + li, 4 * u + kq), O[nt], 0, 0, 0);
    __syncthreads();
    LAS float* osc = (LAS float*)(F.lds + w * 8448);
#pragma unroll
    for (int jj = 0; jj < 4; ++jj) {
        float sm = 0.f;
#pragma unroll
        for (int nt = 0; nt < 8; ++nt) sm += O[nt][jj];
        sm += __shfl_xor(sm, 1); sm += __shfl_xor(sm, 2); sm += __shfl_xor(sm, 4); sm += __shfl_xor(sm, 8);
        const float mean = sm * (1.0f / 128.0f); float q = 0.f;
#pragma unroll
        for (int nt = 0; nt < 8; ++nt) { const float d = O[nt][jj] - mean; q += d * d; }
        q += __shfl_xor(q, 1); q += __shfl_xor(q, 2); q += __shfl_xor(q, 4); q += __shfl_xor(q, 8);
        const float rstd = __builtin_amdgcn_rsqf(q * (1.0f / 128.0f) + LN_EPS);
#pragma unroll
        for (int nt = 0; nt < 8; ++nt) osc[(4 * kq + jj) * 132 + 16 * nt + li] = (O[nt][jj] - mean) * rstd;
    }
    LDS_WAIT(); asm volatile("" ::: "memory");
#pragma unroll
    for (int i = 0; i < 4; ++i) { const int q = lane + 64 * i, row = q >> 4, ch = q & 15; const size_t tk = tok0 + i0 + row;
        const f32x4 a = *(const LAS f32x4*)(osc + row * 132 + 8 * ch), c2 = *(const LAS f32x4*)(osc + row * 132 + 8 * ch + 4);
        const u32x4 g = *(const u32x4*)(P + tk * PW + PO_RG + h * 128 + 8 * ch);
        u32x4 o;
        o.x = pk2(silu_f(bflo(g.x)) * a.x, silu_f(bfhi(g.x)) * a.y); o.y = pk2(silu_f(bflo(g.y)) * a.z, silu_f(bfhi(g.y)) * a.w);
        o.z = pk2(silu_f(bflo(g.z)) * c2.x, silu_f(bfhi(g.z)) * c2.y); o.w = pk2(silu_f(bflo(g.w)) * c2.z, silu_f(bfhi(g.w)) * c2.w);
        if (ABL & 32) o = (u32x4){0u, 0u, 0u, 0u};
        *(u32x4*)(Y + tk * D + h * 128 + 8 * ch) = o; }
    LDS_WAIT(); asm volatile("" ::: "memory");
}
__device__ __forceinline__ void aload16(u32x4& v, const void* p) { asm volatile("global_load_dwordx4 %0, %1, off" : "=&v"(v) : "v"(p) : "memory"); }
__device__ __forceinline__ void ret_issueA(const Ctx& F, int unit) {
    const bf16* ST = (const bf16*)((const char*)F.H + DO_ST);
    const int bh = unit >> 4, c = unit & 15, w = F.wave, lane = F.lane;
#pragma unroll
    for (int i = 0; i < 8; ++i) { const int tile = i >> 2; const int idx = (i & 3) * 512 + w * 64 + lane, R = idx >> 4, cc = (idx & 15) ^ (R & 15);
        dma16(ST + ((((size_t)tile * 64 + bh) * 16 + c) * 128 + R) * 128 + 8 * cc, F.lds + (i * 512 + w * 64) * 16); }
}
__device__ __forceinline__ void ret_issueB(const Ctx& F, int unit) {
    const bf16* P = (const bf16*)(F.ws + WS_P); const bf16* VTr = (const bf16*)(F.ws + WS_VTR);
    const int bh = unit >> 4, b = unit >> 6, h = (unit >> 4) & 3, c = unit & 15, w = F.wave, lane = F.lane;
    const size_t tok0 = (size_t)b * SEQ + c * 128;
#pragma unroll
    for (int i = 8; i < 16; ++i) { const int idx = (i & 3) * 512 + w * 64 + lane, R = idx >> 4, cc = (idx & 15) ^ (R & 15);
        const bf16* src = (i < 12) ? P + (tok0 + R) * PW + PO_RK + h * 128 + 8 * cc : VTr + ((size_t)bh * 128 + R) * TPITCH + c * 128 + 8 * cc;
        dma16(src, F.lds + (i * 512 + w * 64) * 16); }
}
__device__ __forceinline__ void ret_loadq(const Ctx& F, int unit, u32x4 (&qv)[4]) {
    const bf16* P = (const bf16*)(F.ws + WS_P);
    const int b = unit >> 6, h = (unit >> 4) & 3, c = unit & 15, li = F.lane & 15, kq = F.lane >> 4;
    const bf16* qp = P + ((size_t)b * SEQ + c * 128 + 16 * F.wave + li) * PW + PO_RQ + h * 128 + 8 * kq;
#pragma unroll
    for (int ks = 0; ks < 4; ++ks) aload16(qv[ks], qp + 32 * ks);
}
#define RET_FENCE() asm volatile("" ::: "memory")
template <bool FIRST> __device__ __forceinline__ void ret_iter(const Ctx& F, int unit, int nxt, bf16x8 (&qf)[4]) {
    const bf16* P = (const bf16*)(F.ws + WS_P); bf16* Y = (bf16*)(F.ws + WS_XA);
    int lane = F.lane; asm volatile("" : "+v"(lane));
    const int li = lane & 15, kq = lane >> 4, w = F.wave;
    const int b = unit >> 6, h = (unit >> 4) & 3, c = unit & 15;
    const size_t tok0 = (size_t)b * SEQ + c * 128;
    const int i0 = 16 * w;
    const float lgf = ((const LAS float*)(F.lds + LDS_TAB_OFF))[h], lgb = ((const LAS float*)(F.lds + LDS_TAB_OFF))[4 + h];
    constexpr int T_K = 65536, T_V = 98304;
    const int krow = 8 * (li >> 2) + (li & 3);
    RET_FENCE();
    f32x4 O[8];
#pragma unroll
    for (int dirn = 0; dirn < 2; ++dirn) {
        const LAS unsigned char* tl = F.lds + dirn * 32768;
        const float rs = dirn == 0 ? fexp2(lgf * (float)(i0 + li + 1)) : fexp2(lgb * (float)(128 - i0 - li));
#pragma unroll
        for (int nt = 0; nt < 8; ++nt) { f32x4 a = (f32x4){0.f, 0.f, 0.f, 0.f};
#pragma unroll
            for (int ks = 0; ks < 4; ++ks) a = __builtin_amdgcn_mfma_f32_16x16x32_bf16(frag256(tl, 32 * (nt >> 1) + krow + 4 * (nt & 1), 4 * ks + kq), qf[ks], a, 0, 0, 0);
            if (dirn == 0) O[nt] = a * rs; else O[nt] += a * rs; }
    }
    RET_FENCE(); __builtin_amdgcn_s_barrier(); RET_FENCE();
    ret_issueA(F, nxt);
    RET_FENCE();
    if (FIRST) asm volatile("s_waitcnt vmcnt(8)" ::: "memory"); else asm volatile("s_waitcnt vmcnt(12)" ::: "memory");
    __builtin_amdgcn_s_barrier(); RET_FENCE();
    u32x4 g[4];
    { const bf16* gp = P + (tok0 + i0 + li) * PW + PO_RG + h * 128 + 8 * kq;
#pragma unroll
      for (int t = 0; t < 4; ++t) aload16(g[t], gp + 32 * t); }
    RET_FENCE();
    bf16x8 pf[4];
#pragma unroll
    for (int u = 0; u < 4; ++u) {
        f32x4 s2[2];
#pragma unroll
        for (int hf = 0; hf < 2; ++hf) { f32x4 a = (f32x4){0.f, 0.f, 0.f, 0.f};
#pragma unroll
            for (int ks = 0; ks < 4; ++ks) a = __builtin_amdgcn_mfma_f32_16x16x32_bf16(frag256(F.lds + T_K, 32 * u + krow + 4 * hf, 4 * ks + kq), qf[ks], a, 0, 0, 0);
#pragma unroll
            for (int jj = 0; jj < 4; ++jj) { const int dlt = (i0 + li) - (32 * u + 8 * kq + 4 * hf + jj);
                const float ex = fexp2((dlt > 0 ? lgf : lgb) * fabsf((float)dlt));
                a[jj] *= (dlt == 0) ? 2.0f : ex; }
            s2[hf] = a; }
        pf[u] = pack8(s2[0], s2[1]);
    }
#pragma unroll
    for (int u = 0; u < 4; ++u)
#pragma unroll
        for (int nt = 0; nt < 8; ++nt) O[nt] = __builtin_amdgcn_mfma_f32_16x16x32_bf16(frag256(F.lds + T_V, 32 * (nt >> 1) + krow + 4 * (nt & 1), 4 * u + kq), pf[u], O[nt], 0, 0, 0);
    RET_FENCE(); __builtin_amdgcn_s_barrier(); RET_FENCE();
    u32x4 qn[4];
    ret_loadq(F, nxt, qn);
    RET_FENCE();
    ret_issueB(F, nxt);
    RET_FENCE();
    float sm = 0.f;
#pragma unroll
    for (int nt = 0; nt < 8; ++nt) sm += (O[nt].x + O[nt].y) + (O[nt].z + O[nt].w);
    sm += __shfl_xor(sm, 16); sm += __shfl_xor(sm, 32);
    const float mean = sm * (1.0f / 128.0f); float q = 0.f;
#pragma unroll
    for (int nt = 0; nt < 8; ++nt) { O[nt] = O[nt] - mean; q += (O[nt].x * O[nt].x + O[nt].y * O[nt].y) + (O[nt].z * O[nt].z + O[nt].w * O[nt].w); }
    q += __shfl_xor(q, 16); q += __shfl_xor(q, 32);
    const float rstd = __builtin_amdgcn_rsqf(q * (1.0f / 128.0f) + LN_EPS);
    bf16* yp = Y + (tok0 + i0 + li) * D + h * 128 + 8 * kq;
    asm volatile("s_waitcnt vmcnt(12)" : "+v"(g[0]), "+v"(g[1]), "+v"(g[2]), "+v"(g[3]) :: "memory");
#pragma unroll
    for (int t = 0; t < 4; ++t) { const f32x4 a = O[2 * t] * rstd, c2 = O[2 * t + 1] * rstd; const u32x4 gg = g[t];
        u32x4 o;
        o.x = pk2(silu_f(bflo(gg.x)) * a.x, silu_f(bfhi(gg.x)) * a.y); o.y = pk2(silu_f(bflo(gg.y)) * a.z, silu_f(bfhi(gg.y)) * a.w);
        o.z = pk2(silu_f(bflo(gg.z)) * c2.x, silu_f(bfhi(gg.z)) * c2.y); o.w = pk2(silu_f(bflo(gg.w)) * c2.z, silu_f(bfhi(gg.w)) * c2.w);
        if (ABL & 32) o = (u32x4){0u, 0u, 0u, 0u};
        *(u32x4*)(yp + 32 * t) = o; }
    RET_FENCE();
    asm volatile("s_waitcnt vmcnt(12)" : "+v"(qn[0]), "+v"(qn[1]), "+v"(qn[2]), "+v"(qn[3]) :: "memory");
    __builtin_amdgcn_s_barrier(); RET_FENCE();
#pragma unroll
    for (int ks = 0; ks < 4; ++ks) qf[ks] = __builtin_bit_cast(bf16x8, qn[ks]);
}
__device__ __forceinline__ void ret_phase(const Ctx& F) {
    int u = F.bid; if (u >= 1024) return;
    __syncthreads();
    if (F.tid < 8) ((LAS float*)(F.lds + LDS_TAB_OFF))[F.tid] = __log2f(1.0f - __expf(F.a->in[10][F.tid]));
    asm volatile("s_waitcnt vmcnt(0) lgkmcnt(0)" ::: "memory");
    __syncthreads();
    bf16x8 qf[4];
    { u32x4 q0[4];
      ret_issueA(F, u); RET_FENCE(); ret_loadq(F, u, q0); RET_FENCE(); ret_issueB(F, u); RET_FENCE();
      asm volatile("s_waitcnt vmcnt(8)" : "+v"(q0[0]), "+v"(q0[1]), "+v"(q0[2]), "+v"(q0[3]) :: "memory");
      __builtin_amdgcn_s_barrier(); RET_FENCE();
#pragma unroll
      for (int ks = 0; ks < 4; ++ks) qf[ks] = __builtin_bit_cast(bf16x8, q0[ks]); }
    { const int nxt = u + F.G < 1024 ? u + F.G : u; ret_iter<true>(F, u, nxt, qf); u += F.G; }
#pragma unroll 1
    for (; u < 1024; u += F.G) { const int nxt = u + F.G < 1024 ? u + F.G : u; ret_iter<false>(F, u, nxt, qf); }
    asm volatile("s_waitcnt vmcnt(0)" ::: "memory");
    __syncthreads();
}
#undef RET_FENCE
__device__ __forceinline__ void na_unit(const Ctx& F, int unit, bool load_ctx) {
    const bf16* P = (const bf16*)(F.ws + WS_P); const bf16* Pc = (const bf16*)(F.ws + WS_PC); bf16* Y = (bf16*)(F.ws + WS_XA);
    const bf16* VTn = (const bf16*)(F.ws + WS_VTN); const bf16* VTnc = (const bf16*)(F.ws + WS_VTNC);
    int lane = F.lane; asm volatile("" : "+v"(lane));
    const int li = lane & 15, kq = lane >> 4, w = F.wave;
    const int b = unit >> 7, nh = (unit >> 4) & 7, rp = unit & 15;
    const int r = 2 * rp + (w >> 2), cb = w & 3;
    const int rmin = min(max(2 * rp - 4, 0), GROWS - 8);
    const int r0 = min(max(r - 4, 0), GROWS - 8), kstart = min(max(16 * cb - 8, 0), GRIDW - 32);
    const int qc = 16 * cb + li; const int wstart = min(max(qc - 8, 0), GRIDW - 16);
    const size_t tokb = (size_t)b * SEQ;
    const int krow = 8 * (li >> 2) + (li & 3);
    constexpr int L_CTX = 73728, L_TBL = 106496, L_CTXV = 108544;
    __syncthreads();
#pragma unroll
    for (int i = 0; i < 13; ++i) { const int idx = i * 512 + w * 64 + lane; const bf16* src;
        if (i < 9) { const int R = idx >> 3, cc = (idx & 7) ^ (R & 7); const int kr = min(rmin + (R >> 6), GROWS - 1);
            src = P + (tokb + kr * 64 + (R & 63)) * PW + PO_NK + nh * 64 + 8 * cc; }
        else { if (!load_ctx) continue; const int id2 = idx - 4608, R = id2 >> 3, cc = (id2 & 7) ^ (R & 7); src = Pc + ((size_t)b * CTXL + R) * PCW + nh * 64 + 8 * cc; }
        dma16(src, F.lds + (i * 512 + w * 64) * 16); }
    if (load_ctx) {
#pragma unroll
        for (int i = 0; i < 4; ++i) { const int id2 = i * 512 + w * 64 + lane, Rd = id2 >> 5, cc = (id2 & 31) ^ (Rd & 7);
            dma16(VTnc + ((size_t)(b * 8 + nh) * 64 + Rd) * CTXL + 8 * cc, F.lds + L_CTXV + (i * 512 + w * 64) * 16); } }
    LAS float* tbl = (LAS float*)(F.lds + L_TBL);
    for (int q = F.tid; q < 15 * 32; q += 512) { const int rr = q >> 5, cc = q & 31; tbl[q] = cc < 31 ? F.a->in[11][(size_t)(nh * 15 + rr) * 31 + cc] * 1.4426950408889634f : -3.0e38f; }
    bf16x8 qf[2];
    { const bf16* qp = P + (tokb + r * 64 + qc) * PW + PO_NQ + nh * 64 + 8 * kq; qf[0] = *(const bf16x8*)qp; qf[1] = *(const bf16x8*)(qp + 32); }
    asm volatile("s_waitcnt vmcnt(0)" ::: "memory");
    __syncthreads();
    int cidx[8];
#pragma unroll
    for (int o = 0; o < 8; ++o) { const int kc = kstart + 8 * kq + o; const bool ok = (kc >= wstart) && (kc < wstart + 16); cidx[o] = ok ? (kc - qc + 15) : 31; }
    f32x4 sw[16], sc[16];
    float mx = -3.0e38f;
#pragma unroll
    for (int wt = 0; wt < 16; ++wt) {
        const int kr = r0 + (wt >> 1);
        f32x4 a;
#pragma unroll
        for (int jj = 0; jj < 4; ++jj) a[jj] = tbl[(kr - r + 7) * 32 + cidx[4 * (wt & 1) + jj]];
        const int R = (kr - rmin) * 64 + kstart + krow + 4 * (wt & 1);
        const LAS unsigned char* rowp = F.lds + R * 128;
        a = __builtin_amdgcn_mfma_f32_16x16x32_bf16(*(const LAS bf16x8*)(rowp + ((kq ^ (R & 7)) << 4)), qf[0], a, 0, 0, 0);
        a = __builtin_amdgcn_mfma_f32_16x16x32_bf16(*(const LAS bf16x8*)(rowp + (((4 + kq) ^ (R & 7)) << 4)), qf[1], a, 0, 0, 0);
#pragma unroll
        for (int jj = 0; jj < 4; ++jj) mx = fmaxf(mx, a[jj]);
        sw[wt] = a;
    }
#pragma unroll
    for (int ct = 0; ct < 16; ++ct) {
        const int R = 32 * (ct >> 1) + krow + 4 * (ct & 1);
        const LAS unsigned char* rowp = F.lds + L_CTX + R * 128;
        f32x4 a = (f32x4){0.f, 0.f, 0.f, 0.f};
        a = __builtin_amdgcn_mfma_f32_16x16x32_bf16(*(const LAS bf16x8*)(rowp + ((kq ^ (R & 7)) << 4)), qf[0], a, 0, 0, 0);
        a = __builtin_amdgcn_mfma_f32_16x16x32_bf16(*(const LAS bf16x8*)(rowp + (((4 + kq) ^ (R & 7)) << 4)), qf[1], a, 0, 0, 0);
#pragma unroll
        for (int jj = 0; jj < 4; ++jj) mx = fmaxf(mx, a[jj]);
        sc[ct] = a;
    }
    __syncthreads();
#pragma unroll
    for (int i = 0; i < 13; ++i) { const int idx = i * 512 + w * 64 + lane; const bf16* src;
        if (i < 9) { const int Rd = idx / 72, q = idx - Rd * 72, cc = q ^ (Rd & 7); const int kr = min(rmin + (cc >> 3), GROWS - 1);
            src = VTn + ((size_t)(b * 8 + nh) * 64 + Rd) * TPITCH + kr * 64 + (cc & 7) * 8; }
        else continue;
        dma16(src, F.lds + (i * 512 + w * 64) * 16); }
    mx = fmaxf(mx, __shfl_xor(mx, 16)); mx = fmaxf(mx, __shfl_xor(mx, 32));
    float sum = 0.f;
#pragma unroll
    for (int wt = 0; wt < 16; ++wt)
#pragma unroll
        for (int jj = 0; jj < 4; ++jj) { const float e = fexp2(sw[wt][jj] - mx); sw[wt][jj] = e; sum += e; }
#pragma unroll
    for (int ct = 0; ct < 16; ++ct)
#pragma unroll
        for (int jj = 0; jj < 4; ++jj) { const float e = fexp2(sc[ct][jj] - mx); sc[ct][jj] = e; sum += e; }
    sum += __shfl_xor(sum, 16); sum += __shfl_xor(sum, 32);
    asm volatile("s_waitcnt vmcnt(0)" ::: "memory");
    __syncthreads();
    f32x4 O[4];
#pragma unroll
    for (int nt = 0; nt < 4; ++nt) O[nt] = (f32x4){0.f, 0.f, 0.f, 0.f};
#pragma unroll
    for (int u = 0; u < 8; ++u) { bf16x8 pf;
        pf = pack8(sw[2 * u], sw[2 * u + 1]);
        const int cch = (r0 + u - rmin) * 8 + (kstart >> 3) + kq;
#pragma unroll
        for (int nt = 0; nt < 4; ++nt) { const int Rd = 16 * nt + li;
            O[nt] = __builtin_amdgcn_mfma_f32_16x16x32_bf16(pf, *(const LAS bf16x8*)(F.lds + Rd * 1152 + ((cch ^ (Rd & 7)) << 4)), O[nt], 0, 0, 0); } }
#pragma unroll
    for (int u = 0; u < 8; ++u) { bf16x8 pf;
        pf = pack8(sc[2 * u], sc[2 * u + 1]);
#pragma unroll
        for (int nt = 0; nt < 4; ++nt) { const int Rd = 16 * nt + li;
            O[nt] = __builtin_amdgcn_mfma_f32_16x16x32_bf16(pf, *(const LAS bf16x8*)(F.lds + L_CTXV + Rd * 512 + (((4 * u + kq) ^ (Rd & 7)) << 4)), O[nt], 0, 0, 0); } }
    __syncthreads();
    LAS float* osc = (LAS float*)(F.lds + w * 4352);
#pragma unroll
    for (int jj = 0; jj < 4; ++jj) {
        const float sq = __shfl(sum, 4 * kq + jj); const float inv = frcp(sq);
#pragma unroll
        for (int nt = 0; nt < 4; ++nt) osc[(4 * kq + jj) * 68 + 16 * nt + li] = O[nt][jj] * inv;
    }
    LDS_WAIT(); asm volatile("" ::: "memory");
#pragma unroll
    for (int i = 0; i < 2; ++i) { const int q = lane + 64 * i, row = q >> 3, ch = q & 7;
        const f32x4 a = *(const LAS f32x4*)(osc + row * 68 + 8 * ch), c2 = *(const LAS f32x4*)(osc + row * 68 + 8 * ch + 4);
        u32x4 o = (u32x4){pk2(a.x, a.y), pk2(a.z, a.w), pk2(c2.x, c2.y), pk2(c2.z, c2.w)};
        if (ABL & 16) o = (u32x4){0u, 0u, 0u, 0u};
        *(u32x4*)(Y + (tokb + r * 64 + 16 * cb + row) * D + 512 + nh * 64 + 8 * ch) = o; }
    LDS_WAIT(); asm volatile("" ::: "memory");
}
__device__ __forceinline__ void na_pipe(const Ctx& F, int vb) {
    const bf16* P = (const bf16*)(F.ws + WS_P); const bf16* Pc = (const bf16*)(F.ws + WS_PC); bf16* Y = (bf16*)(F.ws + WS_XA);
    const bf16* VTn = (const bf16*)(F.ws + WS_VTN); const bf16* VTnc = (const bf16*)(F.ws + WS_VTNC);
    int lane = F.lane; asm volatile("" : "+v"(lane));
    const int li = lane & 15, kq = lane >> 4, w = F.wave;
    const int b = vb >> 4, nh = (vb >> 1) & 7, rp0 = (vb & 1) * 8;
    const int cb = w & 3;
    const int kstart = min(max(16 * cb - 8, 0), GRIDW - 32);
    const int qc = 16 * cb + li; const int wstart = min(max(qc - 8, 0), GRIDW - 16);
    const size_t tokb = (size_t)b * SEQ;
    const int krow = 8 * (li >> 2) + (li & 3);
    constexpr int L_CTX = 73728, L_TBL = 106496, L_CTXV = 108544;
    LAS float* tbl = (LAS float*)(F.lds + L_TBL);
    __syncthreads();
    for (int q = F.tid; q < 15 * 32; q += 512) { const int rr = q >> 5, cc = q & 31; tbl[q] = cc < 31 ? F.a->in[11][(size_t)(nh * 15 + rr) * 31 + cc] * 1.4426950408889634f : -3.0e38f; }
    asm volatile("s_waitcnt vmcnt(0)" ::: "memory");
#define NA_ISSUE_K(rp_, ln_) do { const int rmin_ = min(max(2 * (rp_) - 4, 0), GROWS - 8); \
        _Pragma("unroll") for (int i = 0; i < 9; ++i) { const int idx = i * 512 + w * 64 + (ln_); const int R = idx >> 3, cc = (idx & 7) ^ (R & 7); const int kr = min(rmin_ + (R >> 6), GROWS - 1); \
            dma16(P + (tokb + kr * 64 + (R & 63)) * PW + PO_NK + nh * 64 + 8 * cc, F.lds + (i * 512 + w * 64) * 16); } } while (0)
    LAS unsigned char* qt = F.lds + (w < 6 ? 141312 + 2048 * w : LDSCTL_OFF + 1024 + 2048 * (w - 6));
#define NA_LOAD_Q(rp_, ln_) do { _Pragma("unroll") for (int p_ = 0; p_ < 2; ++p_) { const int idx_ = p_ * 64 + (ln_), R_ = idx_ >> 3, cc_ = (idx_ & 7) ^ (R_ & 7); \
        dma16(P + (tokb + (2 * (rp_) + (w >> 2)) * 64 + 16 * cb + R_) * PW + PO_NQ + nh * 64 + 8 * cc_, qt + p_ * 1024); } } while (0)
    NA_ISSUE_K(rp0, lane);
#pragma unroll
    for (int i = 9; i < 13; ++i) { const int id2 = i * 512 + w * 64 + lane - 4608, R = id2 >> 3, cc = (id2 & 7) ^ (R & 7);
        dma16(Pc + ((size_t)b * CTXL + R) * PCW + nh * 64 + 8 * cc, F.lds + (i * 512 + w * 64) * 16); }
#pragma unroll
    for (int i = 0; i < 4; ++i) { const int id2 = i * 512 + w * 64 + lane, Rd = id2 >> 5, cc = (id2 & 31) ^ (Rd & 7);
        dma16(VTnc + ((size_t)(b * 8 + nh) * 64 + Rd) * CTXL + 8 * cc, F.lds + L_CTXV + (i * 512 + w * 64) * 16); }
    asm volatile("" ::: "memory");
    NA_LOAD_Q(rp0, lane);
    asm volatile("" ::: "memory");
    int cidx[8];
#pragma unroll
    for (int o = 0; o < 8; ++o) { const int kc = kstart + 8 * kq + o; const bool ok = (kc >= wstart) && (kc < wstart + 16); cidx[o] = ok ? (kc - qc + 15) : 31; }
#pragma unroll 1
    for (int k = 0; k < 8; ++k) {
        const int rp = rp0 + k;
        int lz = lane; asm volatile("" : "+v"(lz));
        const int r = 2 * rp + (w >> 2);
        const int rmin = min(max(2 * rp - 4, 0), GROWS - 8);
        const int r0 = min(max(r - 4, 0), GROWS - 8);
        if (k == 0) asm volatile("s_waitcnt vmcnt(0)" ::: "memory"); else asm volatile("s_waitcnt vmcnt(2)" ::: "memory");
        __builtin_amdgcn_s_barrier(); asm volatile("" ::: "memory");
        bf16x8 qf[2]; qf[0] = *(const LAS bf16x8*)(qt + li * 128 + ((kq ^ (li & 7)) << 4)); qf[1] = *(const LAS bf16x8*)(qt + li * 128 + (((4 + kq) ^ (li & 7)) << 4));
        f32x4 sw[16], sc[16];
        float mx = -3.0e38f;
#pragma unroll
        for (int wt = 0; wt < 16; ++wt) {
            const int kr = r0 + (wt >> 1);
            f32x4 a;
#pragma unroll
            for (int jj = 0; jj < 4; ++jj) a[jj] = tbl[(kr - r + 7) * 32 + cidx[4 * (wt & 1) + jj]];
            const int R = (kr - rmin) * 64 + kstart + krow + 4 * (wt & 1);
            const LAS unsigned char* rowp = F.lds + R * 128;
            a = __builtin_amdgcn_mfma_f32_16x16x32_bf16(*(const LAS bf16x8*)(rowp + ((kq ^ (R & 7)) << 4)), qf[0], a, 0, 0, 0);
            a = __builtin_amdgcn_mfma_f32_16x16x32_bf16(*(const LAS bf16x8*)(rowp + (((4 + kq) ^ (R & 7)) << 4)), qf[1], a, 0, 0, 0);
#pragma unroll
            for (int jj = 0; jj < 4; ++jj) mx = fmaxf(mx, a[jj]);
            sw[wt] = a;
        }
#pragma unroll
        for (int ct = 0; ct < 16; ++ct) {
            const int R = 32 * (ct >> 1) + krow + 4 * (ct & 1);
            const LAS unsigned char* rowp = F.lds + L_CTX + R * 128;
            f32x4 a = (f32x4){0.f, 0.f, 0.f, 0.f};
            a = __builtin_amdgcn_mfma_f32_16x16x32_bf16(*(const LAS bf16x8*)(rowp + ((kq ^ (R & 7)) << 4)), qf[0], a, 0, 0, 0);
            a = __builtin_amdgcn_mfma_f32_16x16x32_bf16(*(const LAS bf16x8*)(rowp + (((4 + kq) ^ (R & 7)) << 4)), qf[1], a, 0, 0, 0);
#pragma unroll
            for (int jj = 0; jj < 4; ++jj) mx = fmaxf(mx, a[jj]);
            sc[ct] = a;
        }
        asm volatile("" ::: "memory"); __builtin_amdgcn_s_barrier(); asm volatile("" ::: "memory");
#pragma unroll
        for (int i = 0; i < 9; ++i) { const int idx = i * 512 + w * 64 + lz; const int Rd = idx / 72, q = idx - Rd * 72, cc = q ^ (Rd & 7); const int kr = min(rmin + (cc >> 3), GROWS - 1);
            dma16(VTn + ((size_t)(b * 8 + nh) * 64 + Rd) * TPITCH + kr * 64 + (cc & 7) * 8, F.lds + (i * 512 + w * 64) * 16); }
        asm volatile("" ::: "memory");
        mx = fmaxf(mx, __shfl_xor(mx, 16)); mx = fmaxf(mx, __shfl_xor(mx, 32));
        float sum = 0.f;
#pragma unroll
        for (int wt = 0; wt < 16; ++wt)
#pragma unroll
            for (int jj = 0; jj < 4; ++jj) { const float e = fexp2(sw[wt][jj] - mx); sw[wt][jj] = e; sum += e; }
#pragma unroll
        for (int ct = 0; ct < 16; ++ct)
#pragma unroll
            for (int jj = 0; jj < 4; ++jj) { const float e = fexp2(sc[ct][jj] - mx); sc[ct][jj] = e; sum += e; }
        sum += __shfl_xor(sum, 16); sum += __shfl_xor(sum, 32);
        asm volatile("s_waitcnt vmcnt(0)" ::: "memory");
        __builtin_amdgcn_s_barrier(); asm volatile("" ::: "memory");
        f32x4 O[4];
#pragma unroll
        for (int nt = 0; nt < 4; ++nt) O[nt] = (f32x4){0.f, 0.f, 0.f, 0.f};
#pragma unroll
        for (int u = 0; u < 8; ++u) { bf16x8 pf;
            pf = pack8(sw[2 * u], sw[2 * u + 1]);
            const int cch = (r0 + u - rmin) * 8 + (kstart >> 3) + kq;
#pragma unroll
            for (int nt = 0; nt < 4; ++nt) { const int Rd = 32 * (nt >> 1) + krow + 4 * (nt & 1);
                O[nt] = __builtin_amdgcn_mfma_f32_16x16x32_bf16(*(const LAS bf16x8*)(F.lds + Rd * 1152 + ((cch ^ (Rd & 7)) << 4)), pf, O[nt], 0, 0, 0); } }
#pragma unroll
        for (int u = 0; u < 8; ++u) { bf16x8 pf;
            pf = pack8(sc[2 * u], sc[2 * u + 1]);
#pragma unroll
            for (int nt = 0; nt < 4; ++nt) { const int Rd = 32 * (nt >> 1) + krow + 4 * (nt & 1);
                O[nt] = __builtin_amdgcn_mfma_f32_16x16x32_bf16(*(const LAS bf16x8*)(F.lds + L_CTXV + Rd * 512 + (((4 * u + kq) ^ (Rd & 7)) << 4)), pf, O[nt], 0, 0, 0); } }
        asm volatile("" ::: "memory"); __builtin_amdgcn_s_barrier(); asm volatile("" ::: "memory");
        if (k < 7) { NA_ISSUE_K(rp + 1, lz); asm volatile("" ::: "memory"); NA_LOAD_Q(rp + 1, lz); asm volatile("" ::: "memory"); }
        const float inv = frcp(sum);
        bf16* yp = Y + (tokb + r * 64 + qc) * D + 512 + nh * 64 + 8 * kq;
#pragma unroll
        for (int t = 0; t < 2; ++t) { const f32x4 a = O[2 * t] * inv, c2 = O[2 * t + 1] * inv;
            u32x4 o = (u32x4){pk2(a.x, a.y), pk2(a.z, a.w), pk2(c2.x, c2.y), pk2(c2.z, c2.w)};
            if (ABL & 16) o = (u32x4){0u, 0u, 0u, 0u};
            *(u32x4*)(yp + 32 * t) = o; }
        asm volatile("" ::: "memory");
    }
#undef NA_ISSUE_K
#undef NA_LOAD_Q
    asm volatile("s_waitcnt vmcnt(0)" ::: "memory");
    __syncthreads();
}
__device__ __forceinline__ void phase4(const Ctx& F) {
#ifndef P4MASK
#define P4MASK 3
#endif
    if (P4MASK & 1) ret_phase(F);
    if (P4MASK & 2) {
        if (F.G == 256) { const int vb = (F.bid & 7) * 32 + (F.bid >> 3);
            na_pipe(F, vb); }
        else for (int u = F.bid; u < 2048; u += F.G) na_unit(F, u, true);
    }
}

struct SchedOut {
    int G, c; const char* Wt;
    __device__ __forceinline__ bool next(int i, g8::Unit& u) const {
        const int L = i * G + c; if (L >= 512) return false;
        int pm, pn; g8::tile_of(L, 128, 4, pm, pn); u.pm = pm; u.pn = pn; u.e = 0; u.aux = 0; u.B = Wt + (size_t)pn * 256 * 1024 * 2; return true; }
    __device__ __forceinline__ unsigned rowoff(const g8::Unit& u, int r) const { return (unsigned)(u.pm * 256 + r) * 2048u; }
};
struct EpiY {
    static constexpr bool IDEMP = true;
    bf16* Yg; const float* gate0; const float* cs; float abl;
    __device__ __forceinline__ void operator()(const f32x4 (&acc)[2][2][4][2], const g8::Unit& u, int wr, int wc, int fr, int fq) const {
        const int row0 = u.pm * 256 + wr * 64 + fr, col0 = u.pn * 256 + wc * 32 + 8 * fq;
        const float* gp = gate0 + (size_t)(row0 >> 11) * 6144 + col0;
        f32x4 gv[2][2];
#pragma unroll
        for (int bj = 0; bj < 2; ++bj)
#pragma unroll
            for (int n = 0; n < 2; ++n) { gv[bj][n] = *(const f32x4*)(gp + bj * 128 + n * 4) * abl; if (cs) gv[bj][n] *= *(const f32x4*)(cs + col0 + bj * 128 + n * 4); }
#pragma unroll
        for (int ai = 0; ai < 2; ++ai)
#pragma unroll
            for (int m = 0; m < 4; ++m) { bf16* rp = Yg + (size_t)(row0 + ai * 128 + m * 16) * D + col0;
#pragma unroll
                for (int bj = 0; bj < 2; ++bj) { const f32x4 v0 = acc[ai][bj][m][0] * gv[bj][0], v1 = acc[ai][bj][m][1] * gv[bj][1];
                    *(u32x4*)(rp + bj * 128) = (u32x4){pk2(v0.x, v0.y), pk2(v0.z, v0.w), pk2(v1.x, v1.y), pk2(v1.z, v1.w)}; } }
    }
};

struct LnVecs { f32x4 lg[4], lb[4], sh[4], sc1[4]; f32x4 br1; };
#define LN_OFF(g_, lane_) (8 * (lane_) + 512 * ((g_) >> 1) + 4 * ((g_) & 1))
template <bool RES32> __device__ __forceinline__ void ln_load(const float* R32, const bf16* R16, const bf16* Yg, int t, int lane, f32x4 (&nr)[4], u32x2 (&ny)[4]) {
    const u32x4* yr = (const u32x4*)(Yg + (size_t)t * D) + lane;
    if (RES32) { const float* rr = R32 + (size_t)t * D;
#pragma unroll
        for (int g = 0; g < 4; ++g) nr[g] = __builtin_nontemporal_load((const f32x4*)(rr + LN_OFF(g, lane))); }
    else { const u32x4* rr = (const u32x4*)(R16 + (size_t)t * D) + lane;
#pragma unroll
        for (int jj = 0; jj < 2; ++jj) { const u32x4 h = rr[64 * jj]; nr[2 * jj] = (f32x4){bflo(h.x), bfhi(h.x), bflo(h.y), bfhi(h.y)}; nr[2 * jj + 1] = (f32x4){bflo(h.z), bfhi(h.z), bflo(h.w), bfhi(h.w)}; } }
#pragma unroll
    for (int jj = 0; jj < 2; ++jj) { const u32x4 q = __builtin_nontemporal_load(yr + 64 * jj); ny[2 * jj] = (u32x2){q.x, q.y}; ny[2 * jj + 1] = (u32x2){q.z, q.w}; }
}
__device__ __forceinline__ void ln_row(const Ctx& F, int l, int t, const f32x4 (&nr)[4], const u32x2 (&ny)[4], const LnVecs& V, LAS f32x4* wl, LAS u32x4* rec_slot) {
    const int lane = F.lane; const LAS float* br2l = (const LAS float*)(F.lds + 149760);
    bf16* hm = (bf16*)(F.ws + WS_XA);
    u32x4* hr16 = (u32x4*)((bf16*)(F.ws + WS_H16) + (size_t)t * D) + lane;
    f32x4 v[4]; float s = 0.f;
#pragma unroll
    for (int j = 0; j < 4; ++j) { const u32x2 y = ny[j]; v[j] = nr[j] * ALPHA + (f32x4){bflo(y.x), bfhi(y.x), bflo(y.y), bfhi(y.y)}; s += (v[j].x + v[j].y) + (v[j].z + v[j].w); }
    const float mean = wave_sum(s) * (1.0f / D); float s2 = 0.f;
#pragma unroll
    for (int j = 0; j < 4; ++j) { v[j] = v[j] - mean; s2 += (v[j].x * v[j].x + v[j].y * v[j].y) + (v[j].z * v[j].z + v[j].w * v[j].w); }
    const float rstd = __builtin_amdgcn_rsqf(wave_sum(s2) * (1.0f / D) + LN_EPS);
    u32x4* o16 = (u32x4*)(hm + (size_t)t * D) + lane;
    f32x2 pgA = (f32x2){0.f, 0.f}, pgB = pgA;
#pragma unroll
    for (int jj = 0; jj < 2; ++jj) {
        const f32x4 ha = v[2 * jj] * rstd * V.lg[2 * jj] + V.lb[2 * jj], hb = v[2 * jj + 1] * rstd * V.lg[2 * jj + 1] + V.lb[2 * jj + 1];
        hr16[64 * jj] = (u32x4){pk2(ha.x, ha.y), pk2(ha.z, ha.w), pk2(hb.x, hb.y), pk2(hb.z, hb.w)};
        const f32x4 ma = ha * V.sc1[2 * jj] + V.sh[2 * jj], mb = hb * V.sc1[2 * jj + 1] + V.sh[2 * jj + 1];
        v[2 * jj] = ma; v[2 * jj + 1] = mb;
        o16[64 * jj] = (u32x4){pk2(ma.x, ma.y), pk2(ma.z, ma.w), pk2(mb.x, mb.y), pk2(mb.z, mb.w)}; }
    constexpr int NA_RD = 4;
    {   f32x4 rb[NA_RD + 1];
#pragma unroll
        for (int i = 0; i < NA_RD; ++i) rb[i] = wl[i * 64 + lane];
#pragma unroll
        for (int i = 0; i < 16; ++i) {
            if (i + NA_RD < 16) rb[(i + NA_RD) % (NA_RD + 1)] = wl[(i + NA_RD) * 64 + lane];
            __builtin_amdgcn_sched_barrier(0);
            const f32x4 w = rb[i % (NA_RD + 1)]; const f32x2 mp = (i & 2) ? (f32x2){v[i >> 2].z, v[i >> 2].w} : (f32x2){v[i >> 2].x, v[i >> 2].y};
            pkfma_bc(pgA, (f32x2){w.x, w.y}, mp, i & 1); pkfma_bc(pgB, (f32x2){w.z, w.w}, mp, i & 1); } }
    int grp; float gate_g;
    {   const bool h1 = lane & 1, h2 = lane & 2;
        const float m0 = h1 ? pgB.x : pgA.x, m1 = h1 ? pgB.y : pgA.y, s0 = h1 ? pgA.x : pgB.x, s1 = h1 ? pgA.y : pgB.y;
        const float b2a = m0 + dppf<0xB1>(s0), b2b = m1 + dppf<0xB1>(s1);
        float b1 = (h2 ? b2b : b2a) + dppf<0x4E>(h2 ? b2a : b2b);
        b1 += dppf<0x124>(b1); b1 += dppf<0x128>(b1);
        b1 += __shfl_xor(b1, 16); b1 += __shfl_xor(b1, 32);
        const int myg = ((lane >> 1) & 1) | ((lane & 1) << 1);
        const float lgq = b1 + (myg == 0 ? V.br1.x : (myg == 1 ? V.br1.y : (myg == 2 ? V.br1.z : V.br1.w)));
        const float gk = __uint_as_float((__float_as_uint(lgq) & ~3u) | (unsigned)(3 - myg));
        float gm = fmaxf(gk, dppf<0xB1>(gk)); gm = fmaxf(gm, dppf<0x4E>(gm));
        grp = __builtin_amdgcn_readfirstlane(3 - (int)(__float_as_uint(gm) & 3u));
        float gs = __expf(gk - gm); gs += dppf<0xB1>(gs); gs += dppf<0x4E>(gs);
        gate_g = frcp(gs); }
    f32x2 pe2[4] = {(f32x2){0.f, 0.f}, (f32x2){0.f, 0.f}, (f32x2){0.f, 0.f}, (f32x2){0.f, 0.f}};
    {   const LAS f32x4* wx = wl + 1024 + 2048 * grp + lane; f32x4 rb[NA_RD + 1];
#pragma unroll
        for (int i = 0; i < NA_RD; ++i) rb[i] = wx[i * 64];
#pragma unroll
        for (int i = 0; i < 32; ++i) {
            if (i + NA_RD < 32) rb[(i + NA_RD) % (NA_RD + 1)] = wx[(i + NA_RD) * 64];
            __builtin_amdgcn_sched_barrier(0);
            const f32x4 w = rb[i % (NA_RD + 1)]; const f32x2 mp = (i & 4) ? (f32x2){v[i >> 3].z, v[i >> 3].w} : (f32x2){v[i >> 3].x, v[i >> 3].y};
            pkfma_bc(pe2[2 * (i & 1)], (f32x2){w.x, w.y}, mp, (i >> 1) & 1); pkfma_bc(pe2[2 * (i & 1) + 1], (f32x2){w.z, w.w}, mp, (i >> 1) & 1); } }
    const float pe[8] = {pe2[0].x, pe2[0].y, pe2[1].x, pe2[1].y, pe2[2].x, pe2[2].y, pe2[3].x, pe2[3].y};
    float key0;
    {
        float a4[4], a2[2], a1;
#pragma unroll
        for (int q = 0; q < 4; ++q) { const float mine = (lane & 1) ? pe[q + 4] : pe[q], send = (lane & 1) ? pe[q] : pe[q + 4]; a4[q] = mine + dppf<0xB1>(send); }
#pragma unroll
        for (int q = 0; q < 2; ++q) { const float mine = (lane & 2) ? a4[q + 2] : a4[q], send = (lane & 2) ? a4[q] : a4[q + 2]; a2[q] = mine + dppf<0x4E>(send); }
        { const float mine = (lane & 4) ? a2[1] : a2[0], send = (lane & 4) ? a2[0] : a2[1]; a1 = mine + dppf<0x124>(send); }
        a1 += dppf<0x128>(a1); a1 += __shfl_xor(a1, 16); a1 += __shfl_xor(a1, 32);
        const int myq = ((lane >> 2) & 1) | (((lane >> 1) & 1) << 1) | ((lane & 1) << 2);
        const float lg8 = a1 + br2l[grp * 8 + myq];
        key0 = __uint_as_float((__float_as_uint(lg8) & ~7u) | (unsigned)(7 - myq));
    }
    const float v0 = max8(key0);
    const float v1 = max8(key0 == v0 ? -3.0e38f : key0);
    const int i0 = 7 - (int)(__float_as_uint(v0) & 7u), i1 = 7 - (int)(__float_as_uint(v1) & 7u);
    const float e1 = __expf(v1 - v0); const float wn = gate_g * frcp(1.0f + e1); const float w0 = (ABL & 128) ? 0.f : wn, w1 = (ABL & 1024) ? 1.0f : ((ABL & 64) ? 0.f : wn * e1);
    if (lane == 0) *rec_slot = (u32x4){(unsigned)(grp * 8 + i0), (unsigned)(grp * 8 + i1), __builtin_bit_cast(unsigned, w0), __builtin_bit_cast(unsigned, w1)};
}
template <bool RES32> __device__ __forceinline__ void phase_ln_router(const Ctx& F, int l, const float* R32, const bf16* Yg) {
    const bf16* R16 = (const bf16*)(F.ws + WS_H16);
    const int gw = F.bid * 8 + F.wave, lane = F.lane;
    int* tokinfo = (int*)(F.ws + WS_TOKINFO); int* list = (int*)(F.ws + WS_LIST);
    unsigned* cnt = (unsigned*)(F.ws + WS_CTL) + CW_CNT + 64 * (l * 32);
    LAS f32x4* wl = (LAS f32x4*)F.lds;
    __syncthreads();
    for (int k = F.tid; k < 1024; k += 512) { const int ln = (k & 511) >> 3, e = k & 3, j = 2 * (k >> 9) + ((k >> 2) & 1);
        wl[(4 * j + e) * 64 + ln] = *(const f32x4*)(F.a->in[14] + ((size_t)l * D + k) * 4);
#pragma unroll
        for (int g = 0; g < 4; ++g)
#pragma unroll
            for (int q = 0; q < 2; ++q) wl[1024 + 2048 * g + ((4 * j + e) * 2 + q) * 64 + ln] = *(const f32x4*)(F.a->in[16] + (((size_t)l * 4 + g) * D + k) * 8 + 4 * q); }
    if (F.tid < 32) ((LAS float*)(F.lds + 149760))[F.tid] = F.a->in[17][l * 32 + F.tid];
    __syncthreads();
    LAS u32x4* recs = (LAS u32x4*)(F.lds + 147456);
    const int t_lo = gw * 16;
    for (int tb = t_lo; tb < T; tb += F.G * 8 * 16) {
        const int b = tb >> 11;
        LnVecs V;
#pragma unroll
        for (int j = 0; j < 4; ++j) { const int ci = LN_OFF(j, lane);
            V.lg[j] = *(const f32x4*)(F.a->in[6] + (l * 2 + 0) * D + ci); V.lb[j] = *(const f32x4*)(F.a->in[7] + (l * 2 + 0) * D + ci);
            V.sh[j] = *(const f32x4*)(modp(F, l, b, 3) + ci); V.sc1[j] = *(const f32x4*)(modp(F, l, b, 4) + ci) + 1.0f; }
        V.br1 = *(const f32x4*)(F.a->in[15] + l * 4);
        f32x4 rA[4], rB[4]; u32x2 yA[4], yB[4];
        LAS u32x4* rw = recs + F.wave * 16;
#define LN_SEP() do { asm volatile("" ::: "memory"); __builtin_amdgcn_sched_barrier(0); } while (0)
        ln_load<RES32>(R32, R16, Yg, tb, lane, rA, yA);
#pragma unroll 1
        for (int k = 0; k < 16; k += 2) {
            ln_load<RES32>(R32, R16, Yg, tb + k + 1, lane, rB, yB); LN_SEP(); ln_row(F, l, tb + k, rA, yA, V, wl, rw + k);
            ln_load<RES32>(R32, R16, Yg, tb + min(k + 2, 15), lane, rA, yA); LN_SEP(); ln_row(F, l, tb + k + 1, rB, yB, V, wl, rw + k + 1);
        }
#undef LN_SEP
        LAS int* lcnt = (LAS int*)(F.lds + 149504);
        __syncthreads();
        if (F.tid < 64) lcnt[F.tid] = 0;
        __syncthreads();
        int e = 0, lp = 0; unsigned wa = 0u, wb = 0u; const int which = F.tid & 1;
        const int r = F.tid >> 1; const int t = (tb - F.wave * 16) + r;
        if (F.tid < 256) { const u32x4 rec = recs[r]; e = which ? (int)rec.y : (int)rec.x; wa = rec.z; wb = rec.w;
            lp = __hip_atomic_fetch_add(&lcnt[e], 1, __ATOMIC_RELAXED, __HIP_MEMORY_SCOPE_WORKGROUP); }
        __syncthreads();
        if (F.tid < 32) lcnt[32 + F.tid] = (int)atomicAdd(cnt + 64 * F.tid, (unsigned)lcnt[F.tid]);
        __syncthreads();
        if (F.tid < 256) { const int pos = lcnt[32 + e] + lp;
            list[(size_t)e * LISTCAP + pos] = t;
            int* ti = tokinfo + (size_t)t * 8;
            *(u32x2*)(ti + 2 * which) = (u32x2){(unsigned)e, (unsigned)pos};
            if (which == 0) *(u32x2*)(ti + 4) = (u32x2){wa, wb}; }
    }
}

__device__ __forceinline__ void moe_table(const Ctx& F, int l) {
    LAS int* tab = (LAS int*)(F.lds + LDS_TAB_OFF);
    __syncthreads();
    if (F.tid < 32) tab[40 + F.tid] = (int)__hip_atomic_load((unsigned*)(F.ws + WS_CTL) + CW_CNT + 64 * (l * 32 + F.tid), __ATOMIC_RELAXED, __HIP_MEMORY_SCOPE_AGENT);
    __syncthreads();
    if (F.tid < 64) {
        const int lane = F.tid; const int mine = lane < 32 ? (tab[40 + lane] + 255) >> 8 : 0; int s = mine;
#pragma unroll
        for (int d = 1; d < 32; d <<= 1) { const int t = __shfl_up(s, d); if (lane >= d) s += t; }
        if (lane < 32) tab[lane] = s - mine;
        if (lane == 31) tab[32] = s; }
    __syncthreads();
}
__device__ __forceinline__ int moe_vc(int c, int G) { return (G == 256) ? (((c & 7) * 8 + (c >> 5)) * 4 + ((c >> 3) & 3)) : c; }
struct SchedMoe {
    int G, c; const char* Wt; size_t wstride; size_t pnstride; const LAS int* tab; const LAS int* tokl; int gather; unsigned lda2;
    __device__ __forceinline__ bool next(int i, g8::Unit& u) const {
        const int L = i * G + moe_vc(c, G); const int nrt = __builtin_amdgcn_readfirstlane(tab[32]); if (L >= 4 * nrt) return false;
        const int rt = L >> 2, pn = L & 3; int e = 0;
        for (int q = 1; q < 32; ++q) e = (tab[q] <= rt) ? q : e;
        e = __builtin_amdgcn_readfirstlane(e);
        u.pm = rt; u.pn = pn; u.e = e; u.aux = i; u.B = Wt + (size_t)e * wstride + (size_t)pn * pnstride; return true; }
    __device__ __forceinline__ unsigned rowoff(const g8::Unit& u, int r) const {
        if (gather) return (unsigned)tokl[u.aux * 256 + r] * lda2;
        return (unsigned)(u.pm * 256 + r) * lda2; }
};
constexpr int MOE_MAXU = 8, LDS_TOKL_OFF = LDSCTL_OFF + 1024;
static_assert(LDS_TOKL_OFF + MOE_MAXU * 256 * 4 <= LDS_BYTES && LDS_SCR_OFF + 8 * 2304 <= LDSCTL_OFF, "LDS map");
__device__ __forceinline__ void moe_tokl(const Ctx& F) {
    const LAS int* tab = (const LAS int*)(F.lds + LDS_TAB_OFF); LAS int* tokl = (LAS int*)(F.lds + LDS_TOKL_OFF);
    const int* list = (const int*)(F.ws + WS_LIST);
    for (int q = F.tid; q < MOE_MAXU * 256; q += 512) { const int i = q >> 8, r = q & 255; const int L = i * F.G + moe_vc(F.bid, F.G); int tk = 0;
        if (L < 4 * tab[32]) { const int rt = L >> 2; int e = 0; for (int k = 1; k < 32; ++k) e = (tab[k] <= rt) ? k : e;
            const int idx = (rt - tab[e]) * 256 + r; tk = list[(size_t)e * LISTCAP + (idx < tab[40 + e] ? idx : 0)]; }
        tokl[q] = tk; }
    __syncthreads();
}
struct EpiAct {
    bf16* act;
    __device__ __forceinline__ void operator()(const f32x4 (&acc)[2][2][4][2], const g8::Unit& u, int wr, int wc, int fr, int fq) const {
        const int row0 = u.pm * 256 + wr * 64 + fr, col0 = u.pn * 128 + wc * 32 + 8 * fq;
#pragma unroll
        for (int ai = 0; ai < 2; ++ai)
#pragma unroll
            for (int m = 0; m < 4; ++m) { bf16* rp = act + (size_t)(row0 + ai * 128 + m * 16) * HID + col0;
                const f32x4 g0 = acc[ai][0][m][0], u0 = acc[ai][0][m][1], g1 = acc[ai][1][m][0], u1 = acc[ai][1][m][1];
                *(u32x4*)rp = (u32x4){pk2(silu_f(g0.x) * u0.x, silu_f(g0.y) * u0.y), pk2(silu_f(g0.z) * u0.z, silu_f(g0.w) * u0.w),
                                      pk2(silu_f(g1.x) * u1.x, silu_f(g1.y) * u1.y), pk2(silu_f(g1.z) * u1.z, silu_f(g1.w) * u1.w)}; }
    }
};
struct EpiEo {
    bf16* eo;
    __device__ __forceinline__ void operator()(const f32x4 (&acc)[2][2][4][2], const g8::Unit& u, int wr, int wc, int fr, int fq) const {
        const int row0 = u.pm * 256 + wr * 64 + fr, col0 = u.pn * 256 + wc * 32 + 8 * fq;
#pragma unroll
        for (int ai = 0; ai < 2; ++ai)
#pragma unroll
            for (int m = 0; m < 4; ++m) { bf16* rp = eo + (size_t)(row0 + ai * 128 + m * 16) * D + col0;
#pragma unroll
                for (int bj = 0; bj < 2; ++bj) { const f32x4 v0 = acc[ai][bj][m][0], v1 = acc[ai][bj][m][1];
                    *(u32x4*)(rp + bj * 128) = (u32x4){pk2(v0.x, v0.y), pk2(v0.z, v0.w), pk2(v1.x, v1.y), pk2(v1.z, v1.w)}; } }
    }
};

struct CmbRow { u32x2 h[4]; u32x2 ea[4], eb[4]; };
__device__ __forceinline__ void cmb_load(const Ctx& F, const LAS int* tab, int t, const u32x4& ti, CmbRow& r) {
    const unsigned e0i = ti.x, p0i = ti.y, e1i = ti.z, p1i = ti.w;
    const size_t s0 = (size_t)tab[e0i] * 256 + p0i, s1 = (size_t)tab[e1i] * 256 + p1i;
    const bf16* eo = (const bf16*)(F.ws + WS_EO);
    const u32x2* e0 = (const u32x2*)(eo + s0 * D) + F.lane; const u32x2* e1 = (const u32x2*)(eo + s1 * D) + F.lane; const u32x2* hp = (const u32x2*)((const bf16*)(F.ws + WS_H16) + (size_t)t * D) + F.lane;
#pragma unroll
    for (int j = 0; j < 4; ++j) { r.ea[j] = __builtin_nontemporal_load(e0 + 64 * j); r.eb[j] = __builtin_nontemporal_load(e1 + 64 * j); r.h[j] = hp[64 * j]; }
}
__device__ __forceinline__ void cmb_row(const Ctx& F, int l, int t, const CmbRow& r, const u32x2& tw, const f32x4 (&gt)[4], const f32x4 (&lg)[4], const f32x4 (&lb)[4]) {
    const float ab = ((ABL >> (1 + 2 * l)) & 1) ? 0.f : 1.f;
    const unsigned twx = tw.x, twy = tw.y;
    const float w0 = ab * __uint_as_float(twx), w1 = ab * __uint_as_float(twy);
    f32x4 v[4]; float s = 0.f;
#pragma unroll
    for (int j = 0; j < 4; ++j) { const u32x2 a = r.ea[j], c2 = r.eb[j];
        f32x4 y; y.x = w0 * bflo(a.x) + w1 * bflo(c2.x); y.y = w0 * bfhi(a.x) + w1 * bfhi(c2.x); y.z = w0 * bflo(a.y) + w1 * bflo(c2.y); y.w = w0 * bfhi(a.y) + w1 * bfhi(c2.y);
        const u32x2 hh = r.h[j]; v[j] = (f32x4){bflo(hh.x), bfhi(hh.x), bflo(hh.y), bfhi(hh.y)} * ALPHA + gt[j] * y; s += (v[j].x + v[j].y) + (v[j].z + v[j].w); }
    const float mean = wave_sum(s) * (1.0f / D); float s2 = 0.f;
#pragma unroll
    for (int j = 0; j < 4; ++j) { v[j] = v[j] - mean; s2 += (v[j].x * v[j].x + v[j].y * v[j].y) + (v[j].z * v[j].z + v[j].w * v[j].w); }
    const float rstd = __builtin_amdgcn_rsqf(wave_sum(s2) * (1.0f / D) + LN_EPS);
    if (l == 1) { float* hr = F.H + (size_t)t * D;
#pragma unroll
        for (int j = 0; j < 4; ++j) *(f32x4*)(hr + 4 * F.lane + 256 * j) = v[j] * rstd * lg[j] + lb[j]; }
    else { unsigned long long* hr8 = (unsigned long long*)((bf16*)(F.ws + WS_H16) + (size_t)t * D) + F.lane;
#pragma unroll
        for (int j = 0; j < 4; ++j) { const f32x4 o = v[j] * rstd * lg[j] + lb[j]; hr8[64 * j] = (unsigned long long)pk2(o.x, o.y) | ((unsigned long long)pk2(o.z, o.w) << 32); } }
}
__device__ __forceinline__ void phase_combine(const Ctx& F, int l) {
    moe_table(F, l);
    const LAS int* tab = (const LAS int*)(F.lds + LDS_TAB_OFF);
    const int gw = F.bid * 8 + F.wave, lane = F.lane;
    const int* tokinfo = (const int*)(F.ws + WS_TOKINFO);
    for (int tb = gw * 16; tb < T; tb += F.G * 8 * 16) {
        const int b = tb >> 11;
        f32x4 gt[4], lg[4], lb[4];
#pragma unroll
        for (int j = 0; j < 4; ++j) { const int ci = 4 * lane + 256 * j; gt[j] = *(const f32x4*)(modp(F, l, b, 5) + ci);
            lg[j] = *(const f32x4*)(F.a->in[6] + (l * 2 + 1) * D + ci); lb[j] = *(const f32x4*)(F.a->in[7] + (l * 2 + 1) * D + ci); }
        u32x4 tiv = (u32x4){0u, 0u, 0u, 0u}; u32x2 twv = (u32x2){0u, 0u};
        if (lane < 16) { tiv = *(const u32x4*)(tokinfo + (size_t)(tb + lane) * 8); twv = *(const u32x2*)(tokinfo + (size_t)(tb + lane) * 8 + 4); }
#define CMB_RL(x_, k_) ((unsigned)__builtin_amdgcn_readlane((int)(x_), (k_)))
#define CMB_TI(k_) ((u32x4){CMB_RL(tiv.x, (k_)), CMB_RL(tiv.y, (k_)), CMB_RL(tiv.z, (k_)), CMB_RL(tiv.w, (k_))})
#define CMB_TW(k_) ((u32x2){CMB_RL(twv.x, (k_)), CMB_RL(twv.y, (k_))})
        CmbRow A, B, C;
#define CMB_SEP() do { asm volatile("" ::: "memory"); __builtin_amdgcn_sched_barrier(0); } while (0)
#define CMB_TRIP(k_) do { const int k3_ = (k_) + 3, k4_ = min((k_) + 4, 15); \
            cmb_load(F, tab, tb + (k_) + 2, CMB_TI((k_) + 2), C); CMB_SEP(); cmb_row(F, l, tb + (k_), A, CMB_TW((k_)), gt, lg, lb); \
            cmb_load(F, tab, tb + k3_, CMB_TI(k3_), A); CMB_SEP(); cmb_row(F, l, tb + (k_) + 1, B, CMB_TW((k_) + 1), gt, lg, lb); \
            cmb_load(F, tab, tb + k4_, CMB_TI(k4_), B); CMB_SEP(); cmb_row(F, l, tb + (k_) + 2, C, CMB_TW((k_) + 2), gt, lg, lb); } while (0)
        cmb_load(F, tab, tb, CMB_TI(0), A); cmb_load(F, tab, tb + 1, CMB_TI(1), B);
        CMB_TRIP(0);
#pragma unroll 1
        for (int k = 3; k < 15; k += 3) CMB_TRIP(k);
        CMB_SEP(); cmb_row(F, l, tb + 15, A, CMB_TW(15), gt, lg, lb);
#undef CMB_TRIP
#undef CMB_SEP
#undef CMB_TI
#undef CMB_TW
#undef CMB_RL
    }
}

template <int WH> __device__ __forceinline__ void pool_item(const Ctx& F, bf16* zp, int b, int p0, int ch) {
    const bf16* hb = (const bf16*)(F.ws + WS_H16) + (size_t)b * SEQ * D + ch;
    const f32x4 sc1 = *(const f32x4*)(modp(F, 1, b, 1) + ch) + 1.0f;
    u32x2 rw[8 + 2 * WH];
#pragma unroll
    for (int i = 0; i < 8 + 2 * WH; ++i) { const int p = p0 - WH + i; const bool ok = (p >= 0) && (p < SEQ); const u32x2 v = *(const u32x2*)(hb + (size_t)(ok ? p : p0) * D); rw[i] = ok ? v : (u32x2){0u, 0u}; }
#define PZ_ROW(i_) ((f32x4){bflo(rw[i_].x), bfhi(rw[i_].x), bflo(rw[i_].y), bfhi(rw[i_].y)})
    f32x4 sum = (f32x4){0.f, 0.f, 0.f, 0.f};
#pragma unroll
    for (int i = 0; i < 2 * WH; ++i) sum += PZ_ROW(i);
#pragma unroll
    for (int j = 0; j < 8; ++j) { const int p = p0 + j; const int cnt = min(p + WH, SEQ) - max(p - WH, 0);
        const f32x4 z = (sum * frcp((float)cnt) - PZ_ROW(j + WH)) * sc1;
        *(u32x2*)(zp + ((size_t)b * SEQ + p) * D + ch) = (u32x2){pk2(z.x, z.y), pk2(z.z, z.w)};
        sum += PZ_ROW(j + 2 * WH) - PZ_ROW(j); }
#undef PZ_ROW
}
template <int WH> __device__ __forceinline__ void pool_item8(const Ctx& F, bf16* zp, int b, int p0, int ch) {
    const bf16* hb = (const bf16*)(F.ws + WS_H16) + (size_t)b * SEQ * D + ch;
    const f32x4 sa = *(const f32x4*)(modp(F, 1, b, 1) + ch) + 1.0f, sb = *(const f32x4*)(modp(F, 1, b, 1) + ch + 4) + 1.0f;
    u32x4 rw[8 + 2 * WH];
#pragma unroll
    for (int i = 0; i < 8 + 2 * WH; ++i) { const int p = p0 - WH + i; const bool ok = (p >= 0) && (p < SEQ); const u32x4 v = *(const u32x4*)(hb + (size_t)(ok ? p : p0) * D); rw[i] = ok ? v : (u32x4){0u, 0u, 0u, 0u}; }
#define PZ_A(i_) ((f32x4){bflo(rw[i_].x), bfhi(rw[i_].x), bflo(rw[i_].y), bfhi(rw[i_].y)})
#define PZ_B(i_) ((f32x4){bflo(rw[i_].z), bfhi(rw[i_].z), bflo(rw[i_].w), bfhi(rw[i_].w)})
    f32x4 suma = (f32x4){0.f, 0.f, 0.f, 0.f}, sumb = suma;
#pragma unroll
    for (int i = 0; i < 2 * WH; ++i) { suma += PZ_A(i); sumb += PZ_B(i); }
#pragma unroll
    for (int j = 0; j < 8; ++j) { const int p = p0 + j; const int cnt = min(p + WH, SEQ) - max(p - WH, 0); const float rc = frcp((float)cnt);
        const f32x4 za = (suma * rc - PZ_A(j + WH)) * sa, zb = (sumb * rc - PZ_B(j + WH)) * sb;
        *(u32x4*)(zp + ((size_t)b * SEQ + p) * D + ch) = (u32x4){pk2(za.x, za.y), pk2(za.z, za.w), pk2(zb.x, zb.y), pk2(zb.z, zb.w)};
        suma += PZ_A(j + 2 * WH) - PZ_A(j); sumb += PZ_B(j + 2 * WH) - PZ_B(j); }
#undef PZ_A
#undef PZ_B
}
__device__ __forceinline__ void phase_pool(const Ctx& F) {
    bf16* zp = (bf16*)(F.ws + WS_XA);
    for (int item = F.bid * 512 + F.tid; item < 4096 * 256; item += F.G * 512) {
        const int strip = item >> 8, ct = item & 255, b = strip >> 8, p0 = (strip & 255) * 8, ch = 4 * ct;
        const int g = __builtin_amdgcn_readfirstlane(ct >> 6);
        if (g == 0) pool_item<1>(F, zp, b, p0, ch); else if (g == 1) pool_item<2>(F, zp, b, p0, ch); else if (g == 2) pool_item<4>(F, zp, b, p0, ch); else pool_item<8>(F, zp, b, p0, ch);
    }
}
__device__ __forceinline__ void pool_tile(const Ctx& F, int pm, int pn) {
    bf16* zp = (bf16*)(F.ws + WS_XA);
    const int b = pm >> 3, t0 = (pm & 7) * 256;
#pragma unroll 1
    for (int j = 0; j < 2; ++j) { const int q = F.tid + 512 * j, strip = q >> 5, ct = q & 31; const int p0 = t0 + strip * 8, ch = 256 * pn + 8 * ct;
        if (pn == 0) pool_item8<1>(F, zp, b, p0, ch); else if (pn == 1) pool_item8<2>(F, zp, b, p0, ch); else if (pn == 2) pool_item8<4>(F, zp, b, p0, ch); else pool_item8<8>(F, zp, b, p0, ch); }
}
struct SchedPool {
    int G, c; const char* Wt;
    __device__ __forceinline__ bool next(int i, g8::Unit& u) const {
        const int L = i * G + c; if (L >= 512) return false;
        int pm, pn; g8::tile_of(L, 128, 4, pm, pn); u.pm = pm; u.pn = pn; u.e = 0; u.aux = 0; u.B = Wt + (size_t)pn * 256 * 256 * 2; return true; }
    __device__ __forceinline__ unsigned rowoff(const g8::Unit& u, int r) const { return (unsigned)(u.pm * 256 + r) * 2048u + (unsigned)u.pn * 512u; }
};

__global__ void __launch_bounds__(512, 2) mk_fwd(Args args) {
    extern __shared__ __attribute__((aligned(16))) unsigned char lds_raw[];
    Ctx F;
    F.lds = (LAS unsigned char*)lds_raw;
    F.tid = threadIdx.x; F.lane = F.tid & 63; F.wave = __builtin_amdgcn_readfirstlane(F.tid >> 6); F.G = gridDim.x; F.bid = blockIdx.x;
    F.a = (KArgs)__builtin_amdgcn_kernarg_segment_ptr();
    F.H = args.out; F.ws = args.ws;
    for (int u = F.tid; u < (LDS_BYTES - LDSCTL_OFF) / 4; u += 512) ((LAS unsigned*)(F.lds + LDSCTL_OFF))[u] = 0u;
    __syncthreads();
    XcdBarrier bar; bar.bar = (unsigned*)(F.ws + WS_CTL) + CW_BAR; bar.x = 0; bar.st = nullptr;
    if (MK_N_LAUNCHES == 1) bar = xcd_barrier_post((unsigned*)(F.ws + WS_CTL) + CW_BAR, (volatile LAS unsigned*)(F.lds + LDSCTL_OFF));
    const int lo = args.ph_lo, hi = args.ph_hi;
#ifndef PHMASK
#define PHMASK 0xFFFF
#endif
#define IN(k) (((PHMASK >> (k)) & 1) && lo <= (k) && (k) < hi)
#define FRESH() do { asm volatile("" : "+s"(F.a)); } while (0)
#define SEAM(k) do { if (IN(k) && IN((k) + 1)) xcd_barrier(bar); } while (0)

    if (IN(0)) { FRESH(); phase0(F); if (RPT & 1) { __syncthreads(); phase0(F); } } SEAM(0);
    if (IN(1)) { FRESH(); phase1(F); if (RPT & 2) { __syncthreads(); phase1(F); } } SEAM(1);
    if (IN(2)) { FRESH();
        SchedIn S{F.G, F.bid, (const char*)(F.ws + WS_WIN)};
        EpiIn E{F.ws, (unsigned char*)F.H, F.lds};
        g8::gemm_phase(F.lds, (const char*)(F.ws + WS_XA), 1024, S, E);
        convert_tail(F, F.bid, (1792 + 128) % 256, 0, 10240);
    } SEAM(2);
    if (IN(3)) { FRESH(); phase3(F); if (RPT & 8) { __syncthreads(); phase3(F); } } SEAM(3);
    if (IN(4)) { FRESH(); phase4(F); if (RPT & 16) { __syncthreads(); phase4(F); } } SEAM(4);
    if (IN(5)) { FRESH();
        SchedOut S{F.G, F.bid, (const char*)(F.ws + WS_WOUT)};
        EpiY E{(bf16*)(F.ws + WS_P), modp(F, 0, 0, 2), nullptr, (ABL & 1) ? 0.f : 1.f};
        g8::gemm_phase(F.lds, (const char*)(F.ws + WS_XA), 1024, S, E); if ((RPT >> 5) & 1) { __syncthreads(); g8::gemm_phase(F.lds, (const char*)(F.ws + WS_XA), 1024, S, E); }
    } SEAM(5);
    if (IN(6)) { FRESH(); phase_ln_router<true>(F, 0, F.a->in[0], (const bf16*)(F.ws + WS_P)); } SEAM(6);
    if (IN(7)) { FRESH();
        moe_table(F, 0); moe_tokl(F);
        SchedMoe S{F.G, F.bid, (const char*)(F.ws + WS_WGU), (size_t)1024 * 1024 * 2, (size_t)256 * 1024 * 2, (const LAS int*)(F.lds + LDS_TAB_OFF), (const LAS int*)(F.lds + LDS_TOKL_OFF), 1, 2048u};
        EpiAct E{(bf16*)(F.ws + WS_ACT)};
        g8::gemm_phase(F.lds, (const char*)(F.ws + WS_XA), 1024, S, E);
        convert_tail(F, moe_vc(F.bid, F.G), (4 * ((const LAS int*)(F.lds + LDS_TAB_OFF))[32]) % 256, 10240, 20480); if ((RPT >> 7) & 1) { __syncthreads(); g8::gemm_phase(F.lds, (const char*)(F.ws + WS_XA), 1024, S, E); }
    } SEAM(7);
    if (IN(8)) { FRESH();
        moe_table(F, 0);
        SchedMoe S{F.G, F.bid, (const char*)(F.ws + WS_WDN), (size_t)1024 * 512 * 2, (size_t)256 * 512 * 2, (const LAS int*)(F.lds + LDS_TAB_OFF), (const LAS int*)(F.lds + LDS_TOKL_OFF), 0, 1024u};
        EpiEo E{(bf16*)(F.ws + WS_EO)};
        g8::gemm_phase(F.lds, (const char*)(F.ws + WS_ACT), 512, S, E);
        convert_tail(F, moe_vc(F.bid, F.G), (4 * ((const LAS int*)(F.lds + LDS_TAB_OFF))[32]) % 256, 20480, I_E1); if ((RPT >> 8) & 1) { __syncthreads(); g8::gemm_phase(F.lds, (const char*)(F.ws + WS_ACT), 512, S, E); }
    } SEAM(8);
    if (IN(9)) { FRESH(); phase_combine(F, 0); } SEAM(9);
    if (IN(10)) { FRESH(); if (MK_N_LAUNCHES != 1 || F.G != 256) phase_pool(F); } if (MK_N_LAUNCHES != 1 || F.G != 256) SEAM(10);
    if (IN(11)) { FRESH();
        SchedPool S{F.G, F.bid, (const char*)(F.ws + WS_WPOOL)};
        if (MK_N_LAUNCHES == 1 && F.G == 256) {
            g8::Unit u;
            for (int i = 0; S.next(i, u); ++i) pool_tile(F, u.pm, u.pn);
            asm volatile("s_waitcnt vmcnt(0)" ::: "memory");
            __syncthreads();
        }
        EpiY E{(bf16*)(F.ws + WS_ACT), modp(F, 1, 0, 2), F.a->in[13], (ABL & 4) ? 0.f : 1.f};
        g8::gemm_phase(F.lds, (const char*)(F.ws + WS_XA), 256, S, E);
    } SEAM(11);
    if (IN(12)) { FRESH(); phase_ln_router<false>(F, 1, nullptr, (const bf16*)(F.ws + WS_ACT)); } SEAM(12);
    if (IN(13)) { FRESH();
        moe_table(F, 1); moe_tokl(F);
        SchedMoe S{F.G, F.bid, (const char*)(F.ws + WS_WGU) + (size_t)32 * 1024 * 1024 * 2, (size_t)1024 * 1024 * 2, (size_t)256 * 1024 * 2, (const LAS int*)(F.lds + LDS_TAB_OFF), (const LAS int*)(F.lds + LDS_TOKL_OFF), 1, 2048u};
        EpiAct E{(bf16*)(F.ws + WS_ACT)};
        g8::gemm_phase(F.lds, (const char*)(F.ws + WS_XA), 1024, S, E);
    } SEAM(13);
    if (IN(14)) { FRESH();
        moe_table(F, 1);
        SchedMoe S{F.G, F.bid, (const char*)(F.ws + WS_WDN) + (size_t)32 * 1024 * 512 * 2, (size_t)1024 * 512 * 2, (size_t)256 * 512 * 2, (const LAS int*)(F.lds + LDS_TAB_OFF), (const LAS int*)(F.lds + LDS_TOKL_OFF), 0, 1024u};
        EpiEo E{(bf16*)(F.ws + WS_EO)};
        g8::gemm_phase(F.lds, (const char*)(F.ws + WS_ACT), 512, S, E);
    } SEAM(14);
    if (IN(15)) { FRESH(); phase_combine(F, 1); }
#undef IN
#undef SEAM
}

extern "C" void kernel_launch(void* const* d_in, const int* in_sizes, int n_in, void* d_out, int out_size, void* d_ws, size_t ws_size, hipStream_t stream) {
    static int grid = 0;
    if (grid == 0) {
        if (n_in != 21 || in_sizes[0] != T * D || out_size != T * D || ws_size < WS_END) { fprintf(stderr, "kernel_launch: unexpected shapes (n_in %d, ws %zu); nothing launched\n", n_in, ws_size); grid = -1; return; }
        int dev = 0, cus = 0, per_cu = 0;
        if (hipGetDevice(&dev) != hipSuccess || hipDeviceGetAttribute(&cus, hipDeviceAttributeMultiprocessorCount, dev) != hipSuccess) { grid = -1; return; }
        if (hipFuncSetAttribute((const void*)mk_fwd, hipFuncAttributeMaxDynamicSharedMemorySize, LDS_BYTES) != hipSuccess) { fprintf(stderr, "kernel_launch: hipFuncSetAttribute failed\n"); grid = -1; return; }
        if (hipOccupancyMaxActiveBlocksPerMultiprocessor(&per_cu, (const void*)mk_fwd, 512, LDS_BYTES) != hipSuccess || per_cu < 1) { fprintf(stderr, "kernel_launch: occupancy query reports %d\n", per_cu); }
        (void)hipGetLastError();
        grid = cus;
    }
    if (grid < 0) return;
    if (hipMemsetAsync((char*)d_ws + WS_CTL, 0, CTL_ZERO_BYTES, stream) != hipSuccess) return;
    Args a{};
    for (int i = 0; i < 21; ++i) a.in[i] = (const float*)d_in[i];
    a.out = (float*)d_out; a.ws = (unsigned char*)d_ws;
    if (MK_N_LAUNCHES == 1) { a.ph_lo = 0; a.ph_hi = NPHASE; hipLaunchKernelGGL(mk_fwd, dim3(grid), dim3(512), LDS_BYTES, stream, a); }
    else for (int p = 0; p < NPHASE; ++p) { a.ph_lo = p; a.ph_hi = p + 1; hipLaunchKernelGGL(mk_fwd, dim3(grid), dim3(512), LDS_BYTES, stream, a); }
}
```
